# Optimizing an MI355X kernel written in HIP

```python
import jax, jax.numpy as jnp
from jax import lax
import numpy as np

D_MODEL = 1024
BATCH = 8
SEQ = 8192
DEPTH = 1

N_MEM = 256
D_MIX = D_MODEL
ML_HEADS = 4
ML_DH = D_MIX // 2 // ML_HEADS
ML_W = ML_HEADS * ML_DH
ML_CHUNK = 64
CONV_W = 4
FX_HEADS = 8
FX_DH = (D_MIX - ML_W) // FX_HEADS
FX_W = FX_HEADS * FX_DH
Q_BLOCK = 128
X_HEADS = 4
X_DH = D_MODEL // X_HEADS
D_FF = 4 * D_MODEL
EPS = 1e-6
IN_SIZES = (2 * ML_W, ML_W, ML_W, ML_HEADS, ML_HEADS, FX_W, FX_W, FX_W, FX_HEADS)
IN_COLS = 4 * ML_W + 2 * ML_HEADS + 3 * FX_W + FX_HEADS

kernel_name = "hymba_mlstm_fox_hybrid"


def rmsnorm(x, g):
    xf = x.astype(jnp.float32)
    y = xf * lax.rsqrt(jnp.mean(xf * xf, axis=-1, keepdims=True) + EPS)
    return (y * g.astype(jnp.float32)).astype(x.dtype)


def causal_conv(u, w, b):
    S = u.shape[1]
    up = jnp.pad(u, ((0, 0), (CONV_W - 1, 0), (0, 0)))
    out = b
    for j in range(CONV_W):
        out = out + up[:, j:j + S] * w[j]
    return out


def mlstm_chunkwise(q, k, v, ig, lf):
    B, S, H, dh = q.shape
    nc = S // ML_CHUNK
    k = k * (dh ** -0.5)

    def to_chunks(t):
        t = t.reshape((B, nc, ML_CHUNK) + t.shape[2:])
        return jnp.moveaxis(t, (1, 3), (0, 2))

    causal = jnp.tril(jnp.ones((ML_CHUNK, ML_CHUNK), dtype=bool))

    def body(carry, xs):
        C, n, m = carry
        qc, kc, vc, ic, fc = xs
        b = jnp.cumsum(fc, axis=-1)
        g = b[..., -1]
        dmat = b[..., :, None] - b[..., None, :] + ic[..., None, :]
        dmat = jnp.where(causal, dmat, -jnp.inf)
        m_inter = b + m[..., None]
        m_t = jnp.maximum(m_inter, jnp.max(dmat, axis=-1))
        scores = jnp.einsum('bhtd,bhsd->bhts', qc, kc) * jnp.exp(dmat - m_t[..., None])
        inter = jnp.exp(m_inter - m_t)
        num = (jnp.einsum('bhts,bhsd->bhtd', scores, vc)
               + inter[..., None] * jnp.einsum('bhed,bhtd->bhte', C, qc))
        den = scores.sum(-1) + inter * jnp.einsum('bhd,bhtd->bht', n, qc)
        h = num / jnp.maximum(jnp.abs(den), jnp.exp(-m_t))[..., None]
        a = g[..., None] - b + ic
        m_new = jnp.maximum(g + m, jnp.max(a, axis=-1))
        decay = jnp.exp(g + m - m_new)
        wa = jnp.exp(a - m_new[..., None])
        C_new = decay[..., None, None] * C + jnp.einsum('bhs,bhse,bhsd->bhed', wa, vc, kc)
        n_new = decay[..., None] * n + jnp.einsum('bhs,bhsd->bhd', wa, kc)
        return (C_new, n_new, m_new), h

    init = (jnp.zeros((B, H, dh, dh), jnp.float32), jnp.zeros((B, H, dh), jnp.float32),
            jnp.zeros((B, H), jnp.float32))
    _, hs = lax.scan(body, init, (to_chunks(q), to_chunks(k), to_chunks(v), to_chunks(ig), to_chunks(lf)))
    hs = jnp.moveaxis(hs, (0, 2), (1, 3))
    return hs.reshape(B, S, H, dh)


def forgetting_attention(q, k, v, lf):
    B, S, H, dh = q.shape
    nb = S // Q_BLOCK
    cT = jnp.cumsum(lf, axis=1).transpose(0, 2, 1)
    qb = q.reshape(B, nb, Q_BLOCK, H, dh).transpose(1, 0, 2, 3, 4)
    cb = cT.reshape(B, H, nb, Q_BLOCK).transpose(2, 0, 1, 3)
    kpos = jnp.arange(S)
    scale = dh ** -0.5

    def block(args):
        qi, ci, blk = args
        qpos = blk * Q_BLOCK + jnp.arange(Q_BLOCK)
        s = jnp.einsum('bqhd,bkhd->bhqk', qi, k, preferred_element_type=jnp.float32) * scale
        s = s + (ci[..., :, None] - cT[..., None, :])
        s = jnp.where(qpos[:, None] >= kpos[None, :], s, -jnp.inf)
        p = jax.nn.softmax(s, axis=-1)
        return jnp.einsum('bhqk,bkhd->bqhd', p.astype(v.dtype), v)

    out = lax.map(block, (qb, cb, jnp.arange(nb)))
    return out.transpose(1, 0, 2, 3, 4).reshape(B, S, H, dh)


def cross_attention(h, memn, w_q, w_kv, w_o):
    B, S, D = h.shape
    M = memn.shape[1]
    q = (h @ w_q).reshape(B, S, X_HEADS, X_DH)
    k, v = jnp.split(memn @ w_kv, 2, axis=-1)
    k = k.reshape(B, M, X_HEADS, X_DH)
    v = v.reshape(B, M, X_HEADS, X_DH)
    s = jnp.einsum('bqhd,bmhd->bhqm', q, k, preferred_element_type=jnp.float32) * (X_DH ** -0.5)
    p = jax.nn.softmax(s, axis=-1)
    o = jnp.einsum('bhqm,bmhd->bqhd', p.astype(v.dtype), v).reshape(B, S, D)
    return o @ w_o


def setup_inputs(seed: int = 0) -> dict:
    key = jax.random.key(seed)
    ks = jax.random.split(key, 24)
    f32 = jnp.float32

    def w(k, shape, fan_in):
        return jax.random.normal(k, shape, f32) * (fan_in ** -0.5)

    def gain(k, shape):
        return 1.0 + 0.1 * jax.random.normal(k, shape, f32)

    def small(k, shape):
        return 0.01 * jax.random.normal(k, shape, f32)

    return {
        "x": jax.random.normal(ks[0], (BATCH, SEQ, D_MODEL), f32),
        "mem": jax.random.normal(ks[1], (BATCH, N_MEM, D_MODEL), f32),
        "ln1": gain(ks[2], (DEPTH, D_MODEL)),
        "w_in": w(ks[3], (DEPTH, D_MODEL, IN_COLS), D_MODEL),
        "ml_conv_w": w(ks[4], (DEPTH, CONV_W, 2 * ML_W), CONV_W),
        "ml_conv_b": small(ks[5], (DEPTH, 2 * ML_W)),
        "ml_b_i": small(ks[6], (DEPTH, ML_HEADS)),
        "ml_b_f": 3.0 + 0.1 * jax.random.normal(ks[7], (DEPTH, ML_HEADS), f32),
        "ml_norm": gain(ks[8], (DEPTH, ML_W)),
        "fx_b_f": 3.0 + 0.1 * jax.random.normal(ks[9], (DEPTH, FX_HEADS), f32),
        "w_out": w(ks[10], (DEPTH, D_MIX, D_MODEL), D_MIX),
        "ln_x": gain(ks[11], (DEPTH, D_MODEL)),
        "ln_mem": gain(ks[12], (DEPTH, D_MODEL)),
        "w_xq": w(ks[13], (DEPTH, D_MODEL, D_MODEL), D_MODEL),
        "w_xkv": w(ks[14], (DEPTH, D_MODEL, 2 * D_MODEL), D_MODEL),
        "w_xo": w(ks[15], (DEPTH, D_MODEL, D_MODEL), D_MODEL),
        "ln2": gain(ks[16], (DEPTH, D_MODEL)),
        "w_ff1": w(ks[17], (DEPTH, D_MODEL, D_FF), D_MODEL),
        "w_ff2": w(ks[18], (DEPTH, D_FF, D_MODEL), D_FF),
        "ln_f": gain(ks[19], (D_MODEL,)),
    }


def reference(x, mem, ln1, w_in, ml_conv_w, ml_conv_b, ml_b_i, ml_b_f, ml_norm, fx_b_f, w_out,
              ln_x, ln_mem, w_xq, w_xkv, w_xo, ln2, w_ff1, w_ff2, ln_f):
    B, S, _ = x.shape
    splits = [int(v) for v in np.cumsum(IN_SIZES)[:-1]]
    for l in range(DEPTH):
        h = rmsnorm(x, ln1[l])
        z = h @ w_in[l]
        ml_qk, ml_v, ml_o, ml_i, ml_f, fx_q, fx_k, fx_v, fx_f = jnp.split(z, splits, axis=-1)

        ml_qk = jax.nn.silu(causal_conv(ml_qk, ml_conv_w[l], ml_conv_b[l]))
        mq, mk = jnp.split(ml_qk.astype(jnp.float32), 2, axis=-1)
        mq = mq.reshape(B, S, ML_HEADS, ML_DH)
        mk = mk.reshape(B, S, ML_HEADS, ML_DH)
        mv = ml_v.astype(jnp.float32).reshape(B, S, ML_HEADS, ML_DH)
        ig = ml_i.astype(jnp.float32) + ml_b_i[l].astype(jnp.float32)
        lf = jax.nn.log_sigmoid(ml_f.astype(jnp.float32) + ml_b_f[l].astype(jnp.float32))
        mh = mlstm_chunkwise(mq, mk, mv, ig, lf)
        mh = mh * lax.rsqrt(jnp.mean(mh * mh, axis=-1, keepdims=True) + EPS)
        mh = mh * ml_norm[l].astype(jnp.float32).reshape(ML_HEADS, ML_DH)
        ml_out = (mh.reshape(B, S, ML_W) * jax.nn.sigmoid(ml_o.astype(jnp.float32))).astype(x.dtype)

        fq = fx_q.reshape(B, S, FX_HEADS, FX_DH)
        fk = fx_k.reshape(B, S, FX_HEADS, FX_DH)
        fv = fx_v.reshape(B, S, FX_HEADS, FX_DH)
        flf = jax.nn.log_sigmoid(fx_f.astype(jnp.float32) + fx_b_f[l].astype(jnp.float32))
        fx_out = forgetting_attention(fq, fk, fv, flf).reshape(B, S, FX_W)

        x = x + jnp.concatenate([ml_out, fx_out], axis=-1) @ w_out[l]

        x = x + cross_attention(rmsnorm(x, ln_x[l]), rmsnorm(mem, ln_mem[l]), w_xq[l], w_xkv[l], w_xo[l])

        u = jax.nn.relu(rmsnorm(x, ln2[l]) @ w_ff1[l])
        x = x + (u * u) @ w_ff2[l]
    return rmsnorm(x, ln_f)
```

```cpp
#include <hip/hip_runtime.h>
#include <hip/hip_cooperative_groups.h>
#include <hip/hip_bf16.h>
#include <cstdio>
#include <cstdint>
#include <cmath>
namespace cg = cooperative_groups;
namespace pg8 {
#define PG8_LAS __attribute__((address_space(3)))
typedef unsigned short bf16_t;
typedef short bf16x8 __attribute__((ext_vector_type(8)));
typedef float f32x4 __attribute__((ext_vector_type(4)));
typedef unsigned u32x4 __attribute__((ext_vector_type(4)));
constexpr int BM = 256, BK = 64, HALF = 128, HTB = HALF * BK * 2  , STAGE_BYTES = 8 * HTB, NXCD = 8, WGM = 8;

__host__ __device__ __forceinline__ int lds_byte(int r, int c) { const int st = (r >> 4) * 2 + (c >> 5), rr = r & 15, cc = c & 31, ob = rr * 64 + cc * 2; return st * 1024 + (ob ^ (((ob >> 9) & 1) << 5)); }
__host__ __device__ __forceinline__ void stage_rc(int b, int& R, int& C) { const int st = b / 1024, sb = b % 1024, swz = sb ^ (((sb >> 9) & 1) << 5); R = (st >> 1) * 16 + swz / 64; C = (st & 1) * 32 + (swz % 64) / 2; }
__host__ __device__ __forceinline__ int perm32(int rho) { const int n = rho >> 4, i = rho & 15; return 8 * (i >> 2) + 4 * n + (i & 3); }

struct Unit { int pm, pn; };
struct Gemm { const bf16_t* A; const bf16_t* Bt; int M, N, K; };

struct StaticOrder {
    int nM, nN, nwg, G, c;
    __host__ __device__ void init(int M, int N, int G_, int c_) { nM = M / BM; nN = N / BM; nwg = nM * nN; G = G_; c = c_; }
    __host__ __device__ bool next(int i, Unit& u) const {
        const long L = (long)i * G + c; if (L >= nwg) return false;
        int wgid = (int)L; { const int q = nwg / NXCD, r = nwg % NXCD, xcd = wgid % NXCD, off = wgid / NXCD; wgid = (xcd < r ? xcd * (q + 1) : r * (q + 1) + (xcd - r) * q) + off; }
        const int nig = WGM * nN, gid = wgid / nig, fm = gid * WGM, gsz = (nM - fm) < WGM ? (nM - fm) : WGM;
        u.pm = fm + ((wgid % nig) % gsz); u.pn = (wgid % nig) / gsz; return true;
    }
    __device__ __forceinline__ void a_ready(const Unit&) const {}
    __device__ __forceinline__ void done(const Unit&) const {}
};

__device__ __forceinline__ unsigned cvt_pk_bf16(float lo, float hi) { unsigned r; asm volatile("v_cvt_pk_bf16_f32 %0, %1, %2" : "=v"(r) : "v"(lo), "v"(hi)); return r; }
typedef float f32x2 __attribute__((ext_vector_type(2)));
typedef unsigned u32x2 __attribute__((ext_vector_type(2)));
constexpr float RMS_EPS = 1e-6f;
__device__ __forceinline__ float row_rs(const float* ss, int row) {
    const f32x4* p = (const f32x4*)(ss + (size_t)row * 16);
    const f32x4 a = p[0], b = p[1], c = p[2], d = p[3];
    const float s = ((a[0] + a[1]) + (a[2] + a[3])) + ((b[0] + b[1]) + (b[2] + b[3])) + ((c[0] + c[1]) + (c[2] + c[3])) + ((d[0] + d[1]) + (d[2] + d[3]));
    return 1.0f / sqrtf(s * (1.0f / 1024.0f) + RMS_EPS);
}
struct EpiZ {
    static constexpr bool PERM = true, AFTER_DRAIN = false;
    bf16_t* Z; float* G; float c2;
    __device__ __forceinline__ void operator()(const f32x4 (&acc)[2][2][4][2], const Unit& u, int wr, int wc, int fr, int fq) const {
        const int row0 = u.pm * BM + wr * 64 + fr;
        if (u.pn < 14) {
            const float sc = (u.pn == 8 || u.pn == 9) ? c2 : 1.0f;
            const int col0 = u.pn * BM + wc * 32 + 8 * fq;
#pragma unroll
            for (int ai = 0; ai < 2; ++ai)
#pragma unroll
                for (int m = 0; m < 4; ++m) { bf16_t* rowp = Z + (size_t)(row0 + ai * HALF + m * 16) * 3584 + col0;
#pragma unroll
                    for (int bj = 0; bj < 2; ++bj) { const f32x4 v0 = acc[ai][bj][m][0] * sc, v1 = acc[ai][bj][m][1] * sc;
                        u32x4 w; w.x = cvt_pk_bf16(v0[0], v0[1]); w.y = cvt_pk_bf16(v0[2], v0[3]); w.z = cvt_pk_bf16(v1[0], v1[1]); w.w = cvt_pk_bf16(v1[2], v1[3]);
                        *(u32x4*)(rowp + bj * HALF) = w; } }
        } else if (wc == 0 && fq < 2) {
#pragma unroll
            for (int ai = 0; ai < 2; ++ai)
#pragma unroll
                for (int m = 0; m < 4; ++m) { float* gp = G + (size_t)(row0 + ai * HALF + m * 16) * 16 + 8 * fq;
                    *(f32x4*)(gp) = acc[ai][0][m][0]; *(f32x4*)(gp + 4) = acc[ai][0][m][1]; }
        }
    }
};
struct EpiPlain {
    static constexpr bool PERM = true, AFTER_DRAIN = false;
    bf16_t* O; int ldc;
    __device__ __forceinline__ void operator()(const f32x4 (&acc)[2][2][4][2], const Unit& u, int wr, int wc, int fr, int fq) const {
        const int row0 = u.pm * BM + wr * 64 + fr; const int col0 = u.pn * BM + wc * 32 + 8 * fq;
#pragma unroll
        for (int ai = 0; ai < 2; ++ai)
#pragma unroll
            for (int m = 0; m < 4; ++m) { bf16_t* rowp = O + (size_t)(row0 + ai * HALF + m * 16) * ldc + col0;
#pragma unroll
                for (int bj = 0; bj < 2; ++bj) { const f32x4 v0 = acc[ai][bj][m][0], v1 = acc[ai][bj][m][1];
                    u32x4 w; w.x = cvt_pk_bf16(v0[0], v0[1]); w.y = cvt_pk_bf16(v0[2], v0[3]); w.z = cvt_pk_bf16(v1[0], v1[1]); w.w = cvt_pk_bf16(v1[2], v1[3]);
                    *(u32x4*)(rowp + bj * HALF) = w; } }
    }
};
template <int ACT> struct EpiRowScale {
    static constexpr bool PERM = true, AFTER_DRAIN = false;
    bf16_t* O; int ldc; const float* ss; float sc;
    __device__ __forceinline__ void operator()(const f32x4 (&acc)[2][2][4][2], const Unit& u, int wr, int wc, int fr, int fq) const {
        const int row0 = u.pm * BM + wr * 64 + fr; const int col0 = u.pn * BM + wc * 32 + 8 * fq;
#pragma unroll
        for (int ai = 0; ai < 2; ++ai)
#pragma unroll
            for (int m = 0; m < 4; ++m) { const int row = row0 + ai * HALF + m * 16; const float r = row_rs(ss, row) ; bf16_t* rowp = O + (size_t)row * ldc + col0;
#pragma unroll
                for (int bj = 0; bj < 2; ++bj) { f32x4 v0 = acc[ai][bj][m][0] * r, v1 = acc[ai][bj][m][1] * r;
                    if (ACT == 1) {
#pragma unroll
                        for (int e = 0; e < 4; ++e) { const float a = fmaxf(v0[e], 0.f), b = fmaxf(v1[e], 0.f); v0[e] = a * a; v1[e] = b * b; }
                    } else { v0 = v0 * sc; v1 = v1 * sc; }
                    u32x4 w; w.x = cvt_pk_bf16(v0[0], v0[1]); w.y = cvt_pk_bf16(v0[2], v0[3]); w.z = cvt_pk_bf16(v1[0], v1[1]); w.w = cvt_pk_bf16(v1[2], v1[3]);
                    *(u32x4*)(rowp + bj * HALF) = w; } }
    }
};
struct EpiRes {
    static constexpr bool PERM = false, AFTER_DRAIN = false;
    const float* base; float* out; bf16_t* xn; const float* gain; float* ssout;
    __device__ __forceinline__ void operator()(const f32x4 (&acc)[2][2][4][2], const Unit& u, int wr, int wc, int fr, int fq) const {
        const int row0 = u.pm * BM + wr * 64 + fr; const int col0 = u.pn * BM + wc * 32 + 4 * fq;
        f32x4 gv[2][2];
#pragma unroll
        for (int bj = 0; bj < 2; ++bj)
#pragma unroll
            for (int n = 0; n < 2; ++n) gv[bj][n] = xn ? *(const f32x4*)(gain + col0 + bj * HALF + n * 16) : (f32x4){1.f, 1.f, 1.f, 1.f};
#pragma unroll
        for (int ai = 0; ai < 2; ++ai)
#pragma unroll
            for (int m = 0; m < 4; ++m) { const int row = row0 + ai * HALF + m * 16; const size_t off = (size_t)row * 1024 + col0; float sq = 0.f;
#pragma unroll
                for (int bj = 0; bj < 2; ++bj)
#pragma unroll
                    for (int n = 0; n < 2; ++n) { const f32x4 bs = *(const f32x4*)(base + off + bj * HALF + n * 16); const f32x4 o = bs + acc[ai][bj][m][n];
                        *(f32x4*)(out + off + bj * HALF + n * 16) = o; sq += (o[0] * o[0] + o[1] * o[1]) + (o[2] * o[2] + o[3] * o[3]);
                        if (xn) { const f32x4 g = o * gv[bj][n]; u32x2 w; w.x = cvt_pk_bf16(g[0], g[1]); w.y = cvt_pk_bf16(g[2], g[3]); *(u32x2*)(xn + off + bj * HALF + n * 16) = w; } }
                sq += __shfl_xor(sq, 16); sq += __shfl_xor(sq, 32);
                if (fq == 0) ssout[(size_t)row * 16 + u.pn * 4 + wc] = sq;
                asm volatile("" ::: "memory"); }
    }
};
template <class Epi, class Sched, bool ALIGN_EPI = false, bool SP2 = false>
__device__ __forceinline__ void gemm_phase(PG8_LAS unsigned char* lds, const Gemm g, const Sched& S, const Epi& E, const int tid_in) {
    const int tid = tid_in, wid = __builtin_amdgcn_readfirstlane(tid >> 6), lane = tid & 63, wr = wid >> 2, wc = wid & 3, fr = lane & 15, fq = lane >> 4;
    const int K = g.K, nt = K / BK;
    unsigned voffA[2], voffB[2];
#pragma unroll
    for (int i = 0; i < 2; ++i) { int R, C; stage_rc(tid * 16 + i * 8192, R, C); const int Rb = Epi::PERM ? ((R & ~31) + perm32(R & 31)) : R;
        voffA[i] = (unsigned)(R * K + C) * 2u; voffB[i] = (unsigned)(Rb * K + C) * 2u; }
    const size_t kstep = (size_t)(BK * 2);
    const size_t hstep = (size_t)HALF * K * 2;
    const size_t tstep = 2 * hstep;
    const unsigned ldsw = (unsigned)wid * 1024u;
    const int aoff = lds_byte(wr * 64 + fr, fq * 8), boff = lds_byte(wc * 32 + fr, fq * 8);
#define PG8_SA(b, h) (((b) * 2 + (h)) * HTB)
#define PG8_SB(b, h) ((4 + (b) * 2 + (h)) * HTB)
#define PG8_STAGE(bufoff, gbase, voff) do { _Pragma("unroll") for (int _i = 0; _i < 2; ++_i) \
        __builtin_amdgcn_global_load_lds((const unsigned*)((const char*)(gbase) + (voff)[_i]), (PG8_LAS unsigned*)(lds + (bufoff) + ldsw + _i * 8192), 16, 0, 0); } while (0)
#define PG8_LDA(dst, b, h) do { _Pragma("unroll") for (int m = 0; m < 4; ++m) _Pragma("unroll") for (int k = 0; k < 2; ++k) dst[m][k] = *(const PG8_LAS bf16x8*)(lds + PG8_SA(b, h) + aoff + m * 2048 + k * 1024); } while (0)
#define PG8_LDB(dst, b, h) do { _Pragma("unroll") for (int n = 0; n < 2; ++n) _Pragma("unroll") for (int k = 0; k < 2; ++k) dst[n][k] = *(const PG8_LAS bf16x8*)(lds + PG8_SB(b, h) + boff + n * 2048 + k * 1024); } while (0)
#define PG8_MMA(ai, bj, At, Bt) do { __builtin_amdgcn_s_setprio(1); _Pragma("unroll") for (int m = 0; m < 4; ++m) _Pragma("unroll") for (int n = 0; n < 2; ++n) _Pragma("unroll") for (int k = 0; k < 2; ++k) \
        acc[ai][bj][m][n] = __builtin_amdgcn_mfma_f32_16x16x32_bf16(Bt[n][k], At[m][k], acc[ai][bj][m][n], 0, 0, 0); __builtin_amdgcn_s_setprio(0); } while (0)
#define PG8_WAIT_V(n) asm volatile("s_waitcnt vmcnt(" #n ")" ::: "memory")
#define PG8_WAIT_L(n) asm volatile("s_waitcnt lgkmcnt(" #n ")" ::: "memory")
#define PG8_BAR __builtin_amdgcn_s_barrier()
#define PG8_SCHED __builtin_amdgcn_sched_barrier(0)
    Unit cur, nxt; int ui = 0;
    if (!S.next(0, cur)) return;
    f32x4 acc[2][2][4][2];
#pragma unroll
    for (int a = 0; a < 2; ++a)
#pragma unroll
        for (int b = 0; b < 2; ++b)
#pragma unroll
            for (int m = 0; m < 4; ++m)
#pragma unroll
                for (int n = 0; n < 2; ++n) acc[a][b][m][n] = (f32x4){0.f, 0.f, 0.f, 0.f};
    bf16x8 At[4][2], B0[2][2], B1[2][2];
    const char* cA = (const char*)g.A + (size_t)cur.pm * tstep; const char* cB = (const char*)g.Bt + (size_t)cur.pn * tstep;
    S.a_ready(cur);
    if constexpr (SP2) {
        PG8_STAGE(PG8_SB(0, 0), cB, voffB); PG8_STAGE(PG8_SB(0, 1), cB + hstep, voffB); PG8_STAGE(PG8_SA(0, 0), cA, voffA); PG8_STAGE(PG8_SA(0, 1), cA + hstep, voffA);
        if (wr == 1) PG8_BAR;
        PG8_WAIT_V(2); PG8_BAR;
        PG8_STAGE(PG8_SB(1, 0), cB + kstep, voffB); PG8_STAGE(PG8_SA(1, 0), cA + kstep, voffA); PG8_STAGE(PG8_SB(1, 1), cB + hstep + kstep, voffB);
        PG8_WAIT_V(6); PG8_BAR;
    } else {
        PG8_STAGE(PG8_SB(0, 0), cB, voffB); PG8_STAGE(PG8_SA(0, 0), cA, voffA); PG8_STAGE(PG8_SB(0, 1), cB + hstep, voffB); PG8_STAGE(PG8_SA(0, 1), cA + hstep, voffA);
        if (wr == 1) PG8_BAR;
        PG8_WAIT_V(4); PG8_BAR;
        PG8_STAGE(PG8_SB(1, 0), cB + kstep, voffB); PG8_STAGE(PG8_SA(1, 0), cA + kstep, voffA); PG8_STAGE(PG8_SB(1, 1), cB + hstep + kstep, voffB);
        PG8_WAIT_V(6); PG8_BAR;
    }
    for (;;) {
        const bool has_next = S.next(ui + 1, nxt);
        const char* nA = has_next ? (const char*)g.A + (size_t)nxt.pm * tstep : cA; const char* nB = has_next ? (const char*)g.Bt + (size_t)nxt.pn * tstep : cB;
        for (int t = 0; t < nt; t += 2) {
            const bool last = (t == nt - 2);
            const char* a1 = cA + (size_t)(t + 1) * kstep;
            const char* a2 = last ? nA : cA + (size_t)(t + 2) * kstep; const char* b2 = last ? nB : cB + (size_t)(t + 2) * kstep;
            const char* a3 = a2 + kstep; const char* b3 = b2 + kstep;
            if (last && has_next) S.a_ready(nxt);
            if constexpr (SP2) {
            PG8_LDB(B0, 0, 0); PG8_LDB(B1, 0, 1); PG8_SCHED; PG8_LDA(At, 0, 0); PG8_STAGE(PG8_SA(1, 1), a1 + hstep, voffA);
            PG8_WAIT_V(8); PG8_WAIT_L(0); PG8_BAR; PG8_MMA(0, 0, At, B0); PG8_MMA(0, 1, At, B1); PG8_BAR; PG8_SCHED;
            PG8_LDA(At, 0, 1); PG8_STAGE(PG8_SB(0, 0), b2, voffB); PG8_STAGE(PG8_SB(0, 1), b2 + hstep, voffB); PG8_STAGE(PG8_SA(0, 0), a2, voffA);
            PG8_WAIT_V(8); PG8_WAIT_L(0); PG8_BAR; PG8_MMA(1, 0, At, B0); PG8_MMA(1, 1, At, B1); PG8_BAR; PG8_SCHED;
            PG8_LDB(B0, 1, 0); PG8_LDB(B1, 1, 1); PG8_SCHED; PG8_LDA(At, 1, 0); PG8_STAGE(PG8_SA(0, 1), a2 + hstep, voffA);
            PG8_WAIT_V(8); PG8_WAIT_L(0); PG8_BAR; PG8_MMA(0, 0, At, B0); PG8_MMA(0, 1, At, B1); PG8_BAR; PG8_SCHED;
            PG8_LDA(At, 1, 1); PG8_STAGE(PG8_SB(1, 0), b3, voffB); PG8_STAGE(PG8_SB(1, 1), b3 + hstep, voffB); PG8_STAGE(PG8_SA(1, 0), a3, voffA);
            PG8_WAIT_V(8); PG8_WAIT_L(0); PG8_BAR; PG8_MMA(1, 0, At, B0); PG8_MMA(1, 1, At, B1); PG8_BAR; PG8_SCHED;
            } else {
            PG8_LDB(B0, 0, 0); PG8_SCHED; PG8_LDA(At, 0, 0); PG8_STAGE(PG8_SA(1, 1), a1 + hstep, voffA);
            PG8_WAIT_L(8); PG8_BAR; PG8_WAIT_L(0); PG8_MMA(0, 0, At, B0); PG8_BAR; PG8_SCHED;
            PG8_LDB(B1, 0, 1); PG8_STAGE(PG8_SB(0, 0), b2, voffB);
            PG8_BAR; PG8_WAIT_L(0); PG8_MMA(0, 1, At, B1); PG8_BAR;
            PG8_LDA(At, 0, 1); PG8_STAGE(PG8_SA(0, 0), a2, voffA);
            PG8_BAR; PG8_WAIT_L(0); PG8_MMA(1, 0, At, B0); PG8_BAR; PG8_SCHED;
            PG8_STAGE(PG8_SB(0, 1), b2 + hstep, voffB);
            PG8_WAIT_V(6); PG8_BAR; PG8_MMA(1, 1, At, B1); PG8_BAR;
            PG8_LDB(B0, 1, 0); PG8_SCHED; PG8_LDA(At, 1, 0); PG8_STAGE(PG8_SA(0, 1), a2 + hstep, voffA);
            PG8_WAIT_L(8); PG8_BAR; PG8_WAIT_L(0); PG8_MMA(0, 0, At, B0); PG8_BAR; PG8_SCHED;
            PG8_LDB(B1, 1, 1); PG8_STAGE(PG8_SB(1, 0), b3, voffB);
            PG8_BAR; PG8_WAIT_L(0); PG8_MMA(0, 1, At, B1); PG8_BAR;
            PG8_LDA(At, 1, 1); PG8_STAGE(PG8_SA(1, 0), a3, voffA);
            PG8_BAR; PG8_WAIT_L(0); PG8_MMA(1, 0, At, B0); PG8_BAR; PG8_SCHED;
            PG8_STAGE(PG8_SB(1, 1), b3 + hstep, voffB);
            PG8_WAIT_V(6); PG8_BAR; PG8_MMA(1, 1, At, B1); PG8_BAR;
            }
        }
        if constexpr (ALIGN_EPI) { if (wr == 0) PG8_BAR; }
        if constexpr (!Epi::AFTER_DRAIN) { E(acc, cur, wr, wc, fr, fq); S.done(cur); }
        if (!has_next) break;
#pragma unroll
        for (int a = 0; a < 2; ++a)
#pragma unroll
            for (int b = 0; b < 2; ++b)
#pragma unroll
                for (int m = 0; m < 4; ++m)
#pragma unroll
                    for (int n = 0; n < 2; ++n) acc[a][b][m][n] = (f32x4){0.f, 0.f, 0.f, 0.f};
        cur = nxt; cA = nA; cB = nB; ++ui;
        if constexpr (ALIGN_EPI) { if (wr == 1) PG8_BAR; }
    }
    PG8_WAIT_V(0);
    if constexpr (!ALIGN_EPI) { if (wr == 0) PG8_BAR; }
    PG8_BAR;
    if constexpr (Epi::AFTER_DRAIN) { E.fused(acc, cur, wr, wc, fr, fq, lds, wid, lane); S.done(cur); }
#undef PG8_SA
#undef PG8_SB
#undef PG8_STAGE
#undef PG8_LDA
#undef PG8_LDB
#undef PG8_MMA
#undef PG8_WAIT_V
#undef PG8_WAIT_L
#undef PG8_BAR
#undef PG8_SCHED
}
}
#include <hip/hip_bf16.h>
#include <cmath>
namespace attn_body {
using bf16=__hip_bfloat16;
using bf16x8=__attribute__((ext_vector_type(8)))short;
using s16x4=__attribute__((ext_vector_type(4)))short;
using f32x16=__attribute__((ext_vector_type(16)))float;
using u32x4=__attribute__((ext_vector_type(4)))unsigned;
using f32x4_t=__attribute__((ext_vector_type(4)))float;
constexpr int BATCH=8,NHEAD=8,SEQ=8192,D=64,DM=3584,DMO=1024;
constexpr int NW=8,QBLK=32,QB=QBLK*NW,KVBLK=64,NQB=SEQ/QB;
constexpr int ATTN_PITCH=DM, ATTN_UNIT_ROWS=QB;
__device__ __forceinline__ int crow(int r,int hi){return (r&3)+8*(r>>2)+4*hi;}
#define SBAR() __builtin_amdgcn_sched_barrier(0)
__device__ __forceinline__ void cmask(f32x16&p0,f32x16&p1,int jb,int qrel,int hi){
  const float NEG=-INFINITY; int dq=qrel-64*jb-4*hi; asm volatile("":"+v"(dq));
  #pragma unroll
  for(int r=0;r<16;++r){const int c=(r&3)+8*(r>>2); if(c>dq)p0[r]=NEG; if(c+32>dq)p1[r]=NEG;}
}

constexpr int NSLOT=3, SLOTB=8192;
constexpr int LDS_K=0, LDS_V=NSLOT*SLOTB, LDS_WS=2*NSLOT*SLOTB, LDS_OST=LDS_WS+NW*64*4, LDS_CN=LDS_OST+NW*4096, LDS_BYTES=LDS_CN+SEQ*4;
constexpr float C2=0.125f*1.4426950408889634f;
__device__ __forceinline__ void glds16(const void*gsrc,unsigned lds_dst){unsigned keep;
  asm volatile("s_mov_b32 %0, m0\n\ts_mov_b32 m0, %2\n\ts_nop 0\n\tglobal_load_lds_dwordx4 %1, off\n\ts_mov_b32 m0, %0":"=&s"(keep):"v"(gsrc),"s"(lds_dst):"memory");}
__device__ __forceinline__ float max3f(float a,float b,float c){float r;asm("v_max3_f32 %0, %1, %2, %3":"=v"(r):"v"(a),"v"(b),"v"(c));return r;}
__device__ __forceinline__ float max2f(float a,float b){float r;asm("v_max_f32_e32 %0, %1, %2":"=v"(r):"v"(a),"v"(b));return r;}
__device__ __forceinline__ float fadd_s(float a,float b){float r;asm("v_add_f32_e32 %0, %1, %2":"=v"(r):"v"(a),"v"(b));return r;}
__device__ __forceinline__ float fsub_s(float a,float b){float r;asm("v_sub_f32_e32 %0, %1, %2":"=v"(r):"v"(a),"v"(b));return r;}
typedef float f32x2_t __attribute__((ext_vector_type(2))); typedef __bf16 bf16x2_t __attribute__((ext_vector_type(2)));
__device__ __forceinline__ unsigned cvtpk_s(float lo,float hi){f32x2_t v={lo,hi};bf16x2_t b=__builtin_convertvector(v,bf16x2_t);return __builtin_bit_cast(unsigned,b);}
#define WAIT_BAR(N) asm volatile("s_waitcnt vmcnt(" #N ") lgkmcnt(0)\n\ts_barrier":::"memory")

__device__ __forceinline__ void qkt(f32x16&p0,f32x16&p1,const char*Kslot,const bf16x8*qr,const f32x16&negm,int r32,int hi){
  const char*kb=Kslot+hi*1024+r32*16;
  #pragma unroll
  for(int d0=0;d0<4;++d0){
    const bf16x8 b0=*reinterpret_cast<const bf16x8*>(kb+d0*2048);
    const bf16x8 b1=*reinterpret_cast<const bf16x8*>(kb+d0*2048+512);
    if(d0==0){p0=__builtin_amdgcn_mfma_f32_32x32x16_bf16(b0,qr[0],negm,0,0,0);p1=__builtin_amdgcn_mfma_f32_32x32x16_bf16(b1,qr[0],negm,0,0,0);}
    else{p0=__builtin_amdgcn_mfma_f32_32x32x16_bf16(b0,qr[d0],p0,0,0,0);p1=__builtin_amdgcn_mfma_f32_32x32x16_bf16(b1,qr[d0],p1,0,0,0);}}
}
typedef __attribute__((address_space(3))) const char* lds_cptr;
typedef short v4i16_t __attribute__((ext_vector_type(4)));
__device__ __forceinline__ void kload8(bf16x8*kf,lds_cptr kp){
  kf[0]=*(const __attribute__((address_space(3))) bf16x8*)(kp);      kf[1]=*(const __attribute__((address_space(3))) bf16x8*)(kp+512);
  kf[2]=*(const __attribute__((address_space(3))) bf16x8*)(kp+2048); kf[3]=*(const __attribute__((address_space(3))) bf16x8*)(kp+2560);
  kf[4]=*(const __attribute__((address_space(3))) bf16x8*)(kp+4096); kf[5]=*(const __attribute__((address_space(3))) bf16x8*)(kp+4608);
  kf[6]=*(const __attribute__((address_space(3))) bf16x8*)(kp+6144); kf[7]=*(const __attribute__((address_space(3))) bf16x8*)(kp+6656);
}
__device__ __forceinline__ void kload2(bf16x8*kf,lds_cptr kp,int j){ kf[2*j]=*(const __attribute__((address_space(3))) bf16x8*)(kp+j*2048); kf[2*j+1]=*(const __attribute__((address_space(3))) bf16x8*)(kp+j*2048+512); }
__device__ __forceinline__ s16x4 vtr(lds_cptr p){ return __builtin_bit_cast(s16x4,__builtin_amdgcn_ds_read_tr16_b64_v4i16((__attribute__((address_space(3))) v4i16_t*)p)); }
__device__ __forceinline__ float rowmax(const f32x16&p0,const f32x16&p1){
  float a=max3f(p0[0],p0[1],p1[0]),b=max3f(p0[2],p0[3],p1[1]);a=max3f(a,p1[2],p1[3]);
  #pragma unroll
  for(int r=4;r<16;r+=4){a=max3f(a,p0[r],p0[r+1]);b=max3f(b,p0[r+2],p0[r+3]);a=max3f(a,p1[r],p1[r+1]);b=max3f(b,p1[r+2],p1[r+3]);}
  const float m=max2f(a,b);
  auto rr=__builtin_amdgcn_permlane32_swap(__float_as_uint(m),__float_as_uint(m),false,false);
  return max2f(__uint_as_float(rr[0]),__uint_as_float(rr[1]));
}
__device__ __forceinline__ void pv(f32x16*o,int vb,bf16x8 pa0,bf16x8 pa1,bf16x8 pa2,bf16x8 pa3){
  #pragma unroll
  for(int d0=0;d0<2;++d0){s16x4 lo[4],hi[4];
    #pragma unroll
    for(int ks=0;ks<4;++ks){
      asm volatile("ds_read_b64_tr_b16 %0,%1 offset:%c2":"=&v"(lo[ks]):"v"(vb),"i"(d0*4096+ks*1024):"memory");
      asm volatile("ds_read_b64_tr_b16 %0,%1 offset:%c2":"=&v"(hi[ks]):"v"(vb),"i"(d0*4096+ks*1024+512):"memory");}
    asm volatile("s_waitcnt lgkmcnt(0)":::"memory");SBAR();
    #define PK(k) (bf16x8){lo[k][0],lo[k][1],lo[k][2],lo[k][3],hi[k][0],hi[k][1],hi[k][2],hi[k][3]}
    o[d0]=__builtin_amdgcn_mfma_f32_32x32x16_bf16(pa0,PK(0),o[d0],0,0,0);
    o[d0]=__builtin_amdgcn_mfma_f32_32x32x16_bf16(pa1,PK(1),o[d0],0,0,0);
    o[d0]=__builtin_amdgcn_mfma_f32_32x32x16_bf16(pa2,PK(2),o[d0],0,0,0);
    o[d0]=__builtin_amdgcn_mfma_f32_32x32x16_bf16(pa3,PK(3),o[d0],0,0,0);
    #undef PK
  }
}

#ifndef ATTN_STORE16
#define ATTN_STORE16(p,v) (*(u32x4*)(p)=(v))
#endif
template<int THRL> __device__ __forceinline__ void attn_unit(int b,int h,int qb,const bf16*Q,const bf16*__restrict__ K,const bf16*__restrict__ V,bf16*O,const float*__restrict__ cng,char*shm,const int tid_in){
  const int tid=tid_in,lane=tid&63,r32=lane&31,hi=lane>>5; const int wid=__builtin_amdgcn_readfirstlane(tid>>6);
  const long rowbase=(long)b*SEQ; const int q0=qb*QB;
  typedef __attribute__((address_space(3))) float lds_f32; typedef __attribute__((address_space(3))) const f32x4_t lds_cf4;
  { lds_f32* cl=(lds_f32*)((__attribute__((address_space(3))) char*)shm+LDS_CN); const int ncn=q0+QB;
    for(int i=tid*4;i<ncn;i+=NW*64*4){ const f32x4_t v=*reinterpret_cast<const f32x4_t*>(cng+i); *(__attribute__((address_space(3))) f32x4_t*)(cl+i)=v; } }
  const __attribute__((address_space(3))) char* cnl=(const __attribute__((address_space(3))) char*)shm+LDS_CN+hi*16;
  #define BIAS(P0,P1,t) do{ const __attribute__((address_space(3))) char* cb_=cnl+(t)*256; _Pragma("unroll") for(int g_=0;g_<4;++g_){ { const f32x4_t b0_=*(lds_cf4*)(cb_+g_*32); \
      _Pragma("unroll") for(int j_=0;j_<4;++j_){ P0[4*g_+j_]+=b0_[j_]; } } __builtin_amdgcn_sched_barrier(0); { const f32x4_t b1_=*(lds_cf4*)(cb_+128+g_*32); \
      _Pragma("unroll") for(int j_=0;j_<4;++j_){ P1[4*g_+j_]+=b1_[j_]; } } __builtin_amdgcn_sched_barrier(0); } }while(0)
  const bf16*Qw=Q+(rowbase+q0+wid*QBLK)*DM+h*D;
  const bf16*Kh=K+rowbase*DM+h*D,*Vh=V+rowbase*DM+h*D;
  const unsigned lds0=(unsigned)(uintptr_t)shm;
  float*wsf=(float*)(shm+LDS_WS)+wid*64;
  const bf16*ksrc=Kh+(long)lane*DM+wid*8;
  const bf16*vsrc=Vh+(long)(16*(wid&3)+(lane>>2))*DM+(wid>>2)*32+(lane&3)*8;
  const unsigned kdst=lds0+LDS_K+wid*1024, vdst=lds0+LDS_V+wid*1024;
  #define DMA_K(t,slot) glds16(ksrc+(long)(t)*KVBLK*DM,(unsigned)__builtin_amdgcn_readfirstlane(kdst+(slot)))
  #define DMA_V(t,slot) glds16(vsrc+(long)(t)*KVBLK*DM,(unsigned)__builtin_amdgcn_readfirstlane(vdst+(slot)))
  const int vb0=(int)(lds0+LDS_V)+((lane>>4)&1)*32+(lane&3)*8+(4*hi+((lane&15)>>2))*64;
  const char*Kbase=shm+LDS_K; bf16x8 kf[8];
  const lds_cptr shm3=(lds_cptr)shm; const lds_cptr kp0=shm3+LDS_K+hi*1024+r32*16; const lds_cptr vp0=shm3+LDS_V+((lane>>4)&1)*32+(lane&3)*8+(4*hi+((lane&15)>>2))*64;
  const int NT=(q0+QB)/KVBLK;
  DMA_K(0,0);DMA_V(0,0);DMA_K(1,SLOTB);
  bf16x8 qr[4];
  #pragma unroll
  for(int d0=0;d0<4;++d0)qr[d0]=*reinterpret_cast<const bf16x8*>(&Qw[(long)r32*DM+d0*16+hi*8]);
  const __attribute__((address_space(3))) char* qlp=(const __attribute__((address_space(3))) char*)shm+LDS_OST+wid*4096+lane*16;
  #pragma unroll
  for(int d0=0;d0<4;++d0)*(__attribute__((address_space(3))) bf16x8*)(qlp+d0*1024)=qr[d0];
  #define QLD() do{ _Pragma("unroll") for(int d_=0;d_<4;++d_)qr[d_]=*(const __attribute__((address_space(3))) bf16x8*)(qlp+d_*1024); }while(0)
  float mhat=0.f,l_reg=0.f;f32x16 o[2];o[0]=f32x16{};o[1]=f32x16{};f32x16 negm=f32x16{};asm volatile("":"+v"(negm));
  const int qrel=wid*QBLK+r32;
  #define CMASK(P0,P1,t) do{int jb_=(t)-(NT-4); if(jb_>=0)cmask(P0,P1,jb_,qrel,hi);}while(0)
  bool resc=false;
  #define START(P0,P1) do{ const float rm=rowmax(P0,P1); resc=false; \
    { const float dl=rm; mhat=fadd_s(mhat,dl); \
      _Pragma("unroll") for(int r=0;r<16;++r){P0[r]=fsub_s(P0[r],dl);P1[r]=fsub_s(P1[r],dl);} \
      _Pragma("unroll") for(int r=0;r<16;++r)negm[r]=-mhat; asm volatile("":"+v"(negm)); } \
    _Pragma("unroll") for(int r=0;r<16;++r)P0[r]=__builtin_amdgcn_exp2f(P0[r]); }while(0)
  #define RESC() do{ if(resc){ asm volatile("s_waitcnt lgkmcnt(0)":::"memory"); \
      _Pragma("unroll") for(int d_=0;d_<2;++d_) _Pragma("unroll") for(int r=0;r<16;++r)o[d_][r]*=wsf[crow(r,hi)]; } }while(0)
  f32x16 pA0,pA1,pB0,pB1;
  int sl_prev=0,sl_cur=0,sl_next=SLOTB;
  #define ROT() do{sl_prev=sl_cur;sl_cur=sl_next;sl_next=(sl_next==(NSLOT-1)*SLOTB)?0:sl_next+SLOTB;}while(0)
  DMA_K(2,2*SLOTB);
  WAIT_BAR(3);
  qkt(pA0,pA1,Kbase,qr,negm,r32,hi);asm volatile("s_nop 15\n\ts_nop 7":"+v"(pA0),"+v"(pA1));BIAS(pA0,pA1,0);CMASK(pA0,pA1,0);
  START(pA0,pA1);
  _Pragma("unroll") for(int r=0;r<16;++r)pA1[r]=__builtin_amdgcn_exp2f(pA1[r]);
  WAIT_BAR(0);
  DMA_K(3,0);DMA_V(1,SLOTB);
  ROT();
  kload8(kf,kp0+sl_cur);
  WAIT_BAR(2);
  s16x4 vlo[8],vhi[8]; u32x4 pw0,pw1,pw2,pw3;
  #define PKW(P,B) cvtpk_s(P[B],P[B+1])
  #define PAF(k) __builtin_bit_cast(bf16x8,pw##k)
  #define VFR(i) (bf16x8){vlo[i][0],vlo[i][1],vlo[i][2],vlo[i][3],vhi[i][0],vhi[i][1],vhi[i][2],vhi[i][3]}
  #define PIN(x) asm volatile("":"+v"(x))
  #define MX3(a,b,c) __builtin_fmaxf(__builtin_fmaxf((a),(b)),(c))
  #define GAPA(MF,A0,A1,A2,A3,W0,W1,PW) do{ MF; sacc+=A0; sacc+=A1; sacc+=A2; sacc+=A3; PIN(sacc); W0; W1; PIN(PW); SBAR(); }while(0)
  #define EX(v) __builtin_amdgcn_exp2f(v)
  #define GAPB(MF,X,B) do{ MF; X[B]=EX(X[B]); X[B+1]=EX(X[B+1]); X[B+2]=EX(X[B+2]); X[B+3]=EX(X[B+3]); PIN(X); SBAR(); }while(0)
  #define VRD(i) do{ vlo[i]=vtr(vp_+(((i)>>2)*4096+((i)&3)*1024)); vhi[i]=vtr(vp_+(((i)>>2)*4096+((i)&3)*1024+512)); }while(0)
  #define KRD(G,j) do{ if(G){ kload2(kf,kp0+sl_next,j); SBAR(); } }while(0)
  #define STEP(C0,C1,P0,P1,t,GK,GV,GL) do{ SBAR(); \
    const lds_cptr vp_=vp0+sl_prev; \
    QLD(); VRD(0); SBAR(); float sacc=(P0[0]+P0[1]); \
    GAPA(C0=__builtin_amdgcn_mfma_f32_32x32x16_bf16(kf[0],qr[0],negm,0,0,0), P0[2],P0[3],P0[4],P0[5],     pw0[0]=PKW(P0,0), pw0[1]=PKW(P0,2), pw0); \
    VRD(4); SBAR(); GAPA(C1=__builtin_amdgcn_mfma_f32_32x32x16_bf16(kf[1],qr[0],negm,0,0,0), P0[6],P0[7],P0[8],P0[9],     pw0[2]=PKW(P0,4), pw0[3]=PKW(P0,6), pw0); \
    VRD(1); SBAR(); GAPA(C0=__builtin_amdgcn_mfma_f32_32x32x16_bf16(kf[2],qr[1],C0,0,0,0),   P0[10],P0[11],P0[12],P0[13], pw1[0]=PKW(P0,8), pw1[1]=PKW(P0,10), pw1); \
    VRD(5); SBAR(); GAPA(C1=__builtin_amdgcn_mfma_f32_32x32x16_bf16(kf[3],qr[1],C1,0,0,0),   P0[14],P0[15],P1[0],P1[1],   pw1[2]=PKW(P0,12),pw1[3]=PKW(P0,14), pw1); \
    VRD(2); SBAR(); GAPA(C0=__builtin_amdgcn_mfma_f32_32x32x16_bf16(kf[4],qr[2],C0,0,0,0),   P1[2],P1[3],P1[4],P1[5],     pw2[0]=PKW(P1,0), pw2[1]=PKW(P1,2), pw2); \
    VRD(6); SBAR(); GAPA(C1=__builtin_amdgcn_mfma_f32_32x32x16_bf16(kf[5],qr[2],C1,0,0,0),   P1[6],P1[7],P1[8],P1[9],     pw2[2]=PKW(P1,4), pw2[3]=PKW(P1,6), pw2); \
    VRD(3); SBAR(); GAPA(C0=__builtin_amdgcn_mfma_f32_32x32x16_bf16(kf[6],qr[3],C0,0,0,0),   P1[10],P1[11],P1[12],P1[13], pw3[0]=PKW(P1,8), pw3[1]=PKW(P1,10), pw3); \
    VRD(7); SBAR(); GAPA(C1=__builtin_amdgcn_mfma_f32_32x32x16_bf16(kf[7],qr[3],C1,0,0,0),   P1[14],P1[15],0.f,0.f,       pw3[2]=PKW(P1,12),pw3[3]=PKW(P1,14), pw3); \
    l_reg+=sacc; \
    if(GK){DMA_K((t)+3,sl_cur);} if(GV){DMA_V((t)+1,sl_next);} \
    BIAS(C0,C1,t); CMASK(C0,C1,t); \
    { float a=MX3(C0[0],C0[1],C1[0]),b=MX3(C0[2],C0[3],C1[1]); a=MX3(a,C1[2],C1[3]); \
      _Pragma("unroll") for(int r=4;r<16;r+=4){a=MX3(a,C0[r],C0[r+1]);b=MX3(b,C0[r+2],C0[r+3]);a=MX3(a,C1[r],C1[r+1]);b=MX3(b,C1[r+2],C1[r+3]);} \
      float rm=__builtin_fmaxf(a,b); { auto rr=__builtin_amdgcn_permlane32_swap(__float_as_uint(rm),__float_as_uint(rm),false,false); rm=__builtin_fmaxf(__uint_as_float(rr[0]),__uint_as_float(rr[1])); } \
      resc=false; \
      if(__builtin_expect(__any(rm>(float)THRL),0)){ const float dl=__builtin_fmaxf(rm,0.f); mhat+=dl; \
        _Pragma("unroll") for(int r=0;r<16;++r){C0[r]-=dl;C1[r]-=dl;} \
        _Pragma("unroll") for(int r=0;r<16;++r)negm[r]=-mhat; asm volatile("":"+v"(negm)); \
        const float f=__builtin_amdgcn_exp2f(-dl); l_reg*=f; if(hi==0)wsf[r32]=f; resc=true; } } \
    SBAR(); \
    GAPB(o[0]=__builtin_amdgcn_mfma_f32_32x32x16_bf16(PAF(0),VFR(0),o[0],0,0,0), C0,0); \
    GAPB(o[1]=__builtin_amdgcn_mfma_f32_32x32x16_bf16(PAF(0),VFR(4),o[1],0,0,0), C0,4); \
    KRD(GL,0); GAPB(o[0]=__builtin_amdgcn_mfma_f32_32x32x16_bf16(PAF(1),VFR(1),o[0],0,0,0), C0,8); \
    KRD(GL,1); GAPB(o[1]=__builtin_amdgcn_mfma_f32_32x32x16_bf16(PAF(1),VFR(5),o[1],0,0,0), C0,12); \
    KRD(GL,2); GAPB(o[0]=__builtin_amdgcn_mfma_f32_32x32x16_bf16(PAF(2),VFR(2),o[0],0,0,0), C1,0); \
    KRD(GL,3); GAPB(o[1]=__builtin_amdgcn_mfma_f32_32x32x16_bf16(PAF(2),VFR(6),o[1],0,0,0), C1,4); \
    GAPB(o[0]=__builtin_amdgcn_mfma_f32_32x32x16_bf16(PAF(3),VFR(3),o[0],0,0,0), C1,8); \
    GAPB(o[1]=__builtin_amdgcn_mfma_f32_32x32x16_bf16(PAF(3),VFR(7),o[1],0,0,0), C1,12); \
    }while(0)
  int t=1;
  #undef CMASK
  #define CMASK(P0,P1,t) do{}while(0)
  for(;t+5<NT;t+=2){
    STEP(pB0,pB1,pA0,pA1,t,true,true,true);     WAIT_BAR(2); RESC(); ROT();
    STEP(pA0,pA1,pB0,pB1,t+1,true,true,true);   WAIT_BAR(2); RESC(); ROT();
  }
  #undef CMASK
  #define CMASK(P0,P1,t) do{int jb_=(t)-(NT-4); if(jb_>=0)cmask(P0,P1,jb_,qrel,hi);}while(0)
  #define ENDW(tt) do{ if((tt)+3<NT){WAIT_BAR(2);} else if((tt)+2<NT){WAIT_BAR(1);} else {WAIT_BAR(0);} }while(0)
  for(;t+1<NT;t+=2){
    STEP(pB0,pB1,pA0,pA1,t,(t+3<NT),(t+1<NT),(t+1<NT));       ENDW(t);   RESC(); ROT();
    STEP(pA0,pA1,pB0,pB1,t+1,(t+4<NT),(t+2<NT),(t+2<NT));     ENDW(t+1); RESC(); ROT();
  }
  STEP(pB0,pB1,pA0,pA1,NT-1,false,false,false); RESC();
  { float sacc=pB0[0]+pB0[1]; _Pragma("unroll") for(int r=2;r<16;++r)sacc+=pB0[r]; _Pragma("unroll") for(int r=0;r<16;++r)sacc+=pB1[r]; l_reg+=sacc;
    pw0=(u32x4){PKW(pB0,0),PKW(pB0,2),PKW(pB0,4),PKW(pB0,6)};pw1=(u32x4){PKW(pB0,8),PKW(pB0,10),PKW(pB0,12),PKW(pB0,14)};pw2=(u32x4){PKW(pB1,0),PKW(pB1,2),PKW(pB1,4),PKW(pB1,6)};pw3=(u32x4){PKW(pB1,8),PKW(pB1,10),PKW(pB1,12),PKW(pB1,14)};
    SBAR(); pv(o,vb0+sl_cur,PAF(0),PAF(1),PAF(2),PAF(3)); }
  #undef PKW
  #undef PAF
  #undef VFR
  #undef PIN
  #undef MX3
  #undef GAPA
  #undef GAPB
  #undef EX
  #undef VRD
  #undef KRD
  #undef STEP
  #undef ENDW
  {auto rr=__builtin_amdgcn_permlane32_swap(__float_as_uint(l_reg),__float_as_uint(l_reg),false,false);l_reg=__uint_as_float(rr[0])+__uint_as_float(rr[1]);}
  if(hi==0)wsf[32+r32]=l_reg;asm volatile("s_waitcnt lgkmcnt(0)":::"memory");
  float rli[16];
  #pragma unroll
  for(int r=0;r<16;++r)rli[r]=__builtin_amdgcn_rcpf(wsf[32+crow(r,hi)]);
  bf16*Ow=O+(rowbase+q0+wid*QBLK)*DMO+h*D;
  { bf16*stg=(bf16*)(shm+LDS_OST)+wid*2048;
    #pragma unroll
    for(int r=0;r<16;++r){const int orow=crow(r,hi);
      #pragma unroll
      for(int d0=0;d0<2;++d0)stg[orow*64+d0*32+r32]=__float2bfloat16(o[d0][r]*rli[r]);}
    asm volatile("s_waitcnt lgkmcnt(0)":::"memory");
    #pragma unroll
    for(int i=0;i<4;++i){const int row=i*8+(lane>>3),ch=lane&7; const u32x4 v=*(const u32x4*)(stg+row*64+ch*8); ATTN_STORE16(Ow+(long)row*DMO+ch*8,v);} }
  asm volatile("s_waitcnt lgkmcnt(0)\n\ts_barrier":::"memory");
  #undef BIAS
  #undef QLD
  #undef DMA_K
  #undef DMA_V
  #undef CMASK
  #undef START
  #undef RESC
  #undef ROT
}
constexpr int ATTN_LDS_BYTES=LDS_BYTES;
#undef SBAR
#undef WAIT_BAR
}
#define LAS __attribute__((address_space(3)))
typedef unsigned short bf16;
typedef unsigned v4u __attribute__((ext_vector_type(4)));
typedef unsigned v2u __attribute__((ext_vector_type(2)));
typedef float f32x4 __attribute__((ext_vector_type(4)));
typedef short bf16x8 __attribute__((ext_vector_type(8)));
typedef float f32x16 __attribute__((ext_vector_type(16)));
typedef LAS unsigned char* ldsp;
constexpr int NWAVES = 8;
constexpr int BATCH = 8, SEQ = 8192, D = 1024, M = BATCH * SEQ, NMEM = 256, MM = BATCH * NMEM, FF = 4096;
constexpr int ZW = 3584, NIN = 3840;
constexpr int ZC_MLQ = 0, ZC_MLK = 512, ZC_MLV = 1024, ZC_MLO = 1536, ZC_FXQ = 2048, ZC_FXK = 2560, ZC_FXV = 3072;
constexpr float LOG2E = 1.4426950408889634f;
constexpr float C2_FOX = 0.125f * LOG2E, C2_X = 0.0625f * LOG2E;
constexpr size_t MiB = 1u << 20;
constexpr size_t WS_CTL = 0, CTL_ZERO_BYTES = 4096;
constexpr size_t WS_WIN = 2 * MiB, WS_WOUT = 10 * MiB, WS_WXQ = 12 * MiB, WS_WXKV = 14 * MiB, WS_WXO = 18 * MiB, WS_W1 = 20 * MiB, WS_W2 = 28 * MiB;
constexpr size_t WS_MEMN = 36 * MiB, WS_KX = 40 * MiB, WS_VXT = 44 * MiB, WS_G = 48 * MiB, WS_CNEG = 52 * MiB, WS_SS1 = 54 * MiB, WS_SS2 = 58 * MiB, WS_SS3 = 62 * MiB;
constexpr size_t WS_XN = 72 * MiB, WS_MIX = 200 * MiB, WS_Z = 328 * MiB, WS_U = 328 * MiB, WS_END = 840 * MiB;
constexpr int RING_BYTES = 131072, MISC_OFF = RING_BYTES, LDS_BYTES = 147456;

__device__ __forceinline__ unsigned f2bf(float f) { unsigned u = __builtin_bit_cast(unsigned, f); return (u + 0x7fffu + ((u >> 16) & 1u)) >> 16; }
__device__ __forceinline__ unsigned pk2(float lo, float hi) { return pg8::cvt_pk_bf16(lo, hi); }
__device__ __forceinline__ float bf_lo(unsigned w) { return __uint_as_float(w << 16); }
__device__ __forceinline__ float bf_hi(unsigned w) { return __uint_as_float(w & 0xffff0000u); }
__device__ __forceinline__ float wave_sum(float v) {
#pragma unroll
    for (int o = 1; o < 64; o <<= 1) v += __shfl_xor(v, o);
    return v;
}
__device__ __forceinline__ float logsig(float x) { return fminf(x, 0.f) - log1pf(expf(-fabsf(x))); }
#define LDS_WAIT() asm volatile("s_waitcnt lgkmcnt(0)" ::: "memory")

template <class F> __device__ __forceinline__ void p0_transpose_item(const float* W, int K, int N, int ND, bf16* WT, LAS float* scr, int item, int lane, F srcmap) {
    const int nblk = ND / 32, kb = item / nblk, nb = item % nblk, k0 = 64 * kb, n0 = 32 * nb;
    const int sc = srcmap(n0 + (lane & 31));
#pragma unroll 8
    for (int i = 0; i < 32; ++i) { const int kk = 2 * i + (lane >> 5); scr[kk * 33 + (lane & 31)] = sc >= 0 ? W[(size_t)(k0 + kk) * N + sc] : 0.f; }
    LDS_WAIT(); asm volatile("" ::: "memory");
    const int c = lane & 7;
#pragma unroll
    for (int j = 0; j < 4; ++j) { const int n = (lane >> 3) + 8 * j; const LAS float* s = scr + (8 * c) * 33 + n;
        v4u o; o.x = pk2(s[0 * 33], s[1 * 33]); o.y = pk2(s[2 * 33], s[3 * 33]); o.z = pk2(s[4 * 33], s[5 * 33]); o.w = pk2(s[6 * 33], s[7 * 33]);
        *(v4u*)(WT + (size_t)(n0 + n) * K + k0 + 8 * c) = o; }
    LDS_WAIT(); asm volatile("" ::: "memory");
}
__device__ __forceinline__ void rms_row_to_bf16(const float* xrow, const float* gain, bf16* orow, int lane) {
    const f32x4* xr = (const f32x4*)xrow + lane; const f32x4* gr = (const f32x4*)gain + lane;
    f32x4 v[4]; float s = 0.f;
#pragma unroll
    for (int j = 0; j < 4; ++j) { v[j] = xr[64 * j]; s += (v[j].x * v[j].x + v[j].y * v[j].y) + (v[j].z * v[j].z + v[j].w * v[j].w); }
    const float r = 1.0f / sqrtf(wave_sum(s) * (1.f / 1024.f) + 1e-6f);
    unsigned long long* o8 = (unsigned long long*)orow + lane;
#pragma unroll
    for (int j = 0; j < 4; ++j) { const f32x4 g = gr[64 * j]; o8[64 * j] = (unsigned long long)pk2(v[j].x * r * g.x, v[j].y * r * g.y) | ((unsigned long long)pk2(v[j].z * r * g.z, v[j].w * r * g.w) << 32); }
}
namespace ml {
constexpr int QS = 0, KS = QS + 64 * 272, KWT = KS + 64 * 272, VT = KWT + 128 * 144, PS = VT + 128 * 144, HB = PS + 64 * 144, RSP = HB + 64 * 528, NQ = RSP + 512, NV = NQ + 256, SSQ = NV + 512, CWL = SSQ + 2048, MLN = CWL + 5120, END = MLN + 512;
static_assert(END <= RING_BYTES, "mlstm LDS");
__device__ __forceinline__ float scan_add(float v, int lane) {
#pragma unroll
    for (int o = 1; o < 64; o <<= 1) { const float t = __shfl_up(v, o); if (lane >= o) v += t; }
    return v;
}
__device__ __forceinline__ float scan_max(float v, int lane) {
#pragma unroll
    for (int o = 1; o < 64; o <<= 1) { const float t = __shfl_up(v, o); if (lane >= o) v = fmaxf(v, t); }
    return v;
}
#define MFMA16(a, b, c) __builtin_amdgcn_mfma_f32_16x16x32_bf16(a, b, c, 0, 0, 0)
__device__ __forceinline__ void mlstm_stream(int b, int h, const bf16* __restrict__ Z, const float* __restrict__ G, bf16* __restrict__ MIX,
        const float* __restrict__ conv_w, const float* __restrict__ conv_b, const float* __restrict__ b_i, const float* __restrict__ b_f, const float* __restrict__ ml_norm, ldsp L, const int tid_in) {
    const int tid = tid_in, lane = tid & 63, w = __builtin_amdgcn_readfirstlane(tid >> 6), fr = lane & 15, fq = lane >> 4;
    const int g8 = tid & 15, isK = tid >> 8, tb = (tid >> 4) & 15, sb = tid >> 4;
    const int ch0 = (isK ? 512 : 0) + h * 128 + 8 * g8;
    for (int idx = tid; idx < 1280; idx += 512) { const int which = idx / 640, j = (idx % 640) >> 7, ch = idx & 127;
        *(LAS float*)(L + CWL + idx * 4) = j < 4 ? conv_w[j * 1024 + which * 512 + h * 128 + ch] : conv_b[which * 512 + h * 128 + ch]; }
    if (tid < 128) *(LAS float*)(L + MLN + tid * 4) = ml_norm[h * 128 + tid];
    const int cwo = CWL + (isK * 640 + 8 * g8) * 4;
    const float bi = b_i[h], bfv = b_f[h];
    const int ft = tid >> 3, fe0 = 16 * (tid & 7);
    f32x4 accC[8];
#pragma unroll
    for (int i = 0; i < 8; ++i) accC[i] = (f32x4){0.f, 0.f, 0.f, 0.f};
    if (tid < 128) *(LAS float*)(L + NV + tid * 4) = 0.f;
    float mcar = 0.f;
    v4u rq[7], rv[2], ro[2]; float g_i, g_f;
    const size_t row0 = (size_t)b * SEQ;
    {
#pragma unroll
        for (int i = 0; i < 7; ++i) { const int t = 4 * tb - 3 + i; rq[i] = (t < 0) ? (v4u){0u, 0u, 0u, 0u} : *(const v4u*)(Z + (row0 + t) * ZW + ch0); }
#pragma unroll
        for (int j = 0; j < 2; ++j) rv[j] = *(const v4u*)(Z + (row0 + 2 * sb + j) * ZW + ZC_MLV + h * 128 + 8 * g8);
        g_i = G[(row0 + lane) * 16 + h]; g_f = G[(row0 + lane) * 16 + 4 + h];
    }
    for (int c = 0; c < 128; ++c) {
        const size_t rb = row0 + (size_t)c * 64;
        const float lf = logsig(g_f + bfv), ig = g_i + bi;
        const float bc = scan_add(lf, lane), uu = ig - bc, pm = scan_max(uu, lane);
        const float Mv = fmaxf(mcar, pm);
        const float gl = __shfl(bc, 63), Ml = __shfl(Mv, 63);
        const float wa = __expf(uu - Ml), inter = __expf(mcar - Mv), flo = __expf(-(bc + Mv)), decay = __expf(mcar - Ml);
        mcar = gl + Ml;
        {
            const float ksc = isK ? 0.08838834764831845f : 1.0f;
            const int base = isK ? KS : QS;
            float was[4];
#pragma unroll
            for (int tt = 0; tt < 4; ++tt) was[tt] = __shfl(wa, 4 * tb + tt);
            unsigned kwp[8][2];
#pragma unroll
            for (int tp = 0; tp < 2; ++tp) {
                float y[2][8];
                { const f32x4 c0 = *(const LAS f32x4*)(L + cwo + 4 * 512), c1 = *(const LAS f32x4*)(L + cwo + 4 * 512 + 16);
#pragma unroll
                  for (int t2 = 0; t2 < 2; ++t2) { y[t2][0] = c0[0]; y[t2][1] = c0[1]; y[t2][2] = c0[2]; y[t2][3] = c0[3]; y[t2][4] = c1[0]; y[t2][5] = c1[1]; y[t2][6] = c1[2]; y[t2][7] = c1[3]; } }
#pragma unroll
                for (int j = 0; j < 4; ++j) {
                    const f32x4 c0 = *(const LAS f32x4*)(L + cwo + j * 512), c1 = *(const LAS f32x4*)(L + cwo + j * 512 + 16);
                    const float cwj[8] = {c0[0], c0[1], c0[2], c0[3], c1[0], c1[1], c1[2], c1[3]};
#pragma unroll
                    for (int t2 = 0; t2 < 2; ++t2) { const int r = 2 * tp + t2 + j;
                        const float x[8] = {bf_lo(rq[r].x), bf_hi(rq[r].x), bf_lo(rq[r].y), bf_hi(rq[r].y), bf_lo(rq[r].z), bf_hi(rq[r].z), bf_lo(rq[r].w), bf_hi(rq[r].w)};
#pragma unroll
                        for (int i = 0; i < 8; ++i) y[t2][i] += cwj[i] * x[i]; }
                }
#pragma unroll
                for (int t2 = 0; t2 < 2; ++t2)
#pragma unroll
                    for (int i = 0; i < 8; ++i) { const float a = y[t2][i]; y[t2][i] = a * __builtin_amdgcn_rcpf(1.0f + __expf(-a)) * ksc; }
#pragma unroll
                for (int t2 = 0; t2 < 2; ++t2) { v4u o; o.x = pk2(y[t2][0], y[t2][1]); o.y = pk2(y[t2][2], y[t2][3]); o.z = pk2(y[t2][4], y[t2][5]); o.w = pk2(y[t2][6], y[t2][7]);
                    *(LAS v4u*)(L + base + (4 * tb + 2 * tp + t2) * 272 + 16 * g8) = o; }
#pragma unroll
                for (int i = 0; i < 8; ++i) kwp[i][tp] = pk2(y[0][i] * was[2 * tp], y[1][i] * was[2 * tp + 1]);
            }
            if (isK) {
#pragma unroll
                for (int i = 0; i < 8; ++i) { v2u o; o.x = kwp[i][0]; o.y = kwp[i][1];
                    *(LAS v2u*)(L + KWT + (8 * g8 + i) * 144 + 8 * tb) = o; }
            }
            {
                const unsigned a0[4] = {rv[0].x, rv[0].y, rv[0].z, rv[0].w}, a1[4] = {rv[1].x, rv[1].y, rv[1].z, rv[1].w};
#pragma unroll
                for (int i = 0; i < 4; ++i) {
                    const unsigned lo = (a0[i] & 0xffffu) | (a1[i] << 16), hi = (a0[i] >> 16) | (a1[i] & 0xffff0000u);
                    *(LAS unsigned*)(L + VT + (8 * g8 + 2 * i) * 144 + 4 * sb) = lo;
                    *(LAS unsigned*)(L + VT + (8 * g8 + 2 * i + 1) * 144 + 4 * sb) = hi; }
            }
        }
#pragma unroll
        for (int j = 0; j < 2; ++j) ro[j] = *(const v4u*)(Z + (rb + ft) * ZW + ZC_MLO + h * 128 + fe0 + 8 * j);
        if (c + 1 < 128) {
            const size_t rn = rb + 64;
#pragma unroll
            for (int i = 0; i < 7; ++i) rq[i] = *(const v4u*)(Z + (rn + 4 * tb - 3 + i) * ZW + ch0);
#pragma unroll
            for (int j = 0; j < 2; ++j) rv[j] = *(const v4u*)(Z + (rn + 2 * sb + j) * ZW + ZC_MLV + h * 128 + 8 * g8);
            g_i = G[(rn + lane) * 16 + h]; g_f = G[(rn + lane) * 16 + 4 + h];
        }
        __syncthreads();
        {
            const int tt = w >> 1, half = w & 1, t = 16 * tt + fr; const float Mt = __shfl(Mv, t); float rs = 0.f;
#pragma unroll
            for (int j = 0; j < 2; ++j) { const int st = 2 * half + j; f32x4 a = (f32x4){0.f, 0.f, 0.f, 0.f};
                if (st <= tt) {
#pragma unroll
                    for (int ks = 0; ks < 4; ++ks) { const bf16x8 kf = *(const LAS bf16x8*)(L + KS + (16 * st + fr) * 272 + (32 * ks + 8 * fq) * 2); const bf16x8 qf = *(const LAS bf16x8*)(L + QS + t * 272 + (32 * ks + 8 * fq) * 2); a = MFMA16(kf, qf, a); }
                }
                float p[4];
#pragma unroll
                for (int i = 0; i < 4; ++i) { const int s = 16 * st + 4 * fq + i; const float us = __shfl(uu, s); p[i] = (s <= t) ? a[i] * __expf(us - Mt) : 0.f; rs += p[i]; }
                v2u o; o.x = pk2(p[0], p[1]); o.y = pk2(p[2], p[3]);
                *(LAS v2u*)(L + PS + t * 144 + (16 * st + 4 * fq) * 2) = o; }
            rs += __shfl_xor(rs, 16); rs += __shfl_xor(rs, 32);
            if (fq == 0) *(LAS float*)(L + RSP + (t * 2 + half) * 4) = rs;
        }
        f32x4 acch[4];
        {
            bf16x8 cx[4];
#pragma unroll
            for (int ks = 0; ks < 4; ++ks) { v4u o; o.x = pk2(accC[2 * ks][0], accC[2 * ks][1]); o.y = pk2(accC[2 * ks][2], accC[2 * ks][3]); o.z = pk2(accC[2 * ks + 1][0], accC[2 * ks + 1][1]); o.w = pk2(accC[2 * ks + 1][2], accC[2 * ks + 1][3]);
                cx[ks] = __builtin_bit_cast(bf16x8, o); }
#pragma unroll
            for (int t4 = 0; t4 < 4; ++t4) { acch[t4] = (f32x4){0.f, 0.f, 0.f, 0.f};
#pragma unroll
                for (int ks = 0; ks < 4; ++ks) { const v2u qlo = *(const LAS v2u*)(L + QS + (16 * t4 + fr) * 272 + (32 * ks + 4 * fq) * 2), qhi = *(const LAS v2u*)(L + QS + (16 * t4 + fr) * 272 + (32 * ks + 16 + 4 * fq) * 2);
                    const v4u qq = {qlo.x, qlo.y, qhi.x, qhi.y}; acch[t4] = MFMA16(cx[ks], __builtin_bit_cast(bf16x8, qq), acch[t4]); } }
        }
        {
            const int part = tid & 7; float s = 0.f;
#pragma unroll
            for (int j = 0; j < 2; ++j) { const v4u qv = *(const LAS v4u*)(L + QS + ft * 272 + (16 * part + 8 * j) * 2); const f32x4 n0 = *(const LAS f32x4*)(L + NV + (16 * part + 8 * j) * 4), n1 = *(const LAS f32x4*)(L + NV + (16 * part + 8 * j + 4) * 4);
                s += bf_lo(qv.x) * n0[0] + bf_hi(qv.x) * n0[1] + bf_lo(qv.y) * n0[2] + bf_hi(qv.y) * n0[3] + bf_lo(qv.z) * n1[0] + bf_hi(qv.z) * n1[1] + bf_lo(qv.w) * n1[2] + bf_hi(qv.w) * n1[3]; }
            s += __shfl_xor(s, 1); s += __shfl_xor(s, 2); s += __shfl_xor(s, 4);
            if (part == 0) *(LAS float*)(L + NQ + ft * 4) = s;
        }
        __syncthreads();
        {
            bf16x8 vf[2];
#pragma unroll
            for (int ks = 0; ks < 2; ++ks) vf[ks] = *(const LAS bf16x8*)(L + VT + (16 * w + fr) * 144 + (32 * ks + 8 * fq) * 2);
#pragma unroll
            for (int t4 = 0; t4 < 4; ++t4) { const int t = 16 * t4 + fr; const float it = __shfl(inter, t), fl = __shfl(flo, t);
                acch[t4] = acch[t4] * it;
#pragma unroll
                for (int ks = 0; ks < 2; ++ks) { const bf16x8 pf = *(const LAS bf16x8*)(L + PS + t * 144 + (32 * ks + 8 * fq) * 2); acch[t4] = MFMA16(vf[ks], pf, acch[t4]); }
                const float den = *(const LAS float*)(L + RSP + t * 8) + *(const LAS float*)(L + RSP + t * 8 + 4) + it * *(const LAS float*)(L + NQ + t * 4);
                const float dn = 1.0f / fmaxf(fabsf(den), fl);
                const f32x4 hv = acch[t4] * dn;
                *(LAS f32x4*)(L + HB + t * 528 + (16 * w + 4 * fq) * 4) = hv;
                float sq = (hv[0] * hv[0] + hv[1] * hv[1]) + (hv[2] * hv[2] + hv[3] * hv[3]);
                sq += __shfl_xor(sq, 16); sq += __shfl_xor(sq, 32);
                if (fq == 0) *(LAS float*)(L + SSQ + (t * 8 + w) * 4) = sq; }
#pragma unroll
            for (int dt = 0; dt < 8; ++dt) { accC[dt] = accC[dt] * decay;
#pragma unroll
                for (int ks = 0; ks < 2; ++ks) { const bf16x8 kwf = *(const LAS bf16x8*)(L + KWT + (16 * dt + fr) * 144 + (32 * ks + 8 * fq) * 2); accC[dt] = MFMA16(kwf, vf[ks], accC[dt]); } }
        }
        {
            const int d = tid >> 2, part = tid & 3; float s = 0.f;
#pragma unroll
            for (int j = 0; j < 2; ++j) { const v4u kv = *(const LAS v4u*)(L + KWT + d * 144 + (16 * part + 8 * j) * 2);
                s += (bf_lo(kv.x) + bf_hi(kv.x)) + (bf_lo(kv.y) + bf_hi(kv.y)) + (bf_lo(kv.z) + bf_hi(kv.z)) + (bf_lo(kv.w) + bf_hi(kv.w)); }
            s += __shfl_xor(s, 1); s += __shfl_xor(s, 2);
            if (part == 0) { LAS float* np = (LAS float*)(L + NV + d * 4); *np = decay * *np + s; }
        }
        __syncthreads();
        {
            const f32x4 s0 = *(const LAS f32x4*)(L + SSQ + ft * 32), s1 = *(const LAS f32x4*)(L + SSQ + ft * 32 + 16);
            const float ss = ((s0[0] + s0[1]) + (s0[2] + s0[3])) + ((s1[0] + s1[1]) + (s1[2] + s1[3]));
            const float r = 1.0f / sqrtf(ss * (1.0f / 128.0f) + 1e-6f);
            float ov[16];
#pragma unroll
            for (int j = 0; j < 2; ++j) { ov[8 * j + 0] = bf_lo(ro[j].x); ov[8 * j + 1] = bf_hi(ro[j].x); ov[8 * j + 2] = bf_lo(ro[j].y); ov[8 * j + 3] = bf_hi(ro[j].y); ov[8 * j + 4] = bf_lo(ro[j].z); ov[8 * j + 5] = bf_hi(ro[j].z); ov[8 * j + 6] = bf_lo(ro[j].w); ov[8 * j + 7] = bf_hi(ro[j].w); }
            float res[16];
#pragma unroll
            for (int q4 = 0; q4 < 4; ++q4) { const f32x4 hv = *(const LAS f32x4*)(L + HB + ft * 528 + (fe0 + 4 * q4) * 4);
#pragma unroll
                for (int i = 0; i < 4; ++i) { const int e = 4 * q4 + i; res[e] = hv[i] * r * *(const LAS float*)(L + MLN + (fe0 + e) * 4) * __builtin_amdgcn_rcpf(1.0f + __expf(-ov[e])); } }
#pragma unroll
            for (int j = 0; j < 2; ++j) { v4u o; o.x = pk2(res[8 * j], res[8 * j + 1]); o.y = pk2(res[8 * j + 2], res[8 * j + 3]); o.z = pk2(res[8 * j + 4], res[8 * j + 5]); o.w = pk2(res[8 * j + 6], res[8 * j + 7]);
                *(v4u*)(MIX + (rb + ft) * 1024 + h * 128 + fe0 + 8 * j) = o; }
        }
    }
    __syncthreads();
}
}
namespace xa {
constexpr int BUFB = 36864;
#define MFMA32(a, b, c) __builtin_amdgcn_mfma_f32_32x32x16_bf16(a, b, c, 0, 0, 0)
__device__ __forceinline__ void xattn_unit(int pt, int hx, bf16* __restrict__ QO, const bf16* __restrict__ KX, const bf16* __restrict__ VXT, ldsp L, const int tid_in) {
    const int tid = tid_in, lane = tid & 63, w = __builtin_amdgcn_readfirstlane(tid >> 6), r32 = lane & 31, hi = lane >> 5;
    const int b = pt >> 5;
    bf16* qrow = QO + ((size_t)pt * 256 + w * 32 + r32) * 1024 + hx * 256;
    bf16x8 qf[16];
#pragma unroll
    for (int d0 = 0; d0 < 16; ++d0) qf[d0] = *(const bf16x8*)(qrow + 16 * d0 + 8 * hi);
    const bf16* kbase = KX + (size_t)b * 256 * 1024 + hx * 256;
    const bf16* vbase = VXT + (size_t)hx * 256 * 2048 + b * 256;
    v4u st[4];
#define XA_LOAD(j) do { if ((j) < 8) { _Pragma("unroll") for (int i_ = 0; i_ < 4; ++i_) { const int it_ = tid + 512 * i_, row_ = it_ >> 5, ch_ = it_ & 31; st[i_] = *(const v4u*)(kbase + (size_t)(64 * ((j) & 3) + row_) * 1024 + 8 * ch_); } } \
        else { _Pragma("unroll") for (int i_ = 0; i_ < 2; ++i_) { const int it_ = tid + 512 * i_, row_ = it_ >> 3, ch_ = it_ & 7; st[i_] = *(const v4u*)(vbase + (size_t)(128 * (((j) - 8) >> 2) + row_) * 2048 + 64 * (((j) - 8) & 3) + 8 * ch_); } } } while (0)
#define XA_STORE(j) do { const int bo_ = ((j) & 1) * BUFB; if ((j) < 8) { _Pragma("unroll") for (int i_ = 0; i_ < 4; ++i_) { const int it_ = tid + 512 * i_, row_ = it_ >> 5, ch_ = it_ & 31; *(LAS v4u*)(L + bo_ + row_ * 528 + 16 * ch_) = st[i_]; } } \
        else { _Pragma("unroll") for (int i_ = 0; i_ < 2; ++i_) { const int it_ = tid + 512 * i_, row_ = it_ >> 3, ch_ = it_ & 7; *(LAS v4u*)(L + bo_ + row_ * 144 + 16 * ch_) = st[i_]; } } } while (0)
#define XA_QK(a0, a1, bo) do { a0 = (f32x16){}; a1 = (f32x16){}; _Pragma("unroll") for (int d0 = 0; d0 < 16; ++d0) { \
        const bf16x8 k0_ = *(const LAS bf16x8*)(L + (bo) + r32 * 528 + (16 * d0 + 8 * hi) * 2), k1_ = *(const LAS bf16x8*)(L + (bo) + (32 + r32) * 528 + (16 * d0 + 8 * hi) * 2); \
        a0 = MFMA32(k0_, qf[d0], a0); a1 = MFMA32(k1_, qf[d0], a1); } } while (0)
    XA_LOAD(0); XA_STORE(0);
    __syncthreads();
    float mx = -INFINITY;
#pragma unroll
    for (int j = 0; j < 4; ++j) {
        XA_LOAD(j + 1);
        f32x16 a0, a1; XA_QK(a0, a1, (j & 1) * BUFB);
#pragma unroll
        for (int r = 0; r < 16; ++r) mx = fmaxf(mx, fmaxf(a0[r], a1[r]));
        XA_STORE(j + 1);
        __syncthreads();
    }
    mx = fmaxf(mx, __shfl_xor(mx, 32));
    float l = 0.f;
    v4u pw[4][4];
#pragma unroll
    for (int j = 4; j < 8; ++j) {
        XA_LOAD(j + 1);
        f32x16 a0, a1; XA_QK(a0, a1, (j & 1) * BUFB);
        float p[16], q[16];
#pragma unroll
        for (int r = 0; r < 16; ++r) { p[r] = __builtin_amdgcn_exp2f(a0[r] - mx); q[r] = __builtin_amdgcn_exp2f(a1[r] - mx); l += p[r] + q[r]; }
        pw[j - 4][0] = (v4u){pk2(p[0], p[1]), pk2(p[2], p[3]), pk2(p[4], p[5]), pk2(p[6], p[7])};
        pw[j - 4][1] = (v4u){pk2(p[8], p[9]), pk2(p[10], p[11]), pk2(p[12], p[13]), pk2(p[14], p[15])};
        pw[j - 4][2] = (v4u){pk2(q[0], q[1]), pk2(q[2], q[3]), pk2(q[4], q[5]), pk2(q[6], q[7])};
        pw[j - 4][3] = (v4u){pk2(q[8], q[9]), pk2(q[10], q[11]), pk2(q[12], q[13]), pk2(q[14], q[15])};
        XA_STORE(j + 1);
        __syncthreads();
    }
    l += __shfl_xor(l, 32);
    const float rl = 1.0f / l;
    bf16* obase = QO + ((size_t)pt * 256 + w * 32) * 1024 + hx * 256;
#pragma unroll
    for (int hd = 0; hd < 2; ++hd) {
        f32x16 o[4];
#pragma unroll
        for (int i = 0; i < 4; ++i) o[i] = (f32x16){};
#pragma unroll
        for (int vt = 0; vt < 4; ++vt) {
            const int j = 8 + 4 * hd + vt;
            if (j < 15) XA_LOAD(j + 1);
            const int bo = (j & 1) * BUFB;
#pragma unroll
            for (int db = 0; db < 4; ++db)
#pragma unroll
                for (int j4 = 0; j4 < 4; ++j4) { const v2u lo = *(const LAS v2u*)(L + bo + (32 * db + r32) * 144 + (16 * j4 + 4 * hi) * 2), hh = *(const LAS v2u*)(L + bo + (32 * db + r32) * 144 + (16 * j4 + 8 + 4 * hi) * 2);
                    const v4u vv = {lo.x, lo.y, hh.x, hh.y}; o[db] = MFMA32(__builtin_bit_cast(bf16x8, pw[vt][j4]), __builtin_bit_cast(bf16x8, vv), o[db]); }
            if (j < 15) { XA_STORE(j + 1); }
            __syncthreads();
        }
#pragma unroll
        for (int r = 0; r < 16; ++r) { const int q = (r & 3) + 8 * (r >> 2) + 4 * hi; const float rq = __shfl(rl, q);
#pragma unroll
            for (int db = 0; db < 4; ++db) obase[(size_t)q * 1024 + 128 * hd + 32 * db + r32] = (bf16)f2bf(o[db][r] * rq); }
    }
#undef XA_QK
#undef XA_LOAD
#undef XA_STORE
}
}
struct Args { const float* in[20]; float* out; unsigned char* ws; int ph_lo, ph_hi, coop, pad; };
constexpr int N_PHASES = 11;
__global__ void __launch_bounds__(NWAVES * 64, 2) mk_fwd(Args args) {
    __builtin_assume(__builtin_amdgcn_workitem_id_y() == 0); __builtin_assume(__builtin_amdgcn_workitem_id_z() == 0);
    extern __shared__ __attribute__((aligned(16))) unsigned char lds[];
    const ldsp L = (ldsp)lds;
    volatile LAS unsigned* MISC = (volatile LAS unsigned*)(L + MISC_OFF);
    const int tid = threadIdx.x, lane = tid & 63, wave = __builtin_amdgcn_readfirstlane(tid >> 6);
    const int G = gridDim.x, bid = blockIdx.x;
#define x (args.in[0])
#define mem (args.in[1])
#define ln1 (args.in[2])
#define w_in (args.in[3])
#define conv_w (args.in[4])
#define conv_b (args.in[5])
#define ml_b_i (args.in[6])
#define ml_b_f (args.in[7])
#define ml_norm (args.in[8])
#define fx_b_f (args.in[9])
#define w_out (args.in[10])
#define ln_x (args.in[11])
#define ln_mem (args.in[12])
#define w_xq (args.in[13])
#define w_xkv (args.in[14])
#define w_xo (args.in[15])
#define ln2 (args.in[16])
#define w_ff1 (args.in[17])
#define w_ff2 (args.in[18])
#define ln_f (args.in[19])
    float* const out = args.out;
#define ctl ((unsigned*)(args.ws + WS_CTL))
#define Win_t ((bf16*)(args.ws + WS_WIN))
#define Wout_t ((bf16*)(args.ws + WS_WOUT))
#define Wxq_t ((bf16*)(args.ws + WS_WXQ))
#define Wxkv_t ((bf16*)(args.ws + WS_WXKV))
#define Wxo_t ((bf16*)(args.ws + WS_WXO))
#define W1_t ((bf16*)(args.ws + WS_W1))
#define W2_t ((bf16*)(args.ws + WS_W2))
#define MEMN ((bf16*)(args.ws + WS_MEMN))
#define KX ((bf16*)(args.ws + WS_KX))
#define VXT ((bf16*)(args.ws + WS_VXT))
#define GT ((float*)(args.ws + WS_G))
#define CNEG ((float*)(args.ws + WS_CNEG))
#define SS1 ((float*)(args.ws + WS_SS1))
#define SS2 ((float*)(args.ws + WS_SS2))
#define SS3 ((float*)(args.ws + WS_SS3))
#define XN ((bf16*)(args.ws + WS_XN))
#define MIX ((bf16*)(args.ws + WS_MIX))
#define Zb ((bf16*)(args.ws + WS_Z))
#define Ub ((bf16*)(args.ws + WS_U))
    const int lo = args.ph_lo, hi = args.ph_hi;
#ifndef PH_MASK
#define PH_MASK 0x7ff
#endif
#define IN(k) ((((PH_MASK) >> (k)) & 1) && lo <= (k) && (k) < hi)
#define SEAM(k) do { if (IN(k) && IN((k) + 1)) { cg::this_grid().sync(); } } while (0)

    if (IN(0)) {
        LAS float* scr = (LAS float*)(L + wave * 16384);
        const int gw = bid * NWAVES + wave, NGW = G * NWAVES;
        constexpr int I_IN = 16 * (NIN / 32), I_SQ = 16 * 32, I_KV = 16 * 64, I_1 = 16 * 128, I_2 = 64 * 32;
        constexpr int NITEMS = I_IN + 3 * I_SQ + I_KV + I_1 + I_2;
        auto ident = [](int n) { return n; };
        auto inmap = [](int n) { return n < 2048 ? n : (n < 3584 ? n + 8 : (n < 3592 ? n - 1536 : (n < 3600 ? n : -1))); };
        for (int it = gw; it < NITEMS; it += NGW) {
            int r = it;
            if (r < I_IN) { p0_transpose_item(w_in, 1024, 3600, NIN, Win_t, scr, r, lane, inmap); continue; } r -= I_IN;
            if (r < I_SQ) { p0_transpose_item(w_out, 1024, 1024, 1024, Wout_t, scr, r, lane, ident); continue; } r -= I_SQ;
            if (r < I_SQ) { p0_transpose_item(w_xq, 1024, 1024, 1024, Wxq_t, scr, r, lane, ident); continue; } r -= I_SQ;
            if (r < I_KV) { p0_transpose_item(w_xkv, 1024, 2048, 2048, Wxkv_t, scr, r, lane, ident); continue; } r -= I_KV;
            if (r < I_SQ) { p0_transpose_item(w_xo, 1024, 1024, 1024, Wxo_t, scr, r, lane, ident); continue; } r -= I_SQ;
            if (r < I_1) { p0_transpose_item(w_ff1, 1024, 4096, 4096, W1_t, scr, r, lane, ident); continue; } r -= I_1;
            p0_transpose_item(w_ff2, 4096, 1024, 1024, W2_t, scr, r, lane, ident);
        }
        for (int m = gw; m < M; m += NGW) rms_row_to_bf16(x + (size_t)m * D, ln1, XN + (size_t)m * D, lane);
        for (int m = gw; m < MM; m += NGW) rms_row_to_bf16(mem + (size_t)m * D, ln_mem, MEMN + (size_t)m * D, lane);
        __syncthreads();
    }
    SEAM(0);
    if (IN(1)) {
        pg8::Gemm g{XN, Win_t, M, NIN, D}; pg8::StaticOrder S; S.init(M, NIN, G, bid);
        pg8::EpiZ E{Zb, GT, C2_FOX};
        pg8::gemm_phase<pg8::EpiZ, pg8::StaticOrder, true, true>(L, g, S, E, tid);
    }
    SEAM(1);
    if (IN(2)) {
        if (bid < 64) {
            const int b = bid >> 3, h = bid & 7; const float bfv = fx_b_f[h];
            float v[16]; float run = 0.f;
#pragma unroll
            for (int j = 0; j < 16; ++j) { const int s = 16 * tid + j; run += logsig(GT[((size_t)b * SEQ + s) * 16 + 8 + h] + bfv); v[j] = run; }
            const float inc = ml::scan_add(run, lane);
            LAS float* wt = (LAS float*)(L);
            if (lane == 63) wt[wave] = inc;
            __syncthreads();
            float off = inc - run;
            for (int ww = 0; ww < wave; ++ww) off += wt[ww];
#pragma unroll
            for (int j4 = 0; j4 < 4; ++j4) { f32x4 o;
#pragma unroll
                for (int i = 0; i < 4; ++i) o[i] = -(off + v[4 * j4 + i]) * LOG2E;
                *(f32x4*)(CNEG + (size_t)bid * SEQ + 16 * tid + 4 * j4) = o; }
            __syncthreads();
        } else if (bid < 96) {
            pg8::Gemm g{MEMN, Wxkv_t, MM, 1024, D}; pg8::StaticOrder S; S.init(MM, 1024, 32, bid - 64);
            pg8::EpiPlain E{KX, 1024};
            pg8::gemm_phase<pg8::EpiPlain, pg8::StaticOrder, true, true>(L, g, S, E, tid);
        } else if (bid < 128) {
            pg8::Gemm g{Wxkv_t + (size_t)1024 * 1024, MEMN, 1024, MM, D}; pg8::StaticOrder S; S.init(1024, MM, 32, bid - 96);
            pg8::EpiPlain E{VXT, 2048};
            pg8::gemm_phase<pg8::EpiPlain, pg8::StaticOrder, true, true>(L, g, S, E, tid);
        }
    }
    SEAM(2);
    if (IN(3)) {
#ifndef NO_ML
        if (bid < 32) ml::mlstm_stream(bid >> 2, bid & 3, Zb, GT, MIX, conv_w, conv_b, ml_b_i, ml_b_f, ml_norm, L, tid);
#endif
        for (;;) {
            if (tid == 0) MISC[0] = atomicAdd(ctl + 64, 1u);
            __syncthreads();
            const unsigned u = MISC[0];
            __syncthreads();
            if (u >= 2048u) break;
            const int bh = (int)(u >> 5), qb = 31 - (int)(u & 31); int tq = tid; asm volatile("" : "+v"(tq));
#ifndef NO_FOX
            attn_body::attn_unit<8>(bh >> 3, bh & 7, qb, (const attn_body::bf16*)(Zb + ZC_FXQ), (const attn_body::bf16*)(Zb + ZC_FXK), (const attn_body::bf16*)(Zb + ZC_FXV),
                                    (attn_body::bf16*)(MIX + 512), CNEG + (size_t)bh * SEQ, (char*)lds, tq);
#endif
        }
    }
    SEAM(3);
    if (IN(4)) {
        pg8::Gemm g{MIX, Wout_t, M, D, D}; pg8::StaticOrder S; S.init(M, D, G, bid);
        pg8::EpiRes E{x, out, XN, ln_x, SS1};
        pg8::gemm_phase<pg8::EpiRes, pg8::StaticOrder, true, true>(L, g, S, E, tid);
    }
    SEAM(4);
    if (IN(5)) {
        pg8::Gemm g{XN, Wxq_t, M, D, D}; pg8::StaticOrder S; S.init(M, D, G, bid);
        pg8::EpiRowScale<0> E{MIX, 1024, SS1, C2_X};
        pg8::gemm_phase<pg8::EpiRowScale<0>, pg8::StaticOrder, true, true>(L, g, S, E, tid);
    }
    SEAM(5);
    if (IN(6)) {
#ifndef NO_XA
        for (int u = bid; u < 1024; u += G) xa::xattn_unit(u >> 2, u & 3, MIX, KX, VXT, L, tid);
#endif
    }
    SEAM(6);
    if (IN(7)) {
        pg8::Gemm g{MIX, Wxo_t, M, D, D}; pg8::StaticOrder S; S.init(M, D, G, bid);
        pg8::EpiRes E{out, out, XN, ln2, SS2};
        pg8::gemm_phase<pg8::EpiRes, pg8::StaticOrder, true, true>(L, g, S, E, tid);
    }
    SEAM(7);
    if (IN(8)) {
        pg8::Gemm g{XN, W1_t, M, FF, D}; pg8::StaticOrder S; S.init(M, FF, G, bid);
        pg8::EpiRowScale<1> E{Ub, FF, SS2, 1.0f};
        pg8::gemm_phase<pg8::EpiRowScale<1>, pg8::StaticOrder, true, true>(L, g, S, E, tid);
    }
    SEAM(8);
    if (IN(9)) {
        pg8::Gemm g{Ub, W2_t, M, D, FF}; pg8::StaticOrder S; S.init(M, D, G, bid);
        pg8::EpiRes E{out, out, nullptr, nullptr, SS3};
        pg8::gemm_phase<pg8::EpiRes, pg8::StaticOrder, true, true>(L, g, S, E, tid);
    }
    SEAM(9);
    if (IN(10)) {
        const int gw = bid * NWAVES + wave, NGW = G * NWAVES;
        f32x4 gv[4];
#pragma unroll
        for (int j = 0; j < 4; ++j) gv[j] = ((const f32x4*)ln_f)[lane + 64 * j];
        for (int m = gw; m < M; m += NGW) { const float r = pg8::row_rs(SS3, m); f32x4* p = (f32x4*)(out + (size_t)m * D) + lane;
#pragma unroll
            for (int j = 0; j < 4; ++j) p[64 * j] = p[64 * j] * gv[j] * r; }
    }
#undef IN
#undef SEAM
}
#undef x
#undef mem
#undef ln1
#undef w_in
#undef conv_w
#undef conv_b
#undef ml_b_i
#undef ml_b_f
#undef ml_norm
#undef fx_b_f
#undef w_out
#undef ln_x
#undef ln_mem
#undef w_xq
#undef w_xkv
#undef w_xo
#undef ln2
#undef w_ff1
#undef w_ff2
#undef ln_f
#undef ctl
#undef Win_t
#undef Wout_t
#undef Wxq_t
#undef Wxkv_t
#undef Wxo_t
#undef W1_t
#undef W2_t
#undef MEMN
#undef KX
#undef VXT
#undef GT
#undef CNEG
#undef SS1
#undef SS2
#undef SS3
#undef XN
#undef MIX
#undef Zb
#undef Ub

#ifndef MK_SPLIT
#define MK_SPLIT 0
#endif
extern "C" void kernel_launch(void* const* d_in, const int* in_sizes, int n_in, void* d_out, int out_size, void* d_ws, size_t ws_size, hipStream_t stream) {
    static int grid = 0;
    if (grid == 0) {
        if (n_in != 20 || out_size != M * D || ws_size < WS_END) { fprintf(stderr, "kernel_launch: unexpected problem (n_in %d out %d ws %zu)\n", n_in, out_size, ws_size); grid = -1; return; }
        int dev = 0, cus = 0, per_cu = 0;
        hipGetDevice(&dev); hipDeviceGetAttribute(&cus, hipDeviceAttributeMultiprocessorCount, dev);
        if (hipFuncSetAttribute((const void*)mk_fwd, hipFuncAttributeMaxDynamicSharedMemorySize, LDS_BYTES) != hipSuccess) { fprintf(stderr, "kernel_launch: hipFuncSetAttribute failed\n"); grid = -1; return; }
        if (hipOccupancyMaxActiveBlocksPerMultiprocessor(&per_cu, (const void*)mk_fwd, NWAVES * 64, LDS_BYTES) != hipSuccess || per_cu < 1) { fprintf(stderr, "kernel_launch: occupancy query says %d\n", per_cu); per_cu = 1; }
        (void)hipGetLastError();
        grid = cus;
        if (grid > 256) grid = 256;
    }
    if (grid < 0) return;
    hipMemsetAsync((char*)d_ws + WS_CTL, 0, CTL_ZERO_BYTES, stream);
    Args a{};
    for (int i = 0; i < 20; ++i) a.in[i] = (const float*)d_in[i];
    a.out = (float*)d_out; a.ws = (unsigned char*)d_ws;
#if MK_SPLIT
    for (int p = 0; p < N_PHASES; ++p) { a.ph_lo = p; a.ph_hi = p + 1; a.coop = 0; hipLaunchKernelGGL(mk_fwd, dim3(grid), dim3(NWAVES * 64), LDS_BYTES, stream, a); }
#else
    a.ph_lo = 0; a.ph_hi = N_PHASES; a.coop = 1;
    void* kargs[] = {&a};
    hipError_t e = hipLaunchCooperativeKernel((const void*)mk_fwd, dim3(grid), dim3(NWAVES * 64), kargs, LDS_BYTES, stream);
    if (e != hipSuccess) fprintf(stderr, "cooperative launch failed: %s (grid %d)\n", hipGetErrorString(e), grid);
#endif
}
```

```cpp
#include <hip/hip_runtime.h>
#include <hip/hip_cooperative_groups.h>
#include <hip/hip_bf16.h>
#include <cstdio>
#include <cstdint>
#include <cmath>
namespace cg = cooperative_groups;
namespace pg8 {
#define PG8_LAS __attribute__((address_space(3)))
typedef unsigned short bf16_t;
typedef short bf16x8 __attribute__((ext_vector_type(8)));
typedef float f32x4 __attribute__((ext_vector_type(4)));
typedef unsigned u32x4 __attribute__((ext_vector_type(4)));
constexpr int BM = 256, BK = 64, HALF = 128, HTB = HALF * BK * 2  , STAGE_BYTES = 8 * HTB, NXCD = 8, WGM = 8;

__host__ __device__ __forceinline__ int lds_byte(int r, int c) { const int st = (r >> 4) * 2 + (c >> 5), rr = r & 15, cc = c & 31, ob = rr * 64 + cc * 2; return st * 1024 + (ob ^ (((ob >> 9) & 1) << 5)); }
__host__ __device__ __forceinline__ void stage_rc(int b, int& R, int& C) { const int st = b / 1024, sb = b % 1024, swz = sb ^ (((sb >> 9) & 1) << 5); R = (st >> 1) * 16 + swz / 64; C = (st & 1) * 32 + (swz % 64) / 2; }
__host__ __device__ __forceinline__ int perm32(int rho) { const int n = rho >> 4, i = rho & 15; return 8 * (i >> 2) + 4 * n + (i & 3); }

struct Unit { int pm, pn; };
struct Gemm { const bf16_t* A; const bf16_t* Bt; int M, N, K; };

struct StaticOrder {
    int nM, nN, nwg, G, c;
    __host__ __device__ void init(int M, int N, int G_, int c_) { nM = M / BM; nN = N / BM; nwg = nM * nN; G = G_; c = c_; }
    __host__ __device__ bool next(int i, Unit& u) const {
        const long L = (long)i * G + c; if (L >= nwg) return false;
        int wgid = (int)L; { const int q = nwg / NXCD, r = nwg % NXCD, xcd = wgid % NXCD, off = wgid / NXCD; wgid = (xcd < r ? xcd * (q + 1) : r * (q + 1) + (xcd - r) * q) + off; }
        const int nig = WGM * nN, gid = wgid / nig, fm = gid * WGM, gsz = (nM - fm) < WGM ? (nM - fm) : WGM;
        u.pm = fm + ((wgid % nig) % gsz); u.pn = (wgid % nig) / gsz; return true;
    }
    __device__ __forceinline__ void a_ready(const Unit&) const {}
    __device__ __forceinline__ void done(const Unit&) const {}
};

__device__ __forceinline__ unsigned cvt_pk_bf16(float lo, float hi) { unsigned r; asm volatile("v_cvt_pk_bf16_f32 %0, %1, %2" : "=v"(r) : "v"(lo), "v"(hi)); return r; }
typedef float f32x2 __attribute__((ext_vector_type(2)));
typedef unsigned u32x2 __attribute__((ext_vector_type(2)));
constexpr float RMS_EPS = 1e-6f;
__device__ __forceinline__ float row_rs(const float* ss, int row) {
    const f32x4* p = (const f32x4*)(ss + (size_t)row * 16);
    const f32x4 a = p[0], b = p[1], c = p[2], d = p[3];
    const float s = ((a[0] + a[1]) + (a[2] + a[3])) + ((b[0] + b[1]) + (b[2] + b[3])) + ((c[0] + c[1]) + (c[2] + c[3])) + ((d[0] + d[1]) + (d[2] + d[3]));
    return 1.0f / sqrtf(s * (1.0f / 1024.0f) + RMS_EPS);
}
struct EpiZ {
    static constexpr bool PERM = true, AFTER_DRAIN = false;
    bf16_t* Z; float* G; float c2;
    __device__ __forceinline__ void operator()(const f32x4 (&acc)[2][2][4][2], const Unit& u, int wr, int wc, int fr, int fq) const {
        const int row0 = u.pm * BM + wr * 64 + fr;
        if (u.pn < 14) {
            const float sc = (u.pn == 8 || u.pn == 9) ? c2 : 1.0f;
            const int col0 = u.pn * BM + wc * 32 + 8 * fq;
#pragma unroll
            for (int ai = 0; ai < 2; ++ai)
#pragma unroll
                for (int m = 0; m < 4; ++m) { bf16_t* rowp = Z + (size_t)(row0 + ai * HALF + m * 16) * 3584 + col0;
#pragma unroll
                    for (int bj = 0; bj < 2; ++bj) { const f32x4 v0 = acc[ai][bj][m][0] * sc, v1 = acc[ai][bj][m][1] * sc;
                        u32x4 w; w.x = cvt_pk_bf16(v0[0], v0[1]); w.y = cvt_pk_bf16(v0[2], v0[3]); w.z = cvt_pk_bf16(v1[0], v1[1]); w.w = cvt_pk_bf16(v1[2], v1[3]);
                        __builtin_nontemporal_store(w, (u32x4*)(rowp + bj * HALF)); } }
        } else if (wc == 0 && fq < 2) {
#pragma unroll
            for (int ai = 0; ai < 2; ++ai)
#pragma unroll
                for (int m = 0; m < 4; ++m) { float* gp = G + (size_t)(row0 + ai * HALF + m * 16) * 16 + 8 * fq;
                    *(f32x4*)(gp) = acc[ai][0][m][0]; *(f32x4*)(gp + 4) = acc[ai][0][m][1]; }
        }
    }
};
struct EpiPlain {
    static constexpr bool PERM = true, AFTER_DRAIN = false;
    bf16_t* O; int ldc;
    __device__ __forceinline__ void operator()(const f32x4 (&acc)[2][2][4][2], const Unit& u, int wr, int wc, int fr, int fq) const {
        const int row0 = u.pm * BM + wr * 64 + fr; const int col0 = u.pn * BM + wc * 32 + 8 * fq;
#pragma unroll
        for (int ai = 0; ai < 2; ++ai)
#pragma unroll
            for (int m = 0; m < 4; ++m) { bf16_t* rowp = O + (size_t)(row0 + ai * HALF + m * 16) * ldc + col0;
#pragma unroll
                for (int bj = 0; bj < 2; ++bj) { const f32x4 v0 = acc[ai][bj][m][0], v1 = acc[ai][bj][m][1];
                    u32x4 w; w.x = cvt_pk_bf16(v0[0], v0[1]); w.y = cvt_pk_bf16(v0[2], v0[3]); w.z = cvt_pk_bf16(v1[0], v1[1]); w.w = cvt_pk_bf16(v1[2], v1[3]);
                    *(u32x4*)(rowp + bj * HALF) = w; } }
    }
};
template <int ACT> struct EpiRowScale {
    static constexpr bool PERM = true, AFTER_DRAIN = false;
    bf16_t* O; int ldc; const float* ss; float sc;
    __device__ __forceinline__ void operator()(const f32x4 (&acc)[2][2][4][2], const Unit& u, int wr, int wc, int fr, int fq) const {
        const int row0 = u.pm * BM + wr * 64 + fr; const int col0 = u.pn * BM + wc * 32 + 8 * fq;
#pragma unroll
        for (int ai = 0; ai < 2; ++ai)
#pragma unroll
            for (int m = 0; m < 4; ++m) { const int row = row0 + ai * HALF + m * 16; const float r = row_rs(ss, row) ; bf16_t* rowp = O + (size_t)row * ldc + col0;
#pragma unroll
                for (int bj = 0; bj < 2; ++bj) { f32x4 v0 = acc[ai][bj][m][0] * r, v1 = acc[ai][bj][m][1] * r;
                    if (ACT == 1) {
#pragma unroll
                        for (int e = 0; e < 4; ++e) { const float a = fmaxf(v0[e], 0.f), b = fmaxf(v1[e], 0.f); v0[e] = a * a; v1[e] = b * b; }
                    } else { v0 = v0 * sc; v1 = v1 * sc; }
                    u32x4 w; w.x = cvt_pk_bf16(v0[0], v0[1]); w.y = cvt_pk_bf16(v0[2], v0[3]); w.z = cvt_pk_bf16(v1[0], v1[1]); w.w = cvt_pk_bf16(v1[2], v1[3]);
                    if (ACT == 1) __builtin_nontemporal_store(w, (u32x4*)(rowp + bj * HALF)); else *(u32x4*)(rowp + bj * HALF) = w; } }
    }
};
struct EpiRes {
    static constexpr bool PERM = true, AFTER_DRAIN = false;
    const float* base; float* out; bf16_t* xn; const float* gain; float* ssout;
    __device__ __forceinline__ void operator()(const f32x4 (&acc)[2][2][4][2], const Unit& u, int wr, int wc, int fr, int fq) const {
        const int row0 = u.pm * BM + wr * 64 + fr; const int col0 = u.pn * BM + wc * 32 + 8 * fq;
        f32x4 gv[2][2];
#pragma unroll
        for (int bj = 0; bj < 2; ++bj)
#pragma unroll
            for (int n = 0; n < 2; ++n) { if (xn) gv[bj][n] = *(const f32x4*)(gain + col0 + bj * HALF + n * 4); else gv[bj][n] = (f32x4){1.f, 1.f, 1.f, 1.f}; }
#pragma unroll
        for (int ai = 0; ai < 2; ++ai) {
            f32x4 bs[4][2][2];
#pragma unroll
            for (int m = 0; m < 4; ++m) { const size_t off = (size_t)(row0 + ai * HALF + m * 16) * 1024 + col0;
#pragma unroll
                for (int bj = 0; bj < 2; ++bj) { bs[m][bj][0] = *(const f32x4*)(base + off + bj * HALF); bs[m][bj][1] = *(const f32x4*)(base + off + bj * HALF + 4); } }
#pragma unroll
            for (int m = 0; m < 4; ++m) { const int row = row0 + ai * HALF + m * 16; const size_t off = (size_t)row * 1024 + col0; float sq = 0.f;
#pragma unroll
                for (int bj = 0; bj < 2; ++bj) {
                    const f32x4 o0 = bs[m][bj][0] + acc[ai][bj][m][0], o1 = bs[m][bj][1] + acc[ai][bj][m][1];
                    *(f32x4*)(out + off + bj * HALF) = o0; *(f32x4*)(out + off + bj * HALF + 4) = o1;
                    sq += ((o0[0] * o0[0] + o0[1] * o0[1]) + (o0[2] * o0[2] + o0[3] * o0[3])) + ((o1[0] * o1[0] + o1[1] * o1[1]) + (o1[2] * o1[2] + o1[3] * o1[3]));
                    if (xn) { const f32x4 g0 = o0 * gv[bj][0], g1 = o1 * gv[bj][1]; u32x4 w; w.x = cvt_pk_bf16(g0[0], g0[1]); w.y = cvt_pk_bf16(g0[2], g0[3]); w.z = cvt_pk_bf16(g1[0], g1[1]); w.w = cvt_pk_bf16(g1[2], g1[3]);
                        *(u32x4*)(xn + off + bj * HALF) = w; } }
                sq += __shfl_xor(sq, 16); sq += __shfl_xor(sq, 32);
                if (fq == 0) ssout[(size_t)row * 16 + u.pn * 4 + wc] = sq; }
            asm volatile("" ::: "memory"); }
    }
};
struct EpiResNorm {
    static constexpr bool PERM = true, AFTER_DRAIN = false;
    const float* base; float* out; const float* gain; float* ss; unsigned* cnt;
    __device__ __forceinline__ void operator()(const f32x4 (&acc_c)[2][2][4][2], const Unit& u, int wr, int wc, int fr, int fq) const {
        f32x4 (&acc)[2][2][4][2] = const_cast<f32x4 (&)[2][2][4][2]>(acc_c);
        const int row0 = u.pm * BM + wr * 64 + fr; const int col0 = u.pn * BM + wc * 32 + 8 * fq;
#pragma unroll
        for (int ai = 0; ai < 2; ++ai)
#pragma unroll
            for (int m = 0; m < 4; ++m) { const int row = row0 + ai * HALF + m * 16; const size_t off = (size_t)row * 1024 + col0; float sq = 0.f;
#pragma unroll
                for (int bj = 0; bj < 2; ++bj) {
                    const f32x4 b0 = *(const f32x4*)(base + off + bj * HALF), b1 = *(const f32x4*)(base + off + bj * HALF + 4);
                    const f32x4 o0 = b0 + acc[ai][bj][m][0], o1 = b1 + acc[ai][bj][m][1];
                    acc[ai][bj][m][0] = o0; acc[ai][bj][m][1] = o1;
                    sq += ((o0[0] * o0[0] + o0[1] * o0[1]) + (o0[2] * o0[2] + o0[3] * o0[3])) + ((o1[0] * o1[0] + o1[1] * o1[1]) + (o1[2] * o1[2] + o1[3] * o1[3])); }
                sq += __shfl_xor(sq, 16); sq += __shfl_xor(sq, 32);
                if (fq == 0) __hip_atomic_store(ss + (size_t)row * 16 + u.pn * 4 + wc, sq, __ATOMIC_RELAXED, __HIP_MEMORY_SCOPE_AGENT);
                if (m == 3) asm volatile("" ::: "memory"); }
        asm volatile("s_waitcnt vmcnt(0)" ::: "memory");
        unsigned* c = cnt + 64 * u.pm;
        if ((fr | fq) == 0) __hip_atomic_fetch_add(c, 1u, __ATOMIC_RELAXED, __HIP_MEMORY_SCOPE_AGENT);
        { unsigned spins = 0;
          while ((unsigned)__builtin_amdgcn_readfirstlane(__hip_atomic_load(c, __ATOMIC_RELAXED, __HIP_MEMORY_SCOPE_AGENT)) < 32u) { __builtin_amdgcn_s_sleep(2); if (++spins > (1u << 22)) break; } }
        asm volatile("" ::: "memory");
        f32x4 gv[2][2];
#pragma unroll
        for (int bj = 0; bj < 2; ++bj)
#pragma unroll
            for (int n = 0; n < 2; ++n) gv[bj][n] = *(const f32x4*)(gain + col0 + bj * HALF + n * 4);
#pragma unroll
        for (int ai = 0; ai < 2; ++ai)
#pragma unroll
            for (int m = 0; m < 4; ++m) { const int row = row0 + ai * HALF + m * 16; const size_t off = (size_t)row * 1024 + col0;
                const unsigned long long* sp = (const unsigned long long*)(ss + (size_t)row * 16); float tot = 0.f;
#pragma unroll
                for (int k = 0; k < 8; ++k) { const unsigned long long v = __hip_atomic_load(sp + k, __ATOMIC_RELAXED, __HIP_MEMORY_SCOPE_AGENT); tot += __uint_as_float((unsigned)v) + __uint_as_float((unsigned)(v >> 32)); }
                const float r = 1.0f / sqrtf(tot * (1.0f / 1024.0f) + RMS_EPS);
#pragma unroll
                for (int bj = 0; bj < 2; ++bj) { *(f32x4*)(out + off + bj * HALF) = acc[ai][bj][m][0] * gv[bj][0] * r; *(f32x4*)(out + off + bj * HALF + 4) = acc[ai][bj][m][1] * gv[bj][1] * r; }
                asm volatile("" ::: "memory"); }
    }
};
template <class Epi, class Sched, bool ALIGN_EPI = false, bool SP2 = false>
__device__ __forceinline__ void gemm_phase(PG8_LAS unsigned char* lds, const Gemm g, const Sched& S, const Epi& E, const int tid_in) {
    const int tid = tid_in, wid = __builtin_amdgcn_readfirstlane(tid >> 6), lane = tid & 63, wr = wid >> 2, wc = wid & 3, fr = lane & 15, fq = lane >> 4;
    const int K = g.K, nt = K / BK;
    unsigned voffA[2], voffB[2];
#pragma unroll
    for (int i = 0; i < 2; ++i) { int R, C; stage_rc(tid * 16 + i * 8192, R, C); const int Rb = Epi::PERM ? ((R & ~31) + perm32(R & 31)) : R;
        voffA[i] = (unsigned)(R * K + C) * 2u; voffB[i] = (unsigned)(Rb * K + C) * 2u; }
    const size_t kstep = (size_t)(BK * 2);
    const size_t hstep = (size_t)HALF * K * 2;
    const size_t tstep = 2 * hstep;
    const unsigned ldsw = (unsigned)wid * 1024u;
    const int aoff = lds_byte(wr * 64 + fr, fq * 8), boff = lds_byte(wc * 32 + fr, fq * 8);
#define PG8_SA(b, h) (((b) * 2 + (h)) * HTB)
#define PG8_SB(b, h) ((4 + (b) * 2 + (h)) * HTB)
#define PG8_STAGE(bufoff, gbase, voff) do { _Pragma("unroll") for (int _i = 0; _i < 2; ++_i) \
        __builtin_amdgcn_global_load_lds((const unsigned*)((const char*)(gbase) + (voff)[_i]), (PG8_LAS unsigned*)(lds + (bufoff) + ldsw + _i * 8192), 16, 0, 0); } while (0)
#define PG8_LDA(dst, b, h) do { _Pragma("unroll") for (int m = 0; m < 4; ++m) _Pragma("unroll") for (int k = 0; k < 2; ++k) dst[m][k] = *(const PG8_LAS bf16x8*)(lds + PG8_SA(b, h) + aoff + m * 2048 + k * 1024); } while (0)
#define PG8_LDB(dst, b, h) do { _Pragma("unroll") for (int n = 0; n < 2; ++n) _Pragma("unroll") for (int k = 0; k < 2; ++k) dst[n][k] = *(const PG8_LAS bf16x8*)(lds + PG8_SB(b, h) + boff + n * 2048 + k * 1024); } while (0)
#define PG8_MMA(ai, bj, At, Bt) do { __builtin_amdgcn_s_setprio(1); _Pragma("unroll") for (int m = 0; m < 4; ++m) _Pragma("unroll") for (int n = 0; n < 2; ++n) _Pragma("unroll") for (int k = 0; k < 2; ++k) \
        acc[ai][bj][m][n] = __builtin_amdgcn_mfma_f32_16x16x32_bf16(Bt[n][k], At[m][k], acc[ai][bj][m][n], 0, 0, 0); __builtin_amdgcn_s_setprio(0); } while (0)
#define PG8_WAIT_V(n) asm volatile("s_waitcnt vmcnt(" #n ")" ::: "memory")
#define PG8_WAIT_L(n) asm volatile("s_waitcnt lgkmcnt(" #n ")" ::: "memory")
#define PG8_BAR __builtin_amdgcn_s_barrier()
#define PG8_SCHED __builtin_amdgcn_sched_barrier(0)
    Unit cur, nxt; int ui = 0;
    if (!S.next(0, cur)) return;
    f32x4 acc[2][2][4][2];
#pragma unroll
    for (int a = 0; a < 2; ++a)
#pragma unroll
        for (int b = 0; b < 2; ++b)
#pragma unroll
            for (int m = 0; m < 4; ++m)
#pragma unroll
                for (int n = 0; n < 2; ++n) acc[a][b][m][n] = (f32x4){0.f, 0.f, 0.f, 0.f};
    bf16x8 At[4][2], B0[2][2], B1[2][2];
    const char* cA = (const char*)g.A + (size_t)cur.pm * tstep; const char* cB = (const char*)g.Bt + (size_t)cur.pn * tstep;
    S.a_ready(cur);
    if constexpr (SP2) {
        PG8_STAGE(PG8_SB(0, 0), cB, voffB); PG8_STAGE(PG8_SB(0, 1), cB + hstep, voffB); PG8_STAGE(PG8_SA(0, 0), cA, voffA); PG8_STAGE(PG8_SA(0, 1), cA + hstep, voffA);
        if (wr == 1) PG8_BAR;
        PG8_WAIT_V(2); PG8_BAR;
        PG8_STAGE(PG8_SB(1, 0), cB + kstep, voffB); PG8_STAGE(PG8_SA(1, 0), cA + kstep, voffA); PG8_STAGE(PG8_SB(1, 1), cB + hstep + kstep, voffB);
        PG8_WAIT_V(6); PG8_BAR;
    } else {
        PG8_STAGE(PG8_SB(0, 0), cB, voffB); PG8_STAGE(PG8_SA(0, 0), cA, voffA); PG8_STAGE(PG8_SB(0, 1), cB + hstep, voffB); PG8_STAGE(PG8_SA(0, 1), cA + hstep, voffA);
        if (wr == 1) PG8_BAR;
        PG8_WAIT_V(4); PG8_BAR;
        PG8_STAGE(PG8_SB(1, 0), cB + kstep, voffB); PG8_STAGE(PG8_SA(1, 0), cA + kstep, voffA); PG8_STAGE(PG8_SB(1, 1), cB + hstep + kstep, voffB);
        PG8_WAIT_V(6); PG8_BAR;
    }
    for (;;) {
        const bool has_next = S.next(ui + 1, nxt);
        const char* nA = has_next ? (const char*)g.A + (size_t)nxt.pm * tstep : cA; const char* nB = has_next ? (const char*)g.Bt + (size_t)nxt.pn * tstep : cB;
        for (int t = 0; t < nt; t += 2) {
            const bool last = (t == nt - 2);
            const char* a1 = cA + (size_t)(t + 1) * kstep;
            const char* a2 = last ? nA : cA + (size_t)(t + 2) * kstep; const char* b2 = last ? nB : cB + (size_t)(t + 2) * kstep;
            const char* a3 = a2 + kstep; const char* b3 = b2 + kstep;
            if (last && has_next) S.a_ready(nxt);
            if constexpr (SP2) {
            PG8_LDB(B0, 0, 0); PG8_LDB(B1, 0, 1); PG8_SCHED; PG8_LDA(At, 0, 0); PG8_STAGE(PG8_SA(1, 1), a1 + hstep, voffA);
            PG8_WAIT_V(8); PG8_WAIT_L(0); PG8_BAR; PG8_MMA(0, 0, At, B0); PG8_MMA(0, 1, At, B1); PG8_BAR; PG8_SCHED;
            PG8_LDA(At, 0, 1); PG8_STAGE(PG8_SB(0, 0), b2, voffB); PG8_STAGE(PG8_SB(0, 1), b2 + hstep, voffB); PG8_STAGE(PG8_SA(0, 0), a2, voffA);
            PG8_WAIT_V(8); PG8_WAIT_L(0); PG8_BAR; PG8_MMA(1, 0, At, B0); PG8_MMA(1, 1, At, B1); PG8_BAR; PG8_SCHED;
            PG8_LDB(B0, 1, 0); PG8_LDB(B1, 1, 1); PG8_SCHED; PG8_LDA(At, 1, 0); PG8_STAGE(PG8_SA(0, 1), a2 + hstep, voffA);
            PG8_WAIT_V(8); PG8_WAIT_L(0); PG8_BAR; PG8_MMA(0, 0, At, B0); PG8_MMA(0, 1, At, B1); PG8_BAR; PG8_SCHED;
            PG8_LDA(At, 1, 1); PG8_STAGE(PG8_SB(1, 0), b3, voffB); PG8_STAGE(PG8_SB(1, 1), b3 + hstep, voffB); PG8_STAGE(PG8_SA(1, 0), a3, voffA);
            PG8_WAIT_V(8); PG8_WAIT_L(0); PG8_BAR; PG8_MMA(1, 0, At, B0); PG8_MMA(1, 1, At, B1); PG8_BAR; PG8_SCHED;
            } else {
            PG8_LDB(B0, 0, 0); PG8_SCHED; PG8_LDA(At, 0, 0); PG8_STAGE(PG8_SA(1, 1), a1 + hstep, voffA);
            PG8_WAIT_L(8); PG8_BAR; PG8_WAIT_L(0); PG8_MMA(0, 0, At, B0); PG8_BAR; PG8_SCHED;
            PG8_LDB(B1, 0, 1); PG8_STAGE(PG8_SB(0, 0), b2, voffB);
            PG8_BAR; PG8_WAIT_L(0); PG8_MMA(0, 1, At, B1); PG8_BAR;
            PG8_LDA(At, 0, 1); PG8_STAGE(PG8_SA(0, 0), a2, voffA);
            PG8_BAR; PG8_WAIT_L(0); PG8_MMA(1, 0, At, B0); PG8_BAR; PG8_SCHED;
            PG8_STAGE(PG8_SB(0, 1), b2 + hstep, voffB);
            PG8_WAIT_V(6); PG8_BAR; PG8_MMA(1, 1, At, B1); PG8_BAR;
            PG8_LDB(B0, 1, 0); PG8_SCHED; PG8_LDA(At, 1, 0); PG8_STAGE(PG8_SA(0, 1), a2 + hstep, voffA);
            PG8_WAIT_L(8); PG8_BAR; PG8_WAIT_L(0); PG8_MMA(0, 0, At, B0); PG8_BAR; PG8_SCHED;
            PG8_LDB(B1, 1, 1); PG8_STAGE(PG8_SB(1, 0), b3, voffB);
            PG8_BAR; PG8_WAIT_L(0); PG8_MMA(0, 1, At, B1); PG8_BAR;
            PG8_LDA(At, 1, 1); PG8_STAGE(PG8_SA(1, 0), a3, voffA);
            PG8_BAR; PG8_WAIT_L(0); PG8_MMA(1, 0, At, B0); PG8_BAR; PG8_SCHED;
            PG8_STAGE(PG8_SB(1, 1), b3 + hstep, voffB);
            PG8_WAIT_V(6); PG8_BAR; PG8_MMA(1, 1, At, B1); PG8_BAR;
            }
        }
        if constexpr (ALIGN_EPI) { if (wr == 0) PG8_BAR; }
        if constexpr (!Epi::AFTER_DRAIN) { E(acc, cur, wr, wc, fr, fq); S.done(cur); }
        if (!has_next) break;
#pragma unroll
        for (int a = 0; a < 2; ++a)
#pragma unroll
            for (int b = 0; b < 2; ++b)
#pragma unroll
                for (int m = 0; m < 4; ++m)
#pragma unroll
                    for (int n = 0; n < 2; ++n) acc[a][b][m][n] = (f32x4){0.f, 0.f, 0.f, 0.f};
        cur = nxt; cA = nA; cB = nB; ++ui;
        if constexpr (ALIGN_EPI) { if (wr == 1) PG8_BAR; }
    }
    PG8_WAIT_V(0);
    if constexpr (!ALIGN_EPI) { if (wr == 0) PG8_BAR; }
    PG8_BAR;
    if constexpr (Epi::AFTER_DRAIN) { E.fused(acc, cur, wr, wc, fr, fq, lds, wid, lane); S.done(cur); }
#undef PG8_SA
#undef PG8_SB
#undef PG8_STAGE
#undef PG8_LDA
#undef PG8_LDB
#undef PG8_MMA
#undef PG8_WAIT_V
#undef PG8_WAIT_L
#undef PG8_BAR
#undef PG8_SCHED
}
}
#include <hip/hip_bf16.h>
#include <cmath>
namespace attn_body {
using bf16=__hip_bfloat16;
using bf16x8=__attribute__((ext_vector_type(8)))short;
using s16x4=__attribute__((ext_vector_type(4)))short;
using f32x16=__attribute__((ext_vector_type(16)))float;
using u32x4=__attribute__((ext_vector_type(4)))unsigned;
using f32x4_t=__attribute__((ext_vector_type(4)))float;
constexpr int BATCH=8,NHEAD=8,SEQ=8192,D=64,DM=3584,DMO=1024;
constexpr int NW=8,QBLK=32,QB=QBLK*NW,KVBLK=64,NQB=SEQ/QB;
constexpr int ATTN_PITCH=DM, ATTN_UNIT_ROWS=QB;
__device__ __forceinline__ int crow(int r,int hi){return (r&3)+8*(r>>2)+4*hi;}
#define SBAR() __builtin_amdgcn_sched_barrier(0)
__device__ __forceinline__ void cmask(f32x16&p0,f32x16&p1,int jb,int qrel,int hi){
  const float NEG=-INFINITY; int dq=qrel-64*jb-4*hi; asm volatile("":"+v"(dq));
  #pragma unroll
  for(int r=0;r<16;++r){const int c=(r&3)+8*(r>>2); if(c>dq)p0[r]=NEG; if(c+32>dq)p1[r]=NEG;}
}

constexpr int NSLOT=3, SLOTB=8192;
constexpr int LDS_K=0, LDS_V=NSLOT*SLOTB, LDS_WS=2*NSLOT*SLOTB, LDS_OST=LDS_WS+NW*64*4, LDS_CN=LDS_OST+NW*4096, LDS_BYTES=LDS_CN+SEQ*4;
constexpr float C2=0.125f*1.4426950408889634f;
__device__ __forceinline__ void glds16(const void*gsrc,unsigned lds_dst){unsigned keep;
  asm volatile("s_mov_b32 %0, m0\n\ts_mov_b32 m0, %2\n\ts_nop 0\n\tglobal_load_lds_dwordx4 %1, off\n\ts_mov_b32 m0, %0":"=&s"(keep):"v"(gsrc),"s"(lds_dst):"memory");}
__device__ __forceinline__ float max3f(float a,float b,float c){float r;asm("v_max3_f32 %0, %1, %2, %3":"=v"(r):"v"(a),"v"(b),"v"(c));return r;}
__device__ __forceinline__ float max2f(float a,float b){float r;asm("v_max_f32_e32 %0, %1, %2":"=v"(r):"v"(a),"v"(b));return r;}
__device__ __forceinline__ float fadd_s(float a,float b){float r;asm("v_add_f32_e32 %0, %1, %2":"=v"(r):"v"(a),"v"(b));return r;}
__device__ __forceinline__ float fsub_s(float a,float b){float r;asm("v_sub_f32_e32 %0, %1, %2":"=v"(r):"v"(a),"v"(b));return r;}
typedef float f32x2_t __attribute__((ext_vector_type(2))); typedef __bf16 bf16x2_t __attribute__((ext_vector_type(2)));
__device__ __forceinline__ unsigned cvtpk_s(float lo,float hi){f32x2_t v={lo,hi};bf16x2_t b=__builtin_convertvector(v,bf16x2_t);return __builtin_bit_cast(unsigned,b);}
#define WAIT_BAR(N) asm volatile("s_waitcnt vmcnt(" #N ") lgkmcnt(0)\n\ts_barrier":::"memory")

__device__ __forceinline__ void qkt(f32x16&p0,f32x16&p1,const char*Kslot,const bf16x8*qr,int r32,int hi){
  const char*kb=Kslot+hi*1024+r32*16;
  #pragma unroll
  for(int d0=0;d0<4;++d0){
    const bf16x8 b0=*reinterpret_cast<const bf16x8*>(kb+d0*2048);
    const bf16x8 b1=*reinterpret_cast<const bf16x8*>(kb+d0*2048+512);
    {p0=__builtin_amdgcn_mfma_f32_32x32x16_bf16(b0,qr[d0],p0,0,0,0);p1=__builtin_amdgcn_mfma_f32_32x32x16_bf16(b1,qr[d0],p1,0,0,0);}}
}
typedef __attribute__((address_space(3))) const char* lds_cptr;
typedef short v4i16_t __attribute__((ext_vector_type(4)));
__device__ __forceinline__ void kload8(bf16x8*kf,lds_cptr kp){
  kf[0]=*(const __attribute__((address_space(3))) bf16x8*)(kp);      kf[1]=*(const __attribute__((address_space(3))) bf16x8*)(kp+512);
  kf[2]=*(const __attribute__((address_space(3))) bf16x8*)(kp+2048); kf[3]=*(const __attribute__((address_space(3))) bf16x8*)(kp+2560);
  kf[4]=*(const __attribute__((address_space(3))) bf16x8*)(kp+4096); kf[5]=*(const __attribute__((address_space(3))) bf16x8*)(kp+4608);
  kf[6]=*(const __attribute__((address_space(3))) bf16x8*)(kp+6144); kf[7]=*(const __attribute__((address_space(3))) bf16x8*)(kp+6656);
}
__device__ __forceinline__ void kload2(bf16x8*kf,lds_cptr kp,int j){ kf[2*j]=*(const __attribute__((address_space(3))) bf16x8*)(kp+j*2048); kf[2*j+1]=*(const __attribute__((address_space(3))) bf16x8*)(kp+j*2048+512); }
__device__ __forceinline__ s16x4 vtr(lds_cptr p){ return __builtin_bit_cast(s16x4,__builtin_amdgcn_ds_read_tr16_b64_v4i16((__attribute__((address_space(3))) v4i16_t*)p)); }
__device__ __forceinline__ float rowmax(const f32x16&p0,const f32x16&p1){
  float a=max3f(p0[0],p0[1],p1[0]),b=max3f(p0[2],p0[3],p1[1]);a=max3f(a,p1[2],p1[3]);
  #pragma unroll
  for(int r=4;r<16;r+=4){a=max3f(a,p0[r],p0[r+1]);b=max3f(b,p0[r+2],p0[r+3]);a=max3f(a,p1[r],p1[r+1]);b=max3f(b,p1[r+2],p1[r+3]);}
  const float m=max2f(a,b);
  auto rr=__builtin_amdgcn_permlane32_swap(__float_as_uint(m),__float_as_uint(m),false,false);
  return max2f(__uint_as_float(rr[0]),__uint_as_float(rr[1]));
}
__device__ __forceinline__ void pv(f32x16*o,int vb,bf16x8 pa0,bf16x8 pa1,bf16x8 pa2,bf16x8 pa3){
  #pragma unroll
  for(int d0=0;d0<2;++d0){s16x4 lo[4],hi[4];
    #pragma unroll
    for(int ks=0;ks<4;++ks){
      asm volatile("ds_read_b64_tr_b16 %0,%1 offset:%c2":"=&v"(lo[ks]):"v"(vb),"i"(d0*4096+ks*1024):"memory");
      asm volatile("ds_read_b64_tr_b16 %0,%1 offset:%c2":"=&v"(hi[ks]):"v"(vb),"i"(d0*4096+ks*1024+512):"memory");}
    asm volatile("s_waitcnt lgkmcnt(0)":::"memory");SBAR();
    #define PK(k) (bf16x8){lo[k][0],lo[k][1],lo[k][2],lo[k][3],hi[k][0],hi[k][1],hi[k][2],hi[k][3]}
    o[d0]=__builtin_amdgcn_mfma_f32_32x32x16_bf16(pa0,PK(0),o[d0],0,0,0);
    o[d0]=__builtin_amdgcn_mfma_f32_32x32x16_bf16(pa1,PK(1),o[d0],0,0,0);
    o[d0]=__builtin_amdgcn_mfma_f32_32x32x16_bf16(pa2,PK(2),o[d0],0,0,0);
    o[d0]=__builtin_amdgcn_mfma_f32_32x32x16_bf16(pa3,PK(3),o[d0],0,0,0);
    #undef PK
  }
}

#ifndef ATTN_STORE16
#define ATTN_STORE16(p,v) (*(u32x4*)(p)=(v))
#endif
template<int THRL> __device__ __forceinline__ void attn_unit(int b,int h,int qb,const bf16*Q,const bf16*__restrict__ K,const bf16*__restrict__ V,bf16*O,const float*__restrict__ cng,char*shm,const int tid_in){
  const int tid=tid_in,lane=tid&63,r32=lane&31,hi=lane>>5; const int wid=__builtin_amdgcn_readfirstlane(tid>>6);
  const long rowbase=(long)b*SEQ; const int q0=qb*QB;
  typedef __attribute__((address_space(3))) float lds_f32; typedef __attribute__((address_space(3))) const f32x4_t lds_cf4;
  { lds_f32* cl=(lds_f32*)((__attribute__((address_space(3))) char*)shm+LDS_CN); const int ncn=q0+QB;
    for(int i=tid*4;i<ncn;i+=NW*64*4){ const f32x4_t v=*reinterpret_cast<const f32x4_t*>(cng+i); *(__attribute__((address_space(3))) f32x4_t*)(cl+i)=v; } }
  const __attribute__((address_space(3))) char* cnr=(const __attribute__((address_space(3))) char*)shm+LDS_CN+r32*4;
  #define BFRAG(F,x_) do{ const unsigned xb_=__float_as_uint(x_), xh_=xb_&0xffff0000u; const float r1_=(x_)-__uint_as_float(xh_); const unsigned mb_=__float_as_uint(r1_)&0xffff0000u; \
      const float r2_=r1_-__uint_as_float(mb_); u32x4 w_; w_.x=hi?0u:((xh_>>16)|mb_); w_.y=hi?0u:((__float_as_uint(r2_)>>16)|0x3f800000u); w_.z=hi?0u:0x3f803f80u; w_.w=0u; F=__builtin_bit_cast(bf16x8,w_); }while(0)
  #define BFR(t) do{ const float c0_=*(const __attribute__((address_space(3))) float*)(cnr+(t)*256), c1_=*(const __attribute__((address_space(3))) float*)(cnr+(t)*256+128); BFRAG(bfa,c0_); BFRAG(bfb,c1_); }while(0)
  #define MFRAG_SET() do{ const float x_=-mhat; const unsigned xb_=__float_as_uint(x_), xh_=xb_&0xffff0000u; const float r1_=x_-__uint_as_float(xh_); const unsigned mb_=__float_as_uint(r1_)&0xffff0000u; \
      const float r2_=r1_-__uint_as_float(mb_); u32x4 w_; w_.x=0x3f803f80u; w_.y=0x3f80u|xh_; w_.z=(mb_>>16)|(__float_as_uint(r2_)&0xffff0000u); w_.w=0u; mfrag=__builtin_bit_cast(bf16x8,w_); asm volatile("":"+v"(mfrag)); }while(0)
  const bf16*Qw=Q+(rowbase+q0+wid*QBLK)*DM+h*D;
  const bf16*Kh=K+rowbase*DM+h*D,*Vh=V+rowbase*DM+h*D;
  const unsigned lds0=(unsigned)(uintptr_t)shm;
  float*wsf=(float*)(shm+LDS_WS)+wid*64;
  const bf16*ksrc=Kh+(long)lane*DM+wid*8;
  const bf16*vsrc=Vh+(long)(16*(wid&3)+(lane>>2))*DM+(wid>>2)*32+(lane&3)*8;
  const unsigned kdst=lds0+LDS_K+wid*1024, vdst=lds0+LDS_V+wid*1024;
  #define DMA_K(t,slot) glds16(ksrc+(long)(t)*KVBLK*DM,(unsigned)__builtin_amdgcn_readfirstlane(kdst+(slot)))
  #define DMA_V(t,slot) glds16(vsrc+(long)(t)*KVBLK*DM,(unsigned)__builtin_amdgcn_readfirstlane(vdst+(slot)))
  const int vb0=(int)(lds0+LDS_V)+((lane>>4)&1)*32+(lane&3)*8+(4*hi+((lane&15)>>2))*64;
  const char*Kbase=shm+LDS_K; bf16x8 kf[8];
  const lds_cptr shm3=(lds_cptr)shm; const lds_cptr kp0=shm3+LDS_K+hi*1024+r32*16; const lds_cptr vp0=shm3+LDS_V+((lane>>4)&1)*32+(lane&3)*8+(4*hi+((lane&15)>>2))*64;
  const int NT=(q0+QB)/KVBLK;
  DMA_K(0,0);DMA_V(0,0);DMA_K(1,SLOTB);
  bf16x8 qr[4];
  #pragma unroll
  for(int d0=0;d0<4;++d0)qr[d0]=*reinterpret_cast<const bf16x8*>(&Qw[(long)r32*DM+d0*16+hi*8]);
  const __attribute__((address_space(3))) char* qlp=(const __attribute__((address_space(3))) char*)shm+LDS_OST+wid*4096+lane*16;
  #pragma unroll
  for(int d0=0;d0<4;++d0)*(__attribute__((address_space(3))) bf16x8*)(qlp+d0*1024)=qr[d0];
  #define QLD() do{ _Pragma("unroll") for(int d_=0;d_<4;++d_)qr[d_]=*(const __attribute__((address_space(3))) bf16x8*)(qlp+d_*1024); }while(0)
  float mhat=0.f,l_reg=0.f;f32x16 o[2];o[0]=f32x16{};o[1]=f32x16{};bf16x8 mfrag,bfa,bfb; const f32x16 zero16=f32x16{}; MFRAG_SET();
  const int qrel=wid*QBLK+r32;
  #define CMASK(P0,P1,t) do{int jb_=(t)-(NT-4); if(jb_>=0)cmask(P0,P1,jb_,qrel,hi);}while(0)
  bool resc=false;
  #define START(P0,P1) do{ const float rm=rowmax(P0,P1); resc=false; \
    { const float dl=rm; mhat=fadd_s(mhat,dl); \
      _Pragma("unroll") for(int r=0;r<16;++r){P0[r]=fsub_s(P0[r],dl);P1[r]=fsub_s(P1[r],dl);} \
      MFRAG_SET(); } \
    _Pragma("unroll") for(int r=0;r<16;++r)P0[r]=__builtin_amdgcn_exp2f(P0[r]); }while(0)
  #define RESC() do{ if(resc){ asm volatile("s_waitcnt lgkmcnt(0)":::"memory"); \
      _Pragma("unroll") for(int d_=0;d_<2;++d_) _Pragma("unroll") for(int r=0;r<16;++r)o[d_][r]*=wsf[crow(r,hi)]; } }while(0)
  f32x16 pA0,pA1,pB0,pB1;
  int sl_prev=0,sl_cur=0,sl_next=SLOTB;
  #define ROT() do{sl_prev=sl_cur;sl_cur=sl_next;sl_next=(sl_next==(NSLOT-1)*SLOTB)?0:sl_next+SLOTB;}while(0)
  DMA_K(2,2*SLOTB);
  WAIT_BAR(3);
  BFR(0); pA0=__builtin_amdgcn_mfma_f32_32x32x16_bf16(bfa,mfrag,zero16,0,0,0); pA1=__builtin_amdgcn_mfma_f32_32x32x16_bf16(bfb,mfrag,zero16,0,0,0);
  qkt(pA0,pA1,Kbase,qr,r32,hi);asm volatile("s_nop 15\n\ts_nop 7":"+v"(pA0),"+v"(pA1));CMASK(pA0,pA1,0);
  START(pA0,pA1);
  _Pragma("unroll") for(int r=0;r<16;++r)pA1[r]=__builtin_amdgcn_exp2f(pA1[r]);
  WAIT_BAR(0);
  DMA_K(3,0);DMA_V(1,SLOTB);
  ROT();
  kload8(kf,kp0+sl_cur);
  BFR(1);
  WAIT_BAR(2);
  s16x4 vlo[8],vhi[8]; u32x4 pw0,pw1,pw2,pw3;
  #define PKW(P,B) cvtpk_s(P[B],P[B+1])
  #define PAF(k) __builtin_bit_cast(bf16x8,pw##k)
  #define VFR(i) (bf16x8){vlo[i][0],vlo[i][1],vlo[i][2],vlo[i][3],vhi[i][0],vhi[i][1],vhi[i][2],vhi[i][3]}
  #define PIN(x) asm volatile("":"+v"(x))
  #define MX3(a,b,c) __builtin_fmaxf(__builtin_fmaxf((a),(b)),(c))
  #define GAPA(MF,A0,A1,A2,A3,W0,W1,PW) do{ MF; sacc+=A0; sacc+=A1; sacc+=A2; sacc+=A3; PIN(sacc); W0; W1; PIN(PW); SBAR(); }while(0)
  #define EX(v) __builtin_amdgcn_exp2f(v)
  #define GAPB(MF,X,B) do{ MF; X[B]=EX(X[B]); X[B+1]=EX(X[B+1]); X[B+2]=EX(X[B+2]); X[B+3]=EX(X[B+3]); PIN(X); SBAR(); }while(0)
  #define VRD(i) do{ vlo[i]=vtr(vp_+(((i)>>2)*4096+((i)&3)*1024)); vhi[i]=vtr(vp_+(((i)>>2)*4096+((i)&3)*1024+512)); }while(0)
  #define KRD(G,j) do{ if(G){ kload2(kf,kp0+sl_next,j); SBAR(); } }while(0)
  #define STEP(C0,C1,P0,P1,t,GK,GV,GL) do{ SBAR(); \
    const lds_cptr vp_=vp0+sl_prev; \
    VRD(0); SBAR(); float sacc=(P0[0]+P0[1]); \
    C0=__builtin_amdgcn_mfma_f32_32x32x16_bf16(bfa,mfrag,zero16,0,0,0); C1=__builtin_amdgcn_mfma_f32_32x32x16_bf16(bfb,mfrag,zero16,0,0,0); SBAR(); \
    GAPA(C0=__builtin_amdgcn_mfma_f32_32x32x16_bf16(kf[0],qr[0],C0,0,0,0), P0[2],P0[3],P0[4],P0[5],     pw0[0]=PKW(P0,0), pw0[1]=PKW(P0,2), pw0); \
    VRD(4); SBAR(); GAPA(C1=__builtin_amdgcn_mfma_f32_32x32x16_bf16(kf[1],qr[0],C1,0,0,0), P0[6],P0[7],P0[8],P0[9],     pw0[2]=PKW(P0,4), pw0[3]=PKW(P0,6), pw0); \
    VRD(1); SBAR(); GAPA(C0=__builtin_amdgcn_mfma_f32_32x32x16_bf16(kf[2],qr[1],C0,0,0,0),   P0[10],P0[11],P0[12],P0[13], pw1[0]=PKW(P0,8), pw1[1]=PKW(P0,10), pw1); \
    VRD(5); SBAR(); GAPA(C1=__builtin_amdgcn_mfma_f32_32x32x16_bf16(kf[3],qr[1],C1,0,0,0),   P0[14],P0[15],P1[0],P1[1],   pw1[2]=PKW(P0,12),pw1[3]=PKW(P0,14), pw1); \
    VRD(2); SBAR(); GAPA(C0=__builtin_amdgcn_mfma_f32_32x32x16_bf16(kf[4],qr[2],C0,0,0,0),   P1[2],P1[3],P1[4],P1[5],     pw2[0]=PKW(P1,0), pw2[1]=PKW(P1,2), pw2); \
    VRD(6); SBAR(); GAPA(C1=__builtin_amdgcn_mfma_f32_32x32x16_bf16(kf[5],qr[2],C1,0,0,0),   P1[6],P1[7],P1[8],P1[9],     pw2[2]=PKW(P1,4), pw2[3]=PKW(P1,6), pw2); \
    VRD(3); SBAR(); GAPA(C0=__builtin_amdgcn_mfma_f32_32x32x16_bf16(kf[6],qr[3],C0,0,0,0),   P1[10],P1[11],P1[12],P1[13], pw3[0]=PKW(P1,8), pw3[1]=PKW(P1,10), pw3); \
    VRD(7); SBAR(); GAPA(C1=__builtin_amdgcn_mfma_f32_32x32x16_bf16(kf[7],qr[3],C1,0,0,0),   P1[14],P1[15],0.f,0.f,       pw3[2]=PKW(P1,12),pw3[3]=PKW(P1,14), pw3); \
    l_reg+=sacc; \
    if(GK){DMA_K((t)+3,sl_cur);} if(GV){DMA_V((t)+1,sl_next);} \
    CMASK(C0,C1,t); \
    { float a=MX3(C0[0],C0[1],C1[0]),b=MX3(C0[2],C0[3],C1[1]); a=MX3(a,C1[2],C1[3]); \
      _Pragma("unroll") for(int r=4;r<16;r+=4){a=MX3(a,C0[r],C0[r+1]);b=MX3(b,C0[r+2],C0[r+3]);a=MX3(a,C1[r],C1[r+1]);b=MX3(b,C1[r+2],C1[r+3]);} \
      float rm=__builtin_fmaxf(a,b); { auto rr=__builtin_amdgcn_permlane32_swap(__float_as_uint(rm),__float_as_uint(rm),false,false); rm=__builtin_fmaxf(__uint_as_float(rr[0]),__uint_as_float(rr[1])); } \
      resc=false; \
      if(__builtin_expect(__any(rm>(float)THRL),0)){ const float dl=__builtin_fmaxf(rm,0.f); mhat+=dl; \
        _Pragma("unroll") for(int r=0;r<16;++r){C0[r]-=dl;C1[r]-=dl;} \
        MFRAG_SET(); \
        const float f=__builtin_amdgcn_exp2f(-dl); l_reg*=f; if(hi==0)wsf[r32]=f; resc=true; } } \
    SBAR(); \
    GAPB(o[0]=__builtin_amdgcn_mfma_f32_32x32x16_bf16(PAF(0),VFR(0),o[0],0,0,0), C0,0); \
    GAPB(o[1]=__builtin_amdgcn_mfma_f32_32x32x16_bf16(PAF(0),VFR(4),o[1],0,0,0), C0,4); \
    KRD(GL,0); GAPB(o[0]=__builtin_amdgcn_mfma_f32_32x32x16_bf16(PAF(1),VFR(1),o[0],0,0,0), C0,8); \
    KRD(GL,1); GAPB(o[1]=__builtin_amdgcn_mfma_f32_32x32x16_bf16(PAF(1),VFR(5),o[1],0,0,0), C0,12); \
    KRD(GL,2); GAPB(o[0]=__builtin_amdgcn_mfma_f32_32x32x16_bf16(PAF(2),VFR(2),o[0],0,0,0), C1,0); \
    KRD(GL,3); GAPB(o[1]=__builtin_amdgcn_mfma_f32_32x32x16_bf16(PAF(2),VFR(6),o[1],0,0,0), C1,4); \
    GAPB(o[0]=__builtin_amdgcn_mfma_f32_32x32x16_bf16(PAF(3),VFR(3),o[0],0,0,0), C1,8); \
    GAPB(o[1]=__builtin_amdgcn_mfma_f32_32x32x16_bf16(PAF(3),VFR(7),o[1],0,0,0), C1,12); \
    BFR((t)+1); \
    }while(0)
  int t=1;
  #undef CMASK
  #define CMASK(P0,P1,t) do{}while(0)
  for(;t+5<NT;t+=2){
    STEP(pB0,pB1,pA0,pA1,t,true,true,true);     WAIT_BAR(2); RESC(); ROT();
    STEP(pA0,pA1,pB0,pB1,t+1,true,true,true);   WAIT_BAR(2); RESC(); ROT();
  }
  #undef CMASK
  #define CMASK(P0,P1,t) do{int jb_=(t)-(NT-4); if(jb_>=0)cmask(P0,P1,jb_,qrel,hi);}while(0)
  #define ENDW(tt) do{ if((tt)+3<NT){WAIT_BAR(2);} else if((tt)+2<NT){WAIT_BAR(1);} else {WAIT_BAR(0);} }while(0)
  for(;t+1<NT;t+=2){
    STEP(pB0,pB1,pA0,pA1,t,(t+3<NT),(t+1<NT),(t+1<NT));       ENDW(t);   RESC(); ROT();
    STEP(pA0,pA1,pB0,pB1,t+1,(t+4<NT),(t+2<NT),(t+2<NT));     ENDW(t+1); RESC(); ROT();
  }
  STEP(pB0,pB1,pA0,pA1,NT-1,false,false,false); RESC();
  { float sacc=pB0[0]+pB0[1]; _Pragma("unroll") for(int r=2;r<16;++r)sacc+=pB0[r]; _Pragma("unroll") for(int r=0;r<16;++r)sacc+=pB1[r]; l_reg+=sacc;
    pw0=(u32x4){PKW(pB0,0),PKW(pB0,2),PKW(pB0,4),PKW(pB0,6)};pw1=(u32x4){PKW(pB0,8),PKW(pB0,10),PKW(pB0,12),PKW(pB0,14)};pw2=(u32x4){PKW(pB1,0),PKW(pB1,2),PKW(pB1,4),PKW(pB1,6)};pw3=(u32x4){PKW(pB1,8),PKW(pB1,10),PKW(pB1,12),PKW(pB1,14)};
    SBAR(); pv(o,vb0+sl_cur,PAF(0),PAF(1),PAF(2),PAF(3)); }
  #undef PKW
  #undef PAF
  #undef VFR
  #undef PIN
  #undef MX3
  #undef GAPA
  #undef GAPB
  #undef EX
  #undef VRD
  #undef KRD
  #undef STEP
  #undef ENDW
  {auto rr=__builtin_amdgcn_permlane32_swap(__float_as_uint(l_reg),__float_as_uint(l_reg),false,false);l_reg=__uint_as_float(rr[0])+__uint_as_float(rr[1]);}
  if(hi==0)wsf[32+r32]=l_reg;asm volatile("s_waitcnt lgkmcnt(0)":::"memory");
  float rli[16];
  #pragma unroll
  for(int r=0;r<16;++r)rli[r]=__builtin_amdgcn_rcpf(wsf[32+crow(r,hi)]);
  bf16*Ow=O+(rowbase+q0+wid*QBLK)*DMO+h*D;
  { bf16*stg=(bf16*)(shm+LDS_OST)+wid*2048;
    #pragma unroll
    for(int r=0;r<16;++r){const int orow=crow(r,hi);
      #pragma unroll
      for(int d0=0;d0<2;++d0)stg[orow*64+d0*32+r32]=__float2bfloat16(o[d0][r]*rli[r]);}
    asm volatile("s_waitcnt lgkmcnt(0)":::"memory");
    #pragma unroll
    for(int i=0;i<4;++i){const int row=i*8+(lane>>3),ch=lane&7; const u32x4 v=*(const u32x4*)(stg+row*64+ch*8); ATTN_STORE16(Ow+(long)row*DMO+ch*8,v);} }
  asm volatile("s_waitcnt lgkmcnt(0)\n\ts_barrier":::"memory");
  #undef BFRAG
  #undef BFR
  #undef MFRAG_SET
  #undef QLD
  #undef DMA_K
  #undef DMA_V
  #undef CMASK
  #undef START
  #undef RESC
  #undef ROT
}
constexpr int ATTN_LDS_BYTES=LDS_BYTES;
#undef SBAR
#undef WAIT_BAR
}
#define LAS __attribute__((address_space(3)))
typedef unsigned short bf16;
typedef unsigned v4u __attribute__((ext_vector_type(4)));
typedef unsigned v2u __attribute__((ext_vector_type(2)));
typedef float f32x4 __attribute__((ext_vector_type(4)));
typedef short bf16x8 __attribute__((ext_vector_type(8)));
typedef float f32x16 __attribute__((ext_vector_type(16)));
typedef LAS unsigned char* ldsp;
constexpr int NWAVES = 8;
constexpr int BATCH = 8, SEQ = 8192, D = 1024, M = BATCH * SEQ, NMEM = 256, MM = BATCH * NMEM, FF = 4096;
constexpr int ZW = 3584, NIN = 3840;
constexpr int ZC_MLQ = 0, ZC_MLK = 512, ZC_MLV = 1024, ZC_MLO = 1536, ZC_FXQ = 2048, ZC_FXK = 2560, ZC_FXV = 3072;
constexpr float LOG2E = 1.4426950408889634f;
constexpr float C2_FOX = 0.125f * LOG2E, C2_X = 0.0625f * LOG2E;
constexpr size_t MiB = 1u << 20;
constexpr size_t WS_CTL = 0, CTL_ZERO_BYTES = 131072;
constexpr size_t WS_WIN = 2 * MiB, WS_WOUT = 10 * MiB, WS_WXQ = 12 * MiB, WS_WXKV = 14 * MiB, WS_WXO = 18 * MiB, WS_W1 = 20 * MiB, WS_W2 = 28 * MiB;
constexpr size_t WS_MEMN = 36 * MiB, WS_KX = 40 * MiB, WS_VXT = 44 * MiB, WS_G = 48 * MiB, WS_CNEG = 52 * MiB, WS_SS1 = 54 * MiB, WS_SS2 = 58 * MiB, WS_SS3 = 62 * MiB;
constexpr size_t WS_XN = 72 * MiB, WS_MIX = 200 * MiB, WS_Z = 328 * MiB, WS_U = 328 * MiB, WS_VTG = 776 * MiB, WS_END = 840 * MiB;
constexpr int RING_BYTES = 131072, MISC_OFF = RING_BYTES, LDS_BYTES = 147456;

__device__ __forceinline__ unsigned f2bf(float f) { unsigned u = __builtin_bit_cast(unsigned, f); return (u + 0x7fffu + ((u >> 16) & 1u)) >> 16; }
__device__ __forceinline__ unsigned pk2(float lo, float hi) { return pg8::cvt_pk_bf16(lo, hi); }
__device__ __forceinline__ float bf_lo(unsigned w) { return __uint_as_float(w << 16); }
__device__ __forceinline__ float bf_hi(unsigned w) { return __uint_as_float(w & 0xffff0000u); }
__device__ __forceinline__ float wave_sum(float v) {
#pragma unroll
    for (int o = 1; o < 64; o <<= 1) v += __shfl_xor(v, o);
    return v;
}
__device__ __forceinline__ float logsig(float x) { const float e = __builtin_amdgcn_exp2f(-fabsf(x) * LOG2E); return fminf(x, 0.f) - __builtin_amdgcn_logf(1.0f + e) * 0.6931471805599453f; }
#define LDS_WAIT() asm volatile("s_waitcnt lgkmcnt(0)" ::: "memory")
#define LBAR() asm volatile("s_waitcnt lgkmcnt(0)\n\ts_barrier" ::: "memory")

template <class F> __device__ __forceinline__ void p0_transpose_item(const float* W, int K, int N, int ND, bf16* WT, LAS float* scr, int item, int lane, F srcmap) {
    const int nblk = ND / 32, kb = item / nblk, nb = item % nblk, k0 = 64 * kb, n0 = 32 * nb;
    const int sc = srcmap(n0 + (lane & 31));
#pragma unroll 8
    for (int i = 0; i < 32; ++i) { const int kk = 2 * i + (lane >> 5); scr[kk * 33 + (lane & 31)] = sc >= 0 ? W[(size_t)(k0 + kk) * N + sc] : 0.f; }
    LDS_WAIT(); asm volatile("" ::: "memory");
    const int c = lane & 7;
#pragma unroll
    for (int j = 0; j < 4; ++j) { const int n = (lane >> 3) + 8 * j; const LAS float* s = scr + (8 * c) * 33 + n;
        v4u o; o.x = pk2(s[0 * 33], s[1 * 33]); o.y = pk2(s[2 * 33], s[3 * 33]); o.z = pk2(s[4 * 33], s[5 * 33]); o.w = pk2(s[6 * 33], s[7 * 33]);
        *(v4u*)(WT + (size_t)(n0 + n) * K + k0 + 8 * c) = o; }
    LDS_WAIT(); asm volatile("" ::: "memory");
}
__device__ __forceinline__ void rms_row_to_bf16(const float* xrow, const float* gain, bf16* orow, int lane) {
    const f32x4* xr = (const f32x4*)xrow + lane; const f32x4* gr = (const f32x4*)gain + lane;
    f32x4 v[4]; float s = 0.f;
#pragma unroll
    for (int j = 0; j < 4; ++j) { v[j] = xr[64 * j]; s += (v[j].x * v[j].x + v[j].y * v[j].y) + (v[j].z * v[j].z + v[j].w * v[j].w); }
    const float r = 1.0f / sqrtf(wave_sum(s) * (1.f / 1024.f) + 1e-6f);
    unsigned long long* o8 = (unsigned long long*)orow + lane;
#pragma unroll
    for (int j = 0; j < 4; ++j) { const f32x4 g = gr[64 * j]; o8[64 * j] = (unsigned long long)pk2(v[j].x * r * g.x, v[j].y * r * g.y) | ((unsigned long long)pk2(v[j].z * r * g.z, v[j].w * r * g.w) << 32); }
}
template <int NR> __device__ __forceinline__ void rms_rows_to_bf16(const float* x0, size_t row_stride, const float* gain, bf16* o0, int lane) {
    f32x4 v[NR][4]; float s[NR];
#pragma unroll
    for (int r = 0; r < NR; ++r) { const f32x4* xr = (const f32x4*)(x0 + r * row_stride) + lane;
#pragma unroll
        for (int j = 0; j < 4; ++j) v[r][j] = xr[64 * j]; }
    f32x4 g[4];
#pragma unroll
    for (int j = 0; j < 4; ++j) g[j] = ((const f32x4*)gain)[lane + 64 * j];
#pragma unroll
    for (int r = 0; r < NR; ++r) { s[r] = 0.f;
#pragma unroll
        for (int j = 0; j < 4; ++j) s[r] += (v[r][j].x * v[r][j].x + v[r][j].y * v[r][j].y) + (v[r][j].z * v[r][j].z + v[r][j].w * v[r][j].w); }
#pragma unroll
    for (int o = 1; o < 64; o <<= 1) {
#pragma unroll
        for (int r = 0; r < NR; ++r) s[r] += __shfl_xor(s[r], o); }
#pragma unroll
    for (int r = 0; r < NR; ++r) { const float rs = 1.0f / sqrtf(s[r] * (1.f / 1024.f) + 1e-6f); unsigned long long* o8 = (unsigned long long*)(o0 + r * row_stride) + lane;
#pragma unroll
        for (int j = 0; j < 4; ++j) o8[64 * j] = (unsigned long long)pk2(v[r][j].x * rs * g[j].x, v[r][j].y * rs * g[j].y) | ((unsigned long long)pk2(v[r][j].z * rs * g[j].z, v[r][j].w * rs * g[j].w) << 32); }
}
namespace ml {
constexpr int QS = 0, KS = QS + 64 * 272, KWT = KS + 64 * 272, VT = KWT + 128 * 144, PS = VT + 128 * 144, RSP = PS + 64 * 144, CWL = RSP + 512, PRE_END = CWL + 5120;
constexpr int SB_Q = 0, SB_KW = 64 * 272, SB_VT = SB_KW + 128 * 144, SB_BYTES = SB_VT + 128 * 144, NQ = 2 * SB_BYTES, NV = NQ + 256, SSQ = NV + 512, ST_END = SSQ + 2048;
static_assert(PRE_END <= RING_BYTES && ST_END <= RING_BYTES, "mlstm LDS");
__device__ __forceinline__ float scan_add(float v, int lane) {
#pragma unroll
    for (int o = 1; o < 64; o <<= 1) { const float t = __shfl_up(v, o); if (lane >= o) v += t; }
    return v;
}
__device__ __forceinline__ float scan_max(float v, int lane) {
#pragma unroll
    for (int o = 1; o < 64; o <<= 1) { const float t = __shfl_up(v, o); if (lane >= o) v = fmaxf(v, t); }
    return v;
}
#define MFMA16(a, b, c) __builtin_amdgcn_mfma_f32_16x16x32_bf16(a, b, c, 0, 0, 0)
struct PreOut { bf16* QF; bf16* KWTg; bf16* VTg; float* HI; float* SC; float* SC2; };
struct PreRegs { v4u rq[7]; v4u rv[2]; float g_i, g_f; };
__device__ __forceinline__ void pre_load(int u, const bf16* __restrict__ Z, const float* __restrict__ G, PreRegs& R, const int tid) {
    const int lane = tid & 63, bh = u >> 7, c = u & 127, b = bh >> 2, h = bh & 3;
    const int g8 = tid & 15, isK = tid >> 8, tb = (tid >> 4) & 15, sb = tid >> 4;
    const int ch0 = (isK ? 512 : 0) + h * 128 + 8 * g8;
    const size_t rb = (size_t)b * SEQ + (size_t)c * 64;
    const bf16* zq = Z + rb * ZW + ch0; const bf16* zv = Z + rb * ZW + ZC_MLV + h * 128 + 8 * g8; const float* gp = G + rb * 16 + h;
#pragma unroll
    for (int i = 0; i < 7; ++i) { const int t = 4 * tb - 3 + i; R.rq[i] = (c == 0 && t < 0) ? (v4u){0u, 0u, 0u, 0u} : *(const v4u*)(zq + t * ZW); }
#pragma unroll
    for (int j = 0; j < 2; ++j) R.rv[j] = *(const v4u*)(zv + (2 * sb + j) * ZW);
    R.g_i = gp[lane * 16]; R.g_f = gp[lane * 16 + 4];
}
__device__ __forceinline__ void pre_unit(int u, const bf16* __restrict__ Z, const float* __restrict__ G, const PreOut& O,
        const float* __restrict__ conv_w, const float* __restrict__ conv_b, const float* __restrict__ b_i, const float* __restrict__ b_f, ldsp L, const int tid_in, int& cw_head, PreRegs& R, const int u_next) {
    const int tid = tid_in, lane = tid & 63, w = __builtin_amdgcn_readfirstlane(tid >> 6), fr = lane & 15, fq = lane >> 4;
    const int bh = u >> 7, c = u & 127, b = bh >> 2, h = bh & 3;
    const int g8 = tid & 15, isK = tid >> 8, tb = (tid >> 4) & 15, sb = tid >> 4;
    const int ch0 = (isK ? 512 : 0) + h * 128 + 8 * g8;
    const size_t rb = (size_t)b * SEQ + (size_t)c * 64;
    if (cw_head != h) {
        for (int idx = tid; idx < 1280; idx += 512) { const int which = idx / 640, j = (idx % 640) >> 7, ch = idx & 127;
            *(LAS float*)(L + CWL + idx * 4) = j < 4 ? conv_w[j * 1024 + which * 512 + h * 128 + ch] : conv_b[which * 512 + h * 128 + ch]; }
        cw_head = h;
        __syncthreads();
    }
    const int cwo = CWL + (isK * 640 + 8 * g8) * 4;
    const float lf = logsig(R.g_f + b_f[h]), ig = R.g_i + b_i[h];
    const float bc = scan_add(lf, lane), uu = ig - bc, pm = scan_max(uu, lane);
    const float umax = __shfl(pm, 63), gl = __shfl(bc, 63);
    const float wl = __expf(uu - umax);
    {
        float y[4][8];
        { const f32x4 c0 = *(const LAS f32x4*)(L + cwo + 4 * 512), c1 = *(const LAS f32x4*)(L + cwo + 4 * 512 + 16);
#pragma unroll
          for (int tt = 0; tt < 4; ++tt) { y[tt][0] = c0[0]; y[tt][1] = c0[1]; y[tt][2] = c0[2]; y[tt][3] = c0[3]; y[tt][4] = c1[0]; y[tt][5] = c1[1]; y[tt][6] = c1[2]; y[tt][7] = c1[3]; } }
#pragma unroll
        for (int j = 0; j < 4; ++j) {
            const f32x4 c0 = *(const LAS f32x4*)(L + cwo + j * 512), c1 = *(const LAS f32x4*)(L + cwo + j * 512 + 16);
            const float cwj[8] = {c0[0], c0[1], c0[2], c0[3], c1[0], c1[1], c1[2], c1[3]};
#pragma unroll
            for (int tt = 0; tt < 4; ++tt) { const int r = tt + j;
                const float x[8] = {bf_lo(R.rq[r].x), bf_hi(R.rq[r].x), bf_lo(R.rq[r].y), bf_hi(R.rq[r].y), bf_lo(R.rq[r].z), bf_hi(R.rq[r].z), bf_lo(R.rq[r].w), bf_hi(R.rq[r].w)};
#pragma unroll
                for (int i = 0; i < 8; ++i) y[tt][i] += cwj[i] * x[i]; }
        }
        const float ksc = isK ? 0.08838834764831845f : 1.0f;
#pragma unroll
        for (int tt = 0; tt < 4; ++tt)
#pragma unroll
            for (int i = 0; i < 8; ++i) { const float a = y[tt][i]; y[tt][i] = a * __builtin_amdgcn_rcpf(1.0f + __expf(-a)) * ksc; }
        const int base = isK ? KS : QS;
#pragma unroll
        for (int tt = 0; tt < 4; ++tt) { v4u o; o.x = pk2(y[tt][0], y[tt][1]); o.y = pk2(y[tt][2], y[tt][3]); o.z = pk2(y[tt][4], y[tt][5]); o.w = pk2(y[tt][6], y[tt][7]);
            *(LAS v4u*)(L + base + (4 * tb + tt) * 272 + 16 * g8) = o;
            if (!isK) *(v4u*)(O.QF + ((size_t)u * 64 + 4 * tb + tt) * 128 + 8 * g8) = o; }
        if (isK) {
            float was[4];
#pragma unroll
            for (int tt = 0; tt < 4; ++tt) was[tt] = __shfl(wl, 4 * tb + tt);
#pragma unroll
            for (int i = 0; i < 8; ++i) { v2u o; o.x = pk2(y[0][i] * was[0], y[1][i] * was[1]); o.y = pk2(y[2][i] * was[2], y[3][i] * was[3]);
                *(LAS v2u*)(L + KWT + (8 * g8 + i) * 144 + 8 * tb) = o; }
        }
        {
            const unsigned a0[4] = {R.rv[0].x, R.rv[0].y, R.rv[0].z, R.rv[0].w}, a1[4] = {R.rv[1].x, R.rv[1].y, R.rv[1].z, R.rv[1].w};
#pragma unroll
            for (int i = 0; i < 4; ++i) {
                const unsigned lo = (a0[i] & 0xffffu) | (a1[i] << 16), hi = (a0[i] >> 16) | (a1[i] & 0xffff0000u);
                *(LAS unsigned*)(L + VT + (8 * g8 + 2 * i) * 144 + 4 * sb) = lo;
                *(LAS unsigned*)(L + VT + (8 * g8 + 2 * i + 1) * 144 + 4 * sb) = hi; }
        }
    }
    if (u_next >= 0) pre_load(u_next, Z, G, R, tid);
    LBAR();
    {
        const int tt = w >> 1, half = w & 1, t = 16 * tt + fr; const float Pt = __shfl(pm, t); float rs = 0.f;
#pragma unroll
        for (int j = 0; j < 2; ++j) { const int st = 2 * half + j; f32x4 a = (f32x4){0.f, 0.f, 0.f, 0.f};
            if (st <= tt) {
#pragma unroll
                for (int ks = 0; ks < 4; ++ks) { const bf16x8 kf = *(const LAS bf16x8*)(L + KS + (16 * st + fr) * 272 + (32 * ks + 8 * fq) * 2); const bf16x8 qf = *(const LAS bf16x8*)(L + QS + t * 272 + (32 * ks + 8 * fq) * 2); a = MFMA16(kf, qf, a); }
            }
            float p[4];
#pragma unroll
            for (int i = 0; i < 4; ++i) { const int s = 16 * st + 4 * fq + i; const float us = __shfl(uu, s); p[i] = (s <= t) ? a[i] * __expf(us - Pt) : 0.f; rs += p[i]; }
            v2u o; o.x = pk2(p[0], p[1]); o.y = pk2(p[2], p[3]);
            *(LAS v2u*)(L + PS + t * 144 + (16 * st + 4 * fq) * 2) = o; }
        rs += __shfl_xor(rs, 16); rs += __shfl_xor(rs, 32);
        if (fq == 0) *(LAS float*)(L + RSP + (t * 2 + half) * 4) = rs;
    }
#pragma unroll
    for (int i = 0; i < 2; ++i) { const int it = tid + 512 * i, row = it >> 3, chk = it & 7;
        *(v4u*)(O.KWTg + ((size_t)u * 128 + row) * 64 + 8 * chk) = *(const LAS v4u*)(L + KWT + row * 144 + 16 * chk);
        *(v4u*)(O.VTg + ((size_t)u * 128 + row) * 64 + 8 * chk) = *(const LAS v4u*)(L + VT + row * 144 + 16 * chk); }
    LBAR();
    {
        bf16x8 vf[2];
#pragma unroll
        for (int ks = 0; ks < 2; ++ks) vf[ks] = *(const LAS bf16x8*)(L + VT + (16 * w + fr) * 144 + (32 * ks + 8 * fq) * 2);
#pragma unroll
        for (int t4 = 0; t4 < 4; ++t4) { const int t = 16 * t4 + fr; f32x4 a = (f32x4){0.f, 0.f, 0.f, 0.f};
#pragma unroll
            for (int ks = 0; ks < 2; ++ks) { const bf16x8 pf = *(const LAS bf16x8*)(L + PS + t * 144 + (32 * ks + 8 * fq) * 2); a = MFMA16(vf[ks], pf, a); }
            *(f32x4*)(O.HI + ((size_t)u * 64 + t) * 128 + 16 * w + 4 * fq) = a; }
        if (w == 0) { const float rsum = *(const LAS float*)(L + RSP + lane * 8) + *(const LAS float*)(L + RSP + lane * 8 + 4);
            *(f32x4*)(O.SC + ((size_t)u * 64 + lane) * 4) = (f32x4){bc, pm, rsum, 0.f};
            if (lane == 0) { O.SC2[(size_t)u * 2] = umax; O.SC2[(size_t)u * 2 + 1] = gl; } }
    }
    LBAR();
}
__device__ __forceinline__ void stream(int b, int h, const bf16* __restrict__ Z, const PreOut& O, bf16* __restrict__ MIX, const float* __restrict__ ml_norm, ldsp L, const int tid_in, const int c_begin, const int c_end) {
    const int tid = tid_in, lane = tid & 63, w = __builtin_amdgcn_readfirstlane(tid >> 6), fr = lane & 15, fq = lane >> 4;
    const int bh = b * 4 + h;
    const f32x4 mln = *(const f32x4*)(ml_norm + h * 128 + 16 * w + 4 * fq);
    f32x4 accC[8];
#pragma unroll
    for (int i = 0; i < 8; ++i) accC[i] = (f32x4){0.f, 0.f, 0.f, 0.f};
    if (tid < 128) *(LAS float*)(L + NV + tid * 4) = 0.f;
    float mcar = 0.f;
    const size_t row0 = (size_t)b * SEQ;
    v4u st[6]; f32x4 hi[4]; v2u ro[4]; f32x4 sc4 = (f32x4){0.f, 0.f, 0.f, 0.f}; float umax, gch;
#pragma unroll
    for (int i = 0; i < 6; ++i) st[i] = (v4u){0u, 0u, 0u, 0u};
#pragma unroll
    for (int i = 0; i < 4; ++i) { hi[i] = (f32x4){0.f, 0.f, 0.f, 0.f}; ro[i] = (v2u){0u, 0u}; }
#define ML_LOAD(cc) do { const size_t u_ = (size_t)bh * 128 + (cc); \
        const bf16* pk_ = O.KWTg + u_ * 8192; const bf16* pv_ = O.VTg + u_ * 8192; \
        _Pragma("unroll") for (int i_ = 0; i_ < 2; ++i_) { const int it_ = tid + 512 * i_; st[2 + i_] = *(const v4u*)(pk_ + it_ * 8); st[4 + i_] = *(const v4u*)(pv_ + it_ * 8); } \
        umax = O.SC2[u_ * 2]; gch = O.SC2[u_ * 2 + 1]; \
        if ((cc) >= c_begin) { const bf16* pq_ = O.QF + u_ * 8192; const float* ph_ = O.HI + u_ * 8192; const bf16* po_ = Z + (row0 + (size_t)(cc) * 64) * ZW + ZC_MLO + h * 128; const float* ps_ = O.SC + u_ * 256; \
        _Pragma("unroll") for (int i_ = 0; i_ < 2; ++i_) { const int it_ = tid + 512 * i_; st[i_] = *(const v4u*)(pq_ + it_ * 8); } \
        _Pragma("unroll") for (int t4_ = 0; t4_ < 4; ++t4_) { hi[t4_] = *(const f32x4*)(ph_ + (16 * t4_ + fr) * 128 + 16 * w + 4 * fq); \
            ro[t4_] = *(const v2u*)(po_ + (16 * t4_ + fr) * ZW + 16 * w + 4 * fq); } \
        sc4 = *(const f32x4*)(ps_ + lane * 4); } } while (0)
    ML_LOAD(0);
    for (int c = 0; c < c_end; ++c) {
        const bool full = c >= c_begin;
        const int sbo = (c & 1) * SB_BYTES;
#pragma unroll
        for (int i = 0; i < 2; ++i) { const int it = tid + 512 * i;
            *(LAS v4u*)(L + sbo + SB_Q + (it >> 4) * 272 + (it & 15) * 16) = st[i];
            *(LAS v4u*)(L + sbo + SB_KW + (it >> 3) * 144 + (it & 7) * 16) = st[2 + i];
            *(LAS v4u*)(L + sbo + SB_VT + (it >> 3) * 144 + (it & 7) * 16) = st[4 + i]; }
        const float bc = sc4[0], pm = sc4[1], rsl = sc4[2];
        const float Mv = fmaxf(mcar, pm), Ml = fmaxf(mcar, umax);
        const float r1 = __expf(pm - Mv), inter = __expf(mcar - Mv), flo = __expf(-(bc + Mv));
        const float scl = __expf(umax - Ml), decay = __expf(mcar - Ml);
        mcar = gch + Ml;
        f32x4 acch[4]; v2u og[4];
#pragma unroll
        for (int t4 = 0; t4 < 4; ++t4) { acch[t4] = hi[t4]; og[t4] = ro[t4]; }
        if (c + 1 < c_end) ML_LOAD(c + 1);
        LBAR();
        if (full) {
            bf16x8 cx[4];
#pragma unroll
            for (int ks = 0; ks < 4; ++ks) { v4u o; o.x = pk2(accC[2 * ks][0], accC[2 * ks][1]); o.y = pk2(accC[2 * ks][2], accC[2 * ks][3]); o.z = pk2(accC[2 * ks + 1][0], accC[2 * ks + 1][1]); o.w = pk2(accC[2 * ks + 1][2], accC[2 * ks + 1][3]);
                cx[ks] = __builtin_bit_cast(bf16x8, o); }
#pragma unroll
            for (int t4 = 0; t4 < 4; ++t4) { const int t = 16 * t4 + fr; const float it = __shfl(inter, t), r1t = __shfl(r1, t);
                f32x4 a = (f32x4){0.f, 0.f, 0.f, 0.f};
#pragma unroll
                for (int ks = 0; ks < 4; ++ks) { const v2u qlo = *(const LAS v2u*)(L + sbo + SB_Q + t * 272 + (32 * ks + 4 * fq) * 2), qhi = *(const LAS v2u*)(L + sbo + SB_Q + t * 272 + (32 * ks + 16 + 4 * fq) * 2);
                    const v4u qq = {qlo.x, qlo.y, qhi.x, qhi.y}; a = MFMA16(cx[ks], __builtin_bit_cast(bf16x8, qq), a); }
                acch[t4] = acch[t4] * r1t + a * it;
                float sq = (acch[t4][0] * acch[t4][0] + acch[t4][1] * acch[t4][1]) + (acch[t4][2] * acch[t4][2] + acch[t4][3] * acch[t4][3]);
                sq += __shfl_xor(sq, 16); sq += __shfl_xor(sq, 32);
                if (fq == 0) *(LAS float*)(L + SSQ + (t * 8 + w) * 4) = sq; }
        }
        if (full) {
            const int ft = tid >> 3, part = tid & 7; float s = 0.f;
#pragma unroll
            for (int j = 0; j < 2; ++j) { const v4u qv = *(const LAS v4u*)(L + sbo + SB_Q + ft * 272 + (16 * part + 8 * j) * 2); const f32x4 n0 = *(const LAS f32x4*)(L + NV + (16 * part + 8 * j) * 4), n1 = *(const LAS f32x4*)(L + NV + (16 * part + 8 * j + 4) * 4);
                s += bf_lo(qv.x) * n0[0] + bf_hi(qv.x) * n0[1] + bf_lo(qv.y) * n0[2] + bf_hi(qv.y) * n0[3] + bf_lo(qv.z) * n1[0] + bf_hi(qv.z) * n1[1] + bf_lo(qv.w) * n1[2] + bf_hi(qv.w) * n1[3]; }
            s += __shfl_xor(s, 1); s += __shfl_xor(s, 2); s += __shfl_xor(s, 4);
            if (part == 0) *(LAS float*)(L + NQ + ft * 4) = s;
        }
        float nsum;
        {
            bf16x8 vf[2];
#pragma unroll
            for (int ks = 0; ks < 2; ++ks) vf[ks] = *(const LAS bf16x8*)(L + sbo + SB_VT + (16 * w + fr) * 144 + (32 * ks + 8 * fq) * 2);
#pragma unroll
            for (int dt = 0; dt < 8; ++dt) { f32x4 a = (f32x4){0.f, 0.f, 0.f, 0.f};
#pragma unroll
                for (int ks = 0; ks < 2; ++ks) { const bf16x8 kwf = *(const LAS bf16x8*)(L + sbo + SB_KW + (16 * dt + fr) * 144 + (32 * ks + 8 * fq) * 2); a = MFMA16(kwf, vf[ks], a); }
                accC[dt] = accC[dt] * decay + a * scl; }
            const int d = tid >> 2, part = tid & 3; float s = 0.f;
#pragma unroll
            for (int j = 0; j < 2; ++j) { const v4u kv = *(const LAS v4u*)(L + sbo + SB_KW + d * 144 + (16 * part + 8 * j) * 2);
                s += (bf_lo(kv.x) + bf_hi(kv.x)) + (bf_lo(kv.y) + bf_hi(kv.y)) + (bf_lo(kv.z) + bf_hi(kv.z)) + (bf_lo(kv.w) + bf_hi(kv.w)); }
            s += __shfl_xor(s, 1); s += __shfl_xor(s, 2);
            nsum = s;
        }
        LBAR();
        { const int d = tid >> 2, part = tid & 3; if (part == 0) { LAS float* np = (LAS float*)(L + NV + d * 4); *np = decay * *np + scl * nsum; } }
        if (full) {
#pragma unroll
        for (int t4 = 0; t4 < 4; ++t4) { const int t = 16 * t4 + fr;
            const float it = __shfl(inter, t), r1t = __shfl(r1, t), fl = __shfl(flo, t), rst = __shfl(rsl, t);
            const float den = r1t * rst + it * *(const LAS float*)(L + NQ + t * 4);
            const float dn = __builtin_amdgcn_rcpf(fmaxf(fabsf(den), fl));
            const f32x4 s0 = *(const LAS f32x4*)(L + SSQ + t * 32), s1 = *(const LAS f32x4*)(L + SSQ + t * 32 + 16);
            const float ss = (((s0[0] + s0[1]) + (s0[2] + s0[3])) + ((s1[0] + s1[1]) + (s1[2] + s1[3]))) * dn * dn;
            const float r = dn * __builtin_amdgcn_rsqf(ss * (1.0f / 128.0f) + 1e-6f);
            const float o0 = bf_lo(og[t4].x), o1 = bf_hi(og[t4].x), o2 = bf_lo(og[t4].y), o3 = bf_hi(og[t4].y);
            const float e0 = acch[t4][0] * r * mln[0] * __builtin_amdgcn_rcpf(1.0f + __expf(-o0)), e1 = acch[t4][1] * r * mln[1] * __builtin_amdgcn_rcpf(1.0f + __expf(-o1));
            const float e2 = acch[t4][2] * r * mln[2] * __builtin_amdgcn_rcpf(1.0f + __expf(-o2)), e3 = acch[t4][3] * r * mln[3] * __builtin_amdgcn_rcpf(1.0f + __expf(-o3));
            v2u o; o.x = pk2(e0, e1); o.y = pk2(e2, e3);
            *(v2u*)(MIX + (row0 + (size_t)c * 64 + t) * 1024 + h * 128 + 16 * w + 4 * fq) = o; }
        }
    }
#undef ML_LOAD
    __syncthreads();
}
}
namespace xa {
constexpr int BUFB = 36864;
#define MFMA32(a, b, c) __builtin_amdgcn_mfma_f32_32x32x16_bf16(a, b, c, 0, 0, 0)
__device__ __forceinline__ void xattn_unit(int pt, int hx, bf16* __restrict__ QO, const bf16* __restrict__ KX, const bf16* __restrict__ VXT, ldsp L, const int tid_in) {
    const int tid = tid_in, lane = tid & 63, w = __builtin_amdgcn_readfirstlane(tid >> 6), r32 = lane & 31, hi = lane >> 5;
    const int b = pt >> 5;
    bf16* qrow = QO + ((size_t)pt * 256 + w * 32 + r32) * 1024 + hx * 256;
    bf16x8 qf[16];
#pragma unroll
    for (int d0 = 0; d0 < 16; ++d0) qf[d0] = *(const bf16x8*)(qrow + 16 * d0 + 8 * hi);
    const bf16* kbase = KX + (size_t)b * 256 * 1024 + hx * 256;
    const bf16* vbase = VXT + (size_t)hx * 256 * 2048 + b * 256;
    v4u st[4];
#define XA_LOAD(j) do { if ((j) < 4) { _Pragma("unroll") for (int i_ = 0; i_ < 4; ++i_) { const int it_ = tid + 512 * i_, row_ = it_ >> 5, ch_ = it_ & 31; st[i_] = *(const v4u*)(kbase + (size_t)(64 * (j) + row_) * 1024 + 8 * ch_); } } \
        else { _Pragma("unroll") for (int i_ = 0; i_ < 2; ++i_) { const int it_ = tid + 512 * i_, row_ = it_ >> 3, ch_ = it_ & 7; st[i_] = *(const v4u*)(vbase + (size_t)(128 * (((j) - 4) >> 2) + row_) * 2048 + 64 * (((j) - 4) & 3) + 8 * ch_); } } } while (0)
#define XA_STORE(j) do { const int bo_ = ((j) & 1) * BUFB; if ((j) < 4) { _Pragma("unroll") for (int i_ = 0; i_ < 4; ++i_) { const int it_ = tid + 512 * i_, row_ = it_ >> 5, ch_ = it_ & 31; *(LAS v4u*)(L + bo_ + row_ * 528 + 16 * ch_) = st[i_]; } } \
        else { _Pragma("unroll") for (int i_ = 0; i_ < 2; ++i_) { const int it_ = tid + 512 * i_, row_ = it_ >> 3, ch_ = it_ & 7; *(LAS v4u*)(L + bo_ + row_ * 144 + 16 * ch_) = st[i_]; } } } while (0)
#define XA_QK(a0, a1, bo) do { a0 = (f32x16){}; a1 = (f32x16){}; _Pragma("unroll") for (int d0 = 0; d0 < 16; ++d0) { \
        const bf16x8 k0_ = *(const LAS bf16x8*)(L + (bo) + r32 * 528 + (16 * d0 + 8 * hi) * 2), k1_ = *(const LAS bf16x8*)(L + (bo) + (32 + r32) * 528 + (16 * d0 + 8 * hi) * 2); \
        a0 = MFMA32(k0_, qf[d0], a0); a1 = MFMA32(k1_, qf[d0], a1); } } while (0)
    XA_LOAD(0); XA_STORE(0);
    LBAR();
    float mt[4], lt[4];
    v4u pw[4][4];
#pragma unroll
    for (int j = 0; j < 4; ++j) {
        XA_LOAD(j + 1);
        f32x16 a0, a1; XA_QK(a0, a1, (j & 1) * BUFB);
        float mx = fmaxf(a0[0], a1[0]);
#pragma unroll
        for (int r = 1; r < 16; ++r) mx = fmaxf(mx, fmaxf(a0[r], a1[r]));
        mx = fmaxf(mx, __shfl_xor(mx, 32));
        float p[16], q[16], l = 0.f;
#pragma unroll
        for (int r = 0; r < 16; ++r) { p[r] = __builtin_amdgcn_exp2f(a0[r] - mx); q[r] = __builtin_amdgcn_exp2f(a1[r] - mx); l += p[r] + q[r]; }
        mt[j] = mx; lt[j] = l;
        pw[j][0] = (v4u){pk2(p[0], p[1]), pk2(p[2], p[3]), pk2(p[4], p[5]), pk2(p[6], p[7])};
        pw[j][1] = (v4u){pk2(p[8], p[9]), pk2(p[10], p[11]), pk2(p[12], p[13]), pk2(p[14], p[15])};
        pw[j][2] = (v4u){pk2(q[0], q[1]), pk2(q[2], q[3]), pk2(q[4], q[5]), pk2(q[6], q[7])};
        pw[j][3] = (v4u){pk2(q[8], q[9]), pk2(q[10], q[11]), pk2(q[12], q[13]), pk2(q[14], q[15])};
        XA_STORE(j + 1);
        LBAR();
    }
    const float mg = fmaxf(fmaxf(mt[0], mt[1]), fmaxf(mt[2], mt[3]));
    float l = 0.f;
#pragma unroll
    for (int j = 0; j < 4; ++j) { const float f = __builtin_amdgcn_exp2f(mt[j] - mg); l += f * lt[j];
#pragma unroll
        for (int k = 0; k < 4; ++k) { unsigned w4[4] = {pw[j][k].x, pw[j][k].y, pw[j][k].z, pw[j][k].w};
#pragma unroll
            for (int e = 0; e < 4; ++e) w4[e] = pk2(bf_lo(w4[e]) * f, bf_hi(w4[e]) * f);
            pw[j][k] = (v4u){w4[0], w4[1], w4[2], w4[3]}; } }
    l += __shfl_xor(l, 32);
    const float rl = 1.0f / l;
    bf16* obase = QO + ((size_t)pt * 256 + w * 32) * 1024 + hx * 256;
#pragma unroll
    for (int hd = 0; hd < 2; ++hd) {
        f32x16 o[4];
#pragma unroll
        for (int i = 0; i < 4; ++i) o[i] = (f32x16){};
#pragma unroll
        for (int vt = 0; vt < 4; ++vt) {
            const int j = 4 + 4 * hd + vt;
            if (j < 11) XA_LOAD(j + 1);
            const int bo = (j & 1) * BUFB;
#pragma unroll
            for (int db = 0; db < 4; ++db)
#pragma unroll
                for (int j4 = 0; j4 < 4; ++j4) { const v2u lo = *(const LAS v2u*)(L + bo + (32 * db + r32) * 144 + (16 * j4 + 4 * hi) * 2), hh = *(const LAS v2u*)(L + bo + (32 * db + r32) * 144 + (16 * j4 + 8 + 4 * hi) * 2);
                    const v4u vv = {lo.x, lo.y, hh.x, hh.y}; o[db] = MFMA32(__builtin_bit_cast(bf16x8, pw[vt][j4]), __builtin_bit_cast(bf16x8, vv), o[db]); }
            if (j < 11) { XA_STORE(j + 1); }
            LBAR();
        }
#pragma unroll
        for (int r = 0; r < 16; ++r) { const int q = (r & 3) + 8 * (r >> 2) + 4 * hi; const float rq = __shfl(rl, q);
#pragma unroll
            for (int db = 0; db < 4; ++db) obase[(size_t)q * 1024 + 128 * hd + 32 * db + r32] = (bf16)f2bf(o[db][r] * rq); }
    }
#undef XA_QK
#undef XA_LOAD
#undef XA_STORE
}
}
#define XB_TMO      128
#define XB_XCNT(j)  (256  + 64 * (j))
#define XB_XSUB(j)  (1280 + 64 * (j))
#define XB_XGEN(j)  (2304 + 64 * (j))
#define XB_TOP      3328
#define XB_TOPGEN   3392
#define XCD_BAR_WORDS 3456
#define XB_SPIN_CAP (1u << 18)

__device__ __forceinline__ unsigned xb_ld(unsigned* p)              { return __hip_atomic_load(p, __ATOMIC_RELAXED, __HIP_MEMORY_SCOPE_AGENT); }
__device__ __forceinline__ unsigned xb_add(unsigned* p, unsigned v) { return __hip_atomic_fetch_add(p, v, __ATOMIC_RELAXED, __HIP_MEMORY_SCOPE_AGENT); }
__device__ __forceinline__ unsigned xb_xcc_id() { return (unsigned)__builtin_amdgcn_s_getreg((3 << 11) | 20) & 0xFu; }
#define XB_SPIN(cond, bar) do { unsigned _sp = 0; while (cond) { __builtin_amdgcn_s_sleep(1); \
    if ((++_sp & 255u) == 0u) { if (xb_ld(&(bar)[XB_TMO])) break; if (_sp > XB_SPIN_CAP) { atomicAdd(&(bar)[XB_TMO], 1u); break; } } } } while (0)

struct XcdBarrier {
    unsigned* bar; unsigned x;
    volatile LAS unsigned* st;
};

__device__ __forceinline__ XcdBarrier xcd_barrier_post(unsigned* bar, volatile LAS unsigned* st) {
    XcdBarrier b; b.bar = bar; b.x = xb_xcc_id(); b.st = st;
    if (threadIdx.x == 0) (void)xb_add(&bar[XB_XCNT(b.x)], 1u);
    return b;
}
__device__ __forceinline__ void xcd_barrier_complete(unsigned* bar, unsigned x, unsigned& nloc, unsigned& nx) {
    const unsigned G = gridDim.x * gridDim.y * gridDim.z;
    unsigned sum, cnt, mine, sp = 0u;
    for (;;) {
        sum = 0u; cnt = 0u; mine = 0u;
#pragma unroll
        for (unsigned j = 0; j < 16; ++j) { const unsigned c = xb_ld(&bar[XB_XCNT(j)]); sum += c; cnt += (c > 0u) ? 1u : 0u; mine = (j == x) ? c : mine; }
        if (sum == G) break;
        __builtin_amdgcn_s_sleep(1);
        if ((++sp & 255u) == 0u) { if (xb_ld(&bar[XB_TMO])) break; if (sp > XB_SPIN_CAP) { atomicAdd(&bar[XB_TMO], 1u); break; } }
    }
    nloc = mine > 0u ? mine : 1u; nx = cnt > 0u ? cnt : 1u;
}

__device__ __forceinline__ void xcd_barrier(const XcdBarrier& b) {
    asm volatile("s_waitcnt vmcnt(0)" ::: "memory");
    __syncthreads();
    if (threadIdx.x == 0) {
        unsigned* bar = b.bar;
        __builtin_amdgcn_s_waitcnt(0);
        unsigned nloc = b.st[0], nx = b.st[1];
        if (nloc == 0u) { xcd_barrier_complete(bar, b.x, nloc, nx); b.st[0] = nloc; b.st[1] = nx; }
        const unsigned old = xb_add(&bar[XB_XSUB(b.x)], 1u);
        const unsigned gen = old / nloc;
        if (old + 1u == (gen + 1u) * nloc) {
            __builtin_amdgcn_fence(__ATOMIC_RELEASE, "agent");
            asm volatile("s_waitcnt vmcnt(0)" ::: "memory");
            const unsigned og = xb_add(&bar[XB_TOP], 1u);
            const unsigned tg = og / nx;
            if (og + 1u == (tg + 1u) * nx) xb_add(&bar[XB_TOPGEN], 1u);
            else XB_SPIN(xb_ld(&bar[XB_TOPGEN]) == tg, bar);
            __builtin_amdgcn_fence(__ATOMIC_ACQUIRE, "agent");
            xb_add(&bar[XB_XGEN(b.x)], 1u);
            asm volatile("s_waitcnt vmcnt(0)" ::: "memory");
        } else {
            XB_SPIN(xb_ld(&bar[XB_XGEN(b.x)]) == gen, bar);
            __builtin_amdgcn_fence(__ATOMIC_ACQUIRE, "agent");
            asm volatile("s_waitcnt vmcnt(0)" ::: "memory");
        }
    }
    __syncthreads();
}

struct Args { const float* in[20]; float* out; unsigned char* ws; int ph_lo, ph_hi, coop, pad; };
constexpr int N_PHASES = 10;
__global__ void __launch_bounds__(NWAVES * 64, 2) mk_fwd(Args args) {
    __builtin_assume(__builtin_amdgcn_workitem_id_y() == 0); __builtin_assume(__builtin_amdgcn_workitem_id_z() == 0);
    extern __shared__ __attribute__((aligned(16))) unsigned char lds[];
    const ldsp L = (ldsp)lds;
    volatile LAS unsigned* MISC = (volatile LAS unsigned*)(L + MISC_OFF);
    const int tid = threadIdx.x, lane = tid & 63, wave = __builtin_amdgcn_readfirstlane(tid >> 6);
    const int G = gridDim.x, bid = blockIdx.x;
#define x (args.in[0])
#define mem (args.in[1])
#define ln1 (args.in[2])
#define w_in (args.in[3])
#define conv_w (args.in[4])
#define conv_b (args.in[5])
#define ml_b_i (args.in[6])
#define ml_b_f (args.in[7])
#define ml_norm (args.in[8])
#define fx_b_f (args.in[9])
#define w_out (args.in[10])
#define ln_x (args.in[11])
#define ln_mem (args.in[12])
#define w_xq (args.in[13])
#define w_xkv (args.in[14])
#define w_xo (args.in[15])
#define ln2 (args.in[16])
#define w_ff1 (args.in[17])
#define w_ff2 (args.in[18])
#define ln_f (args.in[19])
    float* const out = args.out;
#define ctl ((unsigned*)(args.ws + WS_CTL))
#define Win_t ((bf16*)(args.ws + WS_WIN))
#define Wout_t ((bf16*)(args.ws + WS_WOUT))
#define Wxq_t ((bf16*)(args.ws + WS_WXQ))
#define Wxkv_t ((bf16*)(args.ws + WS_WXKV))
#define Wxo_t ((bf16*)(args.ws + WS_WXO))
#define W1_t ((bf16*)(args.ws + WS_W1))
#define W2_t ((bf16*)(args.ws + WS_W2))
#define MEMN ((bf16*)(args.ws + WS_MEMN))
#define KX ((bf16*)(args.ws + WS_KX))
#define VXT ((bf16*)(args.ws + WS_VXT))
#define GT ((float*)(args.ws + WS_G))
#define CNEG ((float*)(args.ws + WS_CNEG))
#define SS1 ((float*)(args.ws + WS_SS1))
#define SS2 ((float*)(args.ws + WS_SS2))
#define SS3 ((float*)(args.ws + WS_SS3))
#define XN ((bf16*)(args.ws + WS_XN))
#define MIX ((bf16*)(args.ws + WS_MIX))
#define Zb ((bf16*)(args.ws + WS_Z))
#define Ub ((bf16*)(args.ws + WS_U))
    const int lo = args.ph_lo, hi = args.ph_hi;
    if (tid < 16) MISC[tid] = 0u;
    __syncthreads();
    const XcdBarrier xbar = xcd_barrier_post((unsigned*)(ctl + 24576), MISC + 8);
#ifndef PH_MASK
#define PH_MASK 0x7ff
#endif
#define IN(k) ((((PH_MASK) >> (k)) & 1) && lo <= (k) && (k) < hi)
#ifndef DIL_MASK
#define DIL_MASK 0
#endif
#ifndef DIL_MUL
#define DIL_MUL 3
#endif
    unsigned long long tprev = (DIL_MASK) ? __builtin_amdgcn_s_memrealtime() : 0ull;
#define SEAM(k) do { if (IN(k) && IN((k) + 1)) { if (args.coop == 0x7fff0001) cg::this_grid().sync(); xcd_barrier(xbar); } \
    if (DIL_MASK) { unsigned long long t1_ = __builtin_amdgcn_s_memrealtime(); if (((DIL_MASK) >> (k)) & 1) { const unsigned long long w_ = (t1_ - tprev) * (DIL_MUL); while (__builtin_amdgcn_s_memrealtime() - t1_ < w_) __builtin_amdgcn_s_sleep(8); t1_ = __builtin_amdgcn_s_memrealtime(); } tprev = t1_; } } while (0)

    if (IN(0)) {
        LAS float* scr = (LAS float*)(L + wave * 16384);
        const int gw = bid * NWAVES + wave, NGW = G * NWAVES;
        constexpr int I_IN = 16 * (NIN / 32), I_SQ = 16 * 32, I_KV = 16 * 64, I_1 = 16 * 128, I_2 = 64 * 32;
        constexpr int NITEMS = I_IN + 3 * I_SQ + I_KV + I_1 + I_2;
        auto ident = [](int n) { return n; };
        auto inmap = [](int n) { return n < 2048 ? n : (n < 3584 ? n + 8 : (n < 3592 ? n - 1536 : (n < 3600 ? n : -1))); };
        for (int it = gw; it < NITEMS; it += NGW) {
            int r = it;
            if (r < I_IN) { p0_transpose_item(w_in, 1024, 3600, NIN, Win_t, scr, r, lane, inmap); continue; } r -= I_IN;
            if (r < I_SQ) { p0_transpose_item(w_out, 1024, 1024, 1024, Wout_t, scr, r, lane, ident); continue; } r -= I_SQ;
            if (r < I_SQ) { p0_transpose_item(w_xq, 1024, 1024, 1024, Wxq_t, scr, r, lane, ident); continue; } r -= I_SQ;
            if (r < I_KV) { p0_transpose_item(w_xkv, 1024, 2048, 2048, Wxkv_t, scr, r, lane, ident); continue; } r -= I_KV;
            if (r < I_SQ) { p0_transpose_item(w_xo, 1024, 1024, 1024, Wxo_t, scr, r, lane, ident); continue; } r -= I_SQ;
            if (r < I_1) { p0_transpose_item(w_ff1, 1024, 4096, 4096, W1_t, scr, r, lane, ident); continue; } r -= I_1;
            p0_transpose_item(w_ff2, 4096, 1024, 1024, W2_t, scr, r, lane, ident);
        }
        { int m = gw; for (; m + 3 * NGW < M; m += 4 * NGW) rms_rows_to_bf16<4>(x + (size_t)m * D, (size_t)NGW * D, ln1, XN + (size_t)m * D, lane);
          for (; m < M; m += NGW) rms_row_to_bf16(x + (size_t)m * D, ln1, XN + (size_t)m * D, lane); }
        for (int m = gw; m < MM; m += NGW) rms_row_to_bf16(mem + (size_t)m * D, ln_mem, MEMN + (size_t)m * D, lane);
        __syncthreads();
    }
    SEAM(0);
    if (IN(1)) {
        pg8::Gemm g{XN, Win_t, M, NIN, D}; pg8::StaticOrder S; S.init(M, NIN, G, bid);
        pg8::EpiZ E{Zb, GT, C2_FOX};
        pg8::gemm_phase<pg8::EpiZ, pg8::StaticOrder, true, true>(L, g, S, E, tid);
    }
    SEAM(1);
    if (IN(2)) {
        if (bid < 64) {
            const int b = bid >> 3, h = bid & 7; const float bfv = fx_b_f[h];
            float v[16]; float run = 0.f;
#pragma unroll
            for (int j = 0; j < 16; ++j) { const int s = 16 * tid + j; run += logsig(GT[((size_t)b * SEQ + s) * 16 + 8 + h] + bfv); v[j] = run; }
            const float inc = ml::scan_add(run, lane);
            LAS float* wt = (LAS float*)(L);
            if (lane == 63) wt[wave] = inc;
            __syncthreads();
            float off = inc - run;
            for (int ww = 0; ww < wave; ++ww) off += wt[ww];
#pragma unroll
            for (int j4 = 0; j4 < 4; ++j4) { f32x4 o;
#pragma unroll
                for (int i = 0; i < 4; ++i) o[i] = -(off + v[4 * j4 + i]) * LOG2E;
                *(f32x4*)(CNEG + (size_t)bid * SEQ + 16 * tid + 4 * j4) = o; }
            __syncthreads();
        } else if (bid < 96) {
            pg8::Gemm g{MEMN, Wxkv_t, MM, 1024, D}; pg8::StaticOrder S; S.init(MM, 1024, 32, bid - 64);
            pg8::EpiPlain E{KX, 1024};
            pg8::gemm_phase<pg8::EpiPlain, pg8::StaticOrder, true, true>(L, g, S, E, tid);
        } else if (bid < 128) {
            pg8::Gemm g{Wxkv_t + (size_t)1024 * 1024, MEMN, 1024, MM, D}; pg8::StaticOrder S; S.init(1024, MM, 32, bid - 96);
            pg8::EpiPlain E{VXT, 2048};
            pg8::gemm_phase<pg8::EpiPlain, pg8::StaticOrder, true, true>(L, g, S, E, tid);
        }
        {
            const ml::PreOut PO{XN, XN + (size_t)32 * 1024 * 1024, (bf16*)(args.ws + WS_VTG), out, SS2, SS3};
            int cw_head = -1;
            const int u0 = bid < 128 ? 14 * bid : 1792 + 18 * (bid - 128), nu = (G == 256) ? (bid < 128 ? 14 : 18) : 0;
            ml::PreRegs PR;
            if (nu > 0) ml::pre_load(u0, Zb, GT, PR, tid);
            for (int i = 0; i < nu; ++i) ml::pre_unit(u0 + i, Zb, GT, PO, conv_w, conv_b, ml_b_i, ml_b_f, L, tid, cw_head, PR, i + 1 < nu ? u0 + i + 1 : -1);
            if (G != 256) { for (int u = bid; u < 4096; u += G) { ml::pre_load(u, Zb, GT, PR, tid); ml::pre_unit(u, Zb, GT, PO, conv_w, conv_b, ml_b_i, ml_b_f, L, tid, cw_head, PR, -1); } }
        }
    }
    SEAM(2);
    if (IN(3)) {
#ifndef NO_ML
        if (bid < 64) { const ml::PreOut PO{XN, XN + (size_t)32 * 1024 * 1024, (bf16*)(args.ws + WS_VTG), out, SS2, SS3}; const int sg = 1 - (bid >> 5), sbh = bid & 31; ml::stream(sbh >> 2, sbh & 3, Zb, PO, MIX, ml_norm, L, tid, 64 * sg, 64 * sg + 64); }
#endif
#if defined(ML_SEP)
        cg::this_grid().sync();
        if (DIL_MASK) { unsigned long long t1_ = __builtin_amdgcn_s_memrealtime(); if (((DIL_MASK) >> 11) & 1) { const unsigned long long w_ = (t1_ - tprev) * (DIL_MUL); while (__builtin_amdgcn_s_memrealtime() - t1_ < w_) __builtin_amdgcn_s_sleep(8); t1_ = __builtin_amdgcn_s_memrealtime(); } tprev = t1_; }
#endif
        {
            if (tid == 0) { MISC[2] = (unsigned)__builtin_amdgcn_s_getreg((3 << 11) | 20) & 7u; MISC[3] = 0u; }
            for (;;) {
                if (tid == 0) { unsigned qi = MISC[3], u = 0xffffffffu;
                    while (qi < 8u) { const unsigned qx = (MISC[2] + qi) & 7u; const unsigned v = atomicAdd(ctl + 64 + 16 * qx, 1u); if (v < 256u) { u = qx * 256u + v; break; } ++qi; }
                    MISC[3] = qi; MISC[0] = u; }
                LBAR();
                const unsigned u = MISC[0];
                LBAR();
                if (u == 0xffffffffu) break;
                const int bh = (int)(u >> 5), qb = 31 - (int)(u & 31); int tq = tid; asm volatile("" : "+v"(tq));
#ifndef NO_FOX
                attn_body::attn_unit<100>(bh >> 3, bh & 7, qb, (const attn_body::bf16*)(Zb + ZC_FXQ), (const attn_body::bf16*)(Zb + ZC_FXK), (const attn_body::bf16*)(Zb + ZC_FXV),
                                        (attn_body::bf16*)(MIX + 512), CNEG + (size_t)bh * SEQ, (char*)lds, tq);
#endif
            }
        }
    }
    SEAM(3);
    if (IN(4)) {
        pg8::Gemm g{MIX, Wout_t, M, D, D}; pg8::StaticOrder S; S.init(M, D, G, bid);
        pg8::EpiRes E{x, out, XN, ln_x, SS1};
        pg8::gemm_phase<pg8::EpiRes, pg8::StaticOrder, true, true>(L, g, S, E, tid);
    }
    SEAM(4);
    if (IN(5)) {
        pg8::Gemm g{XN, Wxq_t, M, D, D}; pg8::StaticOrder S; S.init(M, D, G, bid);
        pg8::EpiRowScale<0> E{MIX, 1024, SS1, C2_X};
        pg8::gemm_phase<pg8::EpiRowScale<0>, pg8::StaticOrder, true, true>(L, g, S, E, tid);
    }
    SEAM(5);
    if (IN(6)) {
#ifndef NO_XA
        for (int u = bid; u < 1024; u += G) xa::xattn_unit(u >> 2, u & 3, MIX, KX, VXT, L, tid);
#endif
    }
    SEAM(6);
    if (IN(7)) {
        pg8::Gemm g{MIX, Wxo_t, M, D, D}; pg8::StaticOrder S; S.init(M, D, G, bid);
        pg8::EpiRes E{out, out, XN, ln2, SS2};
        pg8::gemm_phase<pg8::EpiRes, pg8::StaticOrder, true, true>(L, g, S, E, tid);
    }
    SEAM(7);
    if (IN(8)) {
        pg8::Gemm g{XN, W1_t, M, FF, D}; pg8::StaticOrder S; S.init(M, FF, G, bid);
        pg8::EpiRowScale<1> E{Ub, FF, SS2, 1.0f};
        pg8::gemm_phase<pg8::EpiRowScale<1>, pg8::StaticOrder, true, true>(L, g, S, E, tid);
    }
    SEAM(8);
    if (IN(9)) {
        pg8::Gemm g{Ub, W2_t, M, D, FF}; pg8::StaticOrder S; S.init(M, D, G, bid);
        if (G == 256) {
            pg8::EpiResNorm E{out, out, ln_f, SS3, ctl + 4096};
            pg8::gemm_phase<pg8::EpiResNorm, pg8::StaticOrder, true, true>(L, g, S, E, tid);
        } else {
            pg8::EpiRes E{out, out, nullptr, nullptr, SS3};
            pg8::gemm_phase<pg8::EpiRes, pg8::StaticOrder, true, true>(L, g, S, E, tid);
            xcd_barrier(xbar);
            const int gw = bid * NWAVES + wave, NGW = G * NWAVES;
            for (int m = gw; m < M; m += NGW) { const float r = pg8::row_rs(SS3, m); f32x4* p = (f32x4*)(out + (size_t)m * D) + lane;
#pragma unroll
                for (int j = 0; j < 4; ++j) p[64 * j] = p[64 * j] * ((const f32x4*)ln_f)[lane + 64 * j] * r; }
        }
    }
    SEAM(9);
#undef IN
#undef SEAM
}
#undef x
#undef mem
#undef ln1
#undef w_in
#undef conv_w
#undef conv_b
#undef ml_b_i
#undef ml_b_f
#undef ml_norm
#undef fx_b_f
#undef w_out
#undef ln_x
#undef ln_mem
#undef w_xq
#undef w_xkv
#undef w_xo
#undef ln2
#undef w_ff1
#undef w_ff2
#undef ln_f
#undef ctl
#undef Win_t
#undef Wout_t
#undef Wxq_t
#undef Wxkv_t
#undef Wxo_t
#undef W1_t
#undef W2_t
#undef MEMN
#undef KX
#undef VXT
#undef GT
#undef CNEG
#undef SS1
#undef SS2
#undef SS3
#undef XN
#undef MIX
#undef Zb
#undef Ub

#ifndef MK_SPLIT
#define MK_SPLIT 0
#endif
extern "C" void kernel_launch(void* const* d_in, const int* in_sizes, int n_in, void* d_out, int out_size, void* d_ws, size_t ws_size, hipStream_t stream) {
    static int grid = 0;
    if (grid == 0) {
        if (n_in != 20 || out_size != M * D || ws_size < WS_END) { fprintf(stderr, "kernel_launch: unexpected problem (n_in %d out %d ws %zu)\n", n_in, out_size, ws_size); grid = -1; return; }
        int dev = 0, cus = 0, per_cu = 0;
        hipGetDevice(&dev); hipDeviceGetAttribute(&cus, hipDeviceAttributeMultiprocessorCount, dev);
        if (hipFuncSetAttribute((const void*)mk_fwd, hipFuncAttributeMaxDynamicSharedMemorySize, LDS_BYTES) != hipSuccess) { fprintf(stderr, "kernel_launch: hipFuncSetAttribute failed\n"); grid = -1; return; }
        if (hipOccupancyMaxActiveBlocksPerMultiprocessor(&per_cu, (const void*)mk_fwd, NWAVES * 64, LDS_BYTES) != hipSuccess || per_cu < 1) { fprintf(stderr, "kernel_launch: occupancy query says %d\n", per_cu); per_cu = 1; }
        (void)hipGetLastError();
        grid = cus;
        if (grid > 256) grid = 256;
    }
    if (grid < 0) return;
    hipMemsetAsync((char*)d_ws + WS_CTL, 0, CTL_ZERO_BYTES, stream);
    Args a{};
    for (int i = 0; i < 20; ++i) a.in[i] = (const float*)d_in[i];
    a.out = (float*)d_out; a.ws = (unsigned char*)d_ws;
#if MK_SPLIT
    for (int p = 0; p < N_PHASES; ++p) { a.ph_lo = p; a.ph_hi = p + 1; a.coop = 0; hipLaunchKernelGGL(mk_fwd, dim3(grid), dim3(NWAVES * 64), LDS_BYTES, stream, a); }
#else
    a.ph_lo = 0; a.ph_hi = N_PHASES; a.coop = 1;
    void* kargs[] = {&a};
    hipError_t e = hipLaunchCooperativeKernel((const void*)mk_fwd, dim3(grid), dim3(NWAVES * 64), kargs, LDS_BYTES, stream);
    if (e != hipSuccess) fprintf(stderr, "cooperative launch failed: %s (grid %d)\n", hipGetErrorString(e), grid);
#endif
}
```

```cpp
#include <hip/hip_runtime.h>
#include <hip/hip_cooperative_groups.h>
#include <hip/hip_bf16.h>
#include <cstdio>
#include <cstdint>
#include <cmath>
namespace cg = cooperative_groups;
namespace pg8 {
#define PG8_LAS __attribute__((address_space(3)))
typedef unsigned short bf16_t;
typedef short bf16x8 __attribute__((ext_vector_type(8)));
typedef float f32x4 __attribute__((ext_vector_type(4)));
typedef unsigned u32x4 __attribute__((ext_vector_type(4)));
constexpr int BM = 256, BK = 64, HALF = 128, HTB = HALF * BK * 2  , STAGE_BYTES = 8 * HTB, NXCD = 8, WGM = 8;

__host__ __device__ __forceinline__ int lds_byte(int r, int c) { const int st = (r >> 4) * 2 + (c >> 5), rr = r & 15, cc = c & 31, ob = rr * 64 + cc * 2; return st * 1024 + (ob ^ (((ob >> 9) & 1) << 5)); }
__host__ __device__ __forceinline__ void stage_rc(int b, int& R, int& C) { const int st = b / 1024, sb = b % 1024, swz = sb ^ (((sb >> 9) & 1) << 5); R = (st >> 1) * 16 + swz / 64; C = (st & 1) * 32 + (swz % 64) / 2; }
__host__ __device__ __forceinline__ int perm32(int rho) { const int n = rho >> 4, i = rho & 15; return 8 * (i >> 2) + 4 * n + (i & 3); }

struct Unit { int pm, pn; };
struct Gemm { const bf16_t* A; const bf16_t* Bt; int M, N, K; };

struct StaticOrder {
    int nM, nN, nwg, G, c;
    __host__ __device__ void init(int M, int N, int G_, int c_) { nM = M / BM; nN = N / BM; nwg = nM * nN; G = G_; c = c_; }
    __host__ __device__ bool next(int i, Unit& u) const {
        const long L = (long)i * G + c; if (L >= nwg) return false;
        int wgid = (int)L; { const int q = nwg / NXCD, r = nwg % NXCD, xcd = wgid % NXCD, off = wgid / NXCD; wgid = (xcd < r ? xcd * (q + 1) : r * (q + 1) + (xcd - r) * q) + off; }
        const int nig = WGM * nN, gid = wgid / nig, fm = gid * WGM, gsz = (nM - fm) < WGM ? (nM - fm) : WGM;
        u.pm = fm + ((wgid % nig) % gsz); u.pn = (wgid % nig) / gsz; return true;
    }
    __device__ __forceinline__ void a_ready(const Unit&) const {}
    __device__ __forceinline__ void done(const Unit&) const {}
};

__device__ __forceinline__ unsigned cvt_pk_bf16(float lo, float hi) { unsigned r; asm volatile("v_cvt_pk_bf16_f32 %0, %1, %2" : "=v"(r) : "v"(lo), "v"(hi)); return r; }
typedef float f32x2 __attribute__((ext_vector_type(2)));
typedef unsigned u32x2 __attribute__((ext_vector_type(2)));
constexpr float RMS_EPS = 1e-6f;
__device__ __forceinline__ float row_rs(const float* ss, int row) {
    const f32x4* p = (const f32x4*)(ss + (size_t)row * 16);
    const f32x4 a = p[0], b = p[1], c = p[2], d = p[3];
    const float s = ((a[0] + a[1]) + (a[2] + a[3])) + ((b[0] + b[1]) + (b[2] + b[3])) + ((c[0] + c[1]) + (c[2] + c[3])) + ((d[0] + d[1]) + (d[2] + d[3]));
    return 1.0f / sqrtf(s * (1.0f / 1024.0f) + RMS_EPS);
}
struct EpiZ {
    static constexpr bool PERM = true, AFTER_DRAIN = false;
    bf16_t* Z; float* G; float c2;
    __device__ __forceinline__ void operator()(const f32x4 (&acc)[2][2][4][2], const Unit& u, int wr, int wc, int fr, int fq) const {
        const int row0 = u.pm * BM + wr * 64 + fr;
        if (u.pn < 14) {
            const float sc = (u.pn == 8 || u.pn == 9) ? c2 : 1.0f;
            const int col0 = u.pn * BM + wc * 32 + 8 * fq;
#pragma unroll
            for (int ai = 0; ai < 2; ++ai)
#pragma unroll
                for (int m = 0; m < 4; ++m) { bf16_t* rowp = Z + (size_t)(row0 + ai * HALF + m * 16) * 3584 + col0;
#pragma unroll
                    for (int bj = 0; bj < 2; ++bj) { const f32x4 v0 = acc[ai][bj][m][0] * sc, v1 = acc[ai][bj][m][1] * sc;
                        u32x4 w; w.x = cvt_pk_bf16(v0[0], v0[1]); w.y = cvt_pk_bf16(v0[2], v0[3]); w.z = cvt_pk_bf16(v1[0], v1[1]); w.w = cvt_pk_bf16(v1[2], v1[3]);
                        *(u32x4*)(rowp + bj * HALF) = w; } }
        } else if (wc == 0 && fq < 2) {
#pragma unroll
            for (int ai = 0; ai < 2; ++ai)
#pragma unroll
                for (int m = 0; m < 4; ++m) { float* gp = G + (size_t)(row0 + ai * HALF + m * 16) * 16 + 8 * fq;
                    *(f32x4*)(gp) = acc[ai][0][m][0]; *(f32x4*)(gp + 4) = acc[ai][0][m][1]; }
        }
    }
};
struct EpiPlain {
    static constexpr bool PERM = true, AFTER_DRAIN = false;
    bf16_t* O; int ldc;
    __device__ __forceinline__ void operator()(const f32x4 (&acc)[2][2][4][2], const Unit& u, int wr, int wc, int fr, int fq) const {
        const int row0 = u.pm * BM + wr * 64 + fr; const int col0 = u.pn * BM + wc * 32 + 8 * fq;
#pragma unroll
        for (int ai = 0; ai < 2; ++ai)
#pragma unroll
            for (int m = 0; m < 4; ++m) { bf16_t* rowp = O + (size_t)(row0 + ai * HALF + m * 16) * ldc + col0;
#pragma unroll
                for (int bj = 0; bj < 2; ++bj) { const f32x4 v0 = acc[ai][bj][m][0], v1 = acc[ai][bj][m][1];
                    u32x4 w; w.x = cvt_pk_bf16(v0[0], v0[1]); w.y = cvt_pk_bf16(v0[2], v0[3]); w.z = cvt_pk_bf16(v1[0], v1[1]); w.w = cvt_pk_bf16(v1[2], v1[3]);
                    *(u32x4*)(rowp + bj * HALF) = w; } }
    }
};
template <int ACT> struct EpiRowScale {
    static constexpr bool PERM = true, AFTER_DRAIN = false;
    bf16_t* O; int ldc; const float* ss; float sc;
    __device__ __forceinline__ void operator()(const f32x4 (&acc)[2][2][4][2], const Unit& u, int wr, int wc, int fr, int fq) const {
        const int row0 = u.pm * BM + wr * 64 + fr; const int col0 = u.pn * BM + wc * 32 + 8 * fq;
#pragma unroll
        for (int ai = 0; ai < 2; ++ai)
#pragma unroll
            for (int m = 0; m < 4; ++m) { const int row = row0 + ai * HALF + m * 16; const float r = row_rs(ss, row) ; bf16_t* rowp = O + (size_t)row * ldc + col0;
#pragma unroll
                for (int bj = 0; bj < 2; ++bj) { f32x4 v0 = acc[ai][bj][m][0] * r, v1 = acc[ai][bj][m][1] * r;
                    if (ACT == 1) {
#pragma unroll
                        for (int e = 0; e < 4; ++e) { const float a = fmaxf(v0[e], 0.f), b = fmaxf(v1[e], 0.f); v0[e] = a * a; v1[e] = b * b; }
                    } else { v0 = v0 * sc; v1 = v1 * sc; }
                    u32x4 w; w.x = cvt_pk_bf16(v0[0], v0[1]); w.y = cvt_pk_bf16(v0[2], v0[3]); w.z = cvt_pk_bf16(v1[0], v1[1]); w.w = cvt_pk_bf16(v1[2], v1[3]);
                    *(u32x4*)(rowp + bj * HALF) = w; } }
    }
};
struct EpiRes {
    static constexpr bool PERM = true, AFTER_DRAIN = false;
    const float* base; float* out; bf16_t* xn; const float* gain; float* ssout;
    __device__ __forceinline__ void operator()(const f32x4 (&acc)[2][2][4][2], const Unit& u, int wr, int wc, int fr, int fq) const {
        const int row0 = u.pm * BM + wr * 64 + fr; const int col0 = u.pn * BM + wc * 32 + 8 * fq;
        f32x4 gv[2][2];
#pragma unroll
        for (int bj = 0; bj < 2; ++bj)
#pragma unroll
            for (int n = 0; n < 2; ++n) { if (xn) gv[bj][n] = *(const f32x4*)(gain + col0 + bj * HALF + n * 4); else gv[bj][n] = (f32x4){1.f, 1.f, 1.f, 1.f}; }
#pragma unroll
        for (int ai = 0; ai < 2; ++ai) {
            f32x4 bs[4][2][2];
#pragma unroll
            for (int m = 0; m < 4; ++m) { const size_t off = (size_t)(row0 + ai * HALF + m * 16) * 1024 + col0;
#pragma unroll
                for (int bj = 0; bj < 2; ++bj) { bs[m][bj][0] = *(const f32x4*)(base + off + bj * HALF); bs[m][bj][1] = *(const f32x4*)(base + off + bj * HALF + 4); } }
#pragma unroll
            for (int m = 0; m < 4; ++m) { const int row = row0 + ai * HALF + m * 16; const size_t off = (size_t)row * 1024 + col0; float sq = 0.f;
#pragma unroll
                for (int bj = 0; bj < 2; ++bj) {
                    const f32x4 o0 = bs[m][bj][0] + acc[ai][bj][m][0], o1 = bs[m][bj][1] + acc[ai][bj][m][1];
                    *(f32x4*)(out + off + bj * HALF) = o0; *(f32x4*)(out + off + bj * HALF + 4) = o1;
                    sq += ((o0[0] * o0[0] + o0[1] * o0[1]) + (o0[2] * o0[2] + o0[3] * o0[3])) + ((o1[0] * o1[0] + o1[1] * o1[1]) + (o1[2] * o1[2] + o1[3] * o1[3]));
                    if (xn) { const f32x4 g0 = o0 * gv[bj][0], g1 = o1 * gv[bj][1]; u32x4 w; w.x = cvt_pk_bf16(g0[0], g0[1]); w.y = cvt_pk_bf16(g0[2], g0[3]); w.z = cvt_pk_bf16(g1[0], g1[1]); w.w = cvt_pk_bf16(g1[2], g1[3]);
                        *(u32x4*)(xn + off + bj * HALF) = w; } }
                sq += __shfl_xor(sq, 16); sq += __shfl_xor(sq, 32);
                if (fq == 0) ssout[(size_t)row * 16 + u.pn * 4 + wc] = sq; }
            asm volatile("" ::: "memory"); }
    }
};
struct EpiResNorm {
    static constexpr bool PERM = true, AFTER_DRAIN = false;
    const float* base; float* out; const float* gain; float* ss; unsigned* cnt;
    __device__ __forceinline__ void operator()(const f32x4 (&acc_c)[2][2][4][2], const Unit& u, int wr, int wc, int fr, int fq) const {
        f32x4 (&acc)[2][2][4][2] = const_cast<f32x4 (&)[2][2][4][2]>(acc_c);
        const int row0 = u.pm * BM + wr * 64 + fr; const int col0 = u.pn * BM + wc * 32 + 8 * fq;
#pragma unroll
        for (int ai = 0; ai < 2; ++ai)
#pragma unroll
            for (int m = 0; m < 4; ++m) { const int row = row0 + ai * HALF + m * 16; const size_t off = (size_t)row * 1024 + col0; float sq = 0.f;
#pragma unroll
                for (int bj = 0; bj < 2; ++bj) {
                    const f32x4 b0 = *(const f32x4*)(base + off + bj * HALF), b1 = *(const f32x4*)(base + off + bj * HALF + 4);
                    const f32x4 o0 = b0 + acc[ai][bj][m][0], o1 = b1 + acc[ai][bj][m][1];
                    acc[ai][bj][m][0] = o0; acc[ai][bj][m][1] = o1;
                    sq += ((o0[0] * o0[0] + o0[1] * o0[1]) + (o0[2] * o0[2] + o0[3] * o0[3])) + ((o1[0] * o1[0] + o1[1] * o1[1]) + (o1[2] * o1[2] + o1[3] * o1[3])); }
                sq += __shfl_xor(sq, 16); sq += __shfl_xor(sq, 32);
                if (fq == 0) __hip_atomic_store(ss + (size_t)row * 16 + u.pn * 4 + wc, sq, __ATOMIC_RELAXED, __HIP_MEMORY_SCOPE_AGENT);
                if (m == 3) asm volatile("" ::: "memory"); }
        asm volatile("s_waitcnt vmcnt(0)" ::: "memory");
        unsigned* c = cnt + 64 * u.pm;
        if ((fr | fq) == 0) __hip_atomic_fetch_add(c, 1u, __ATOMIC_RELAXED, __HIP_MEMORY_SCOPE_AGENT);
        { unsigned spins = 0;
          while ((unsigned)__builtin_amdgcn_readfirstlane(__hip_atomic_load(c, __ATOMIC_RELAXED, __HIP_MEMORY_SCOPE_AGENT)) < 32u) { __builtin_amdgcn_s_sleep(2); if (++spins > (1u << 22)) break; } }
        asm volatile("" ::: "memory");
        f32x4 gv[2][2];
#pragma unroll
        for (int bj = 0; bj < 2; ++bj)
#pragma unroll
            for (int n = 0; n < 2; ++n) gv[bj][n] = *(const f32x4*)(gain + col0 + bj * HALF + n * 4);
#pragma unroll
        for (int ai = 0; ai < 2; ++ai)
#pragma unroll
            for (int m = 0; m < 4; ++m) { const int row = row0 + ai * HALF + m * 16; const size_t off = (size_t)row * 1024 + col0;
                const unsigned long long* sp = (const unsigned long long*)(ss + (size_t)row * 16); float tot = 0.f;
#pragma unroll
                for (int k = 0; k < 8; ++k) { const unsigned long long v = __hip_atomic_load(sp + k, __ATOMIC_RELAXED, __HIP_MEMORY_SCOPE_AGENT); tot += __uint_as_float((unsigned)v) + __uint_as_float((unsigned)(v >> 32)); }
                const float r = 1.0f / sqrtf(tot * (1.0f / 1024.0f) + RMS_EPS);
#pragma unroll
                for (int bj = 0; bj < 2; ++bj) { *(f32x4*)(out + off + bj * HALF) = acc[ai][bj][m][0] * gv[bj][0] * r; *(f32x4*)(out + off + bj * HALF + 4) = acc[ai][bj][m][1] * gv[bj][1] * r; }
                asm volatile("" ::: "memory"); }
    }
};
template <class Epi, class Sched, bool ALIGN_EPI = false, bool SP2 = false>
__device__ __forceinline__ void gemm_phase(PG8_LAS unsigned char* lds, const Gemm g, const Sched& S, const Epi& E, const int tid_in) {
    const int tid = tid_in, wid = __builtin_amdgcn_readfirstlane(tid >> 6), lane = tid & 63, wr = wid >> 2, wc = wid & 3, fr = lane & 15, fq = lane >> 4;
    const int K = g.K, nt = K / BK;
    unsigned voffA[2], voffB[2];
#pragma unroll
    for (int i = 0; i < 2; ++i) { int R, C; stage_rc(tid * 16 + i * 8192, R, C); const int Rb = Epi::PERM ? ((R & ~31) + perm32(R & 31)) : R;
        voffA[i] = (unsigned)(R * K + C) * 2u; voffB[i] = (unsigned)(Rb * K + C) * 2u; }
    const size_t kstep = (size_t)(BK * 2);
    const size_t hstep = (size_t)HALF * K * 2;
    const size_t tstep = 2 * hstep;
    const unsigned ldsw = (unsigned)wid * 1024u;
    const int aoff = lds_byte(wr * 64 + fr, fq * 8), boff = lds_byte(wc * 32 + fr, fq * 8);
#define PG8_SA(b, h) (((b) * 2 + (h)) * HTB)
#define PG8_SB(b, h) ((4 + (b) * 2 + (h)) * HTB)
#define PG8_STAGE(bufoff, gbase, voff) do { _Pragma("unroll") for (int _i = 0; _i < 2; ++_i) \
        __builtin_amdgcn_global_load_lds((const unsigned*)((const char*)(gbase) + (voff)[_i]), (PG8_LAS unsigned*)(lds + (bufoff) + ldsw + _i * 8192), 16, 0, 0); } while (0)
#define PG8_LDA(dst, b, h) do { _Pragma("unroll") for (int m = 0; m < 4; ++m) _Pragma("unroll") for (int k = 0; k < 2; ++k) dst[m][k] = *(const PG8_LAS bf16x8*)(lds + PG8_SA(b, h) + aoff + m * 2048 + k * 1024); } while (0)
#define PG8_LDB(dst, b, h) do { _Pragma("unroll") for (int n = 0; n < 2; ++n) _Pragma("unroll") for (int k = 0; k < 2; ++k) dst[n][k] = *(const PG8_LAS bf16x8*)(lds + PG8_SB(b, h) + boff + n * 2048 + k * 1024); } while (0)
#define PG8_MMA(ai, bj, At, Bt) do { __builtin_amdgcn_s_setprio(1); _Pragma("unroll") for (int m = 0; m < 4; ++m) _Pragma("unroll") for (int n = 0; n < 2; ++n) _Pragma("unroll") for (int k = 0; k < 2; ++k) \
        acc[ai][bj][m][n] = __builtin_amdgcn_mfma_f32_16x16x32_bf16(Bt[n][k], At[m][k], acc[ai][bj][m][n], 0, 0, 0); __builtin_amdgcn_s_setprio(0); } while (0)
#define PG8_WAIT_V(n) asm volatile("s_waitcnt vmcnt(" #n ")" ::: "memory")
#define PG8_WAIT_L(n) asm volatile("s_waitcnt lgkmcnt(" #n ")" ::: "memory")
#define PG8_BAR __builtin_amdgcn_s_barrier()
#define PG8_SCHED __builtin_amdgcn_sched_barrier(0)
    Unit cur, nxt; int ui = 0;
    if (!S.next(0, cur)) return;
    f32x4 acc[2][2][4][2];
#pragma unroll
    for (int a = 0; a < 2; ++a)
#pragma unroll
        for (int b = 0; b < 2; ++b)
#pragma unroll
            for (int m = 0; m < 4; ++m)
#pragma unroll
                for (int n = 0; n < 2; ++n) acc[a][b][m][n] = (f32x4){0.f, 0.f, 0.f, 0.f};
    bf16x8 At[4][2], B0[2][2], B1[2][2];
    const char* cA = (const char*)g.A + (size_t)cur.pm * tstep; const char* cB = (const char*)g.Bt + (size_t)cur.pn * tstep;
    S.a_ready(cur);
    if constexpr (SP2) {
        PG8_STAGE(PG8_SB(0, 0), cB, voffB); PG8_STAGE(PG8_SB(0, 1), cB + hstep, voffB); PG8_STAGE(PG8_SA(0, 0), cA, voffA); PG8_STAGE(PG8_SA(0, 1), cA + hstep, voffA);
        if (wr == 1) PG8_BAR;
        PG8_WAIT_V(2); PG8_BAR;
        PG8_STAGE(PG8_SB(1, 0), cB + kstep, voffB); PG8_STAGE(PG8_SA(1, 0), cA + kstep, voffA); PG8_STAGE(PG8_SB(1, 1), cB + hstep + kstep, voffB);
        PG8_WAIT_V(6); PG8_BAR;
    } else {
        PG8_STAGE(PG8_SB(0, 0), cB, voffB); PG8_STAGE(PG8_SA(0, 0), cA, voffA); PG8_STAGE(PG8_SB(0, 1), cB + hstep, voffB); PG8_STAGE(PG8_SA(0, 1), cA + hstep, voffA);
        if (wr == 1) PG8_BAR;
        PG8_WAIT_V(4); PG8_BAR;
        PG8_STAGE(PG8_SB(1, 0), cB + kstep, voffB); PG8_STAGE(PG8_SA(1, 0), cA + kstep, voffA); PG8_STAGE(PG8_SB(1, 1), cB + hstep + kstep, voffB);
        PG8_WAIT_V(6); PG8_BAR;
    }
    for (;;) {
        const bool has_next = S.next(ui + 1, nxt);
        const char* nA = has_next ? (const char*)g.A + (size_t)nxt.pm * tstep : cA; const char* nB = has_next ? (const char*)g.Bt + (size_t)nxt.pn * tstep : cB;
        for (int t = 0; t < nt; t += 2) {
            const bool last = (t == nt - 2);
            const char* a1 = cA + (size_t)(t + 1) * kstep;
            const char* a2 = last ? nA : cA + (size_t)(t + 2) * kstep; const char* b2 = last ? nB : cB + (size_t)(t + 2) * kstep;
            const char* a3 = a2 + kstep; const char* b3 = b2 + kstep;
            if (last && has_next) S.a_ready(nxt);
            if constexpr (SP2) {
            PG8_LDB(B0, 0, 0); PG8_LDB(B1, 0, 1); PG8_SCHED; PG8_LDA(At, 0, 0); PG8_STAGE(PG8_SA(1, 1), a1 + hstep, voffA);
            PG8_WAIT_V(8); PG8_WAIT_L(0); PG8_BAR; PG8_MMA(0, 0, At, B0); PG8_MMA(0, 1, At, B1); PG8_BAR; PG8_SCHED;
            PG8_LDA(At, 0, 1); PG8_STAGE(PG8_SB(0, 0), b2, voffB); PG8_STAGE(PG8_SB(0, 1), b2 + hstep, voffB); PG8_STAGE(PG8_SA(0, 0), a2, voffA);
            PG8_WAIT_V(8); PG8_WAIT_L(0); PG8_BAR; PG8_MMA(1, 0, At, B0); PG8_MMA(1, 1, At, B1); PG8_BAR; PG8_SCHED;
            PG8_LDB(B0, 1, 0); PG8_LDB(B1, 1, 1); PG8_SCHED; PG8_LDA(At, 1, 0); PG8_STAGE(PG8_SA(0, 1), a2 + hstep, voffA);
            PG8_WAIT_V(8); PG8_WAIT_L(0); PG8_BAR; PG8_MMA(0, 0, At, B0); PG8_MMA(0, 1, At, B1); PG8_BAR; PG8_SCHED;
            PG8_LDA(At, 1, 1); PG8_STAGE(PG8_SB(1, 0), b3, voffB); PG8_STAGE(PG8_SB(1, 1), b3 + hstep, voffB); PG8_STAGE(PG8_SA(1, 0), a3, voffA);
            PG8_WAIT_V(8); PG8_WAIT_L(0); PG8_BAR; PG8_MMA(1, 0, At, B0); PG8_MMA(1, 1, At, B1); PG8_BAR; PG8_SCHED;
            } else {
            PG8_LDB(B0, 0, 0); PG8_SCHED; PG8_LDA(At, 0, 0); PG8_STAGE(PG8_SA(1, 1), a1 + hstep, voffA);
            PG8_WAIT_L(8); PG8_BAR; PG8_WAIT_L(0); PG8_MMA(0, 0, At, B0); PG8_BAR; PG8_SCHED;
            PG8_LDB(B1, 0, 1); PG8_STAGE(PG8_SB(0, 0), b2, voffB);
            PG8_BAR; PG8_WAIT_L(0); PG8_MMA(0, 1, At, B1); PG8_BAR;
            PG8_LDA(At, 0, 1); PG8_STAGE(PG8_SA(0, 0), a2, voffA);
            PG8_BAR; PG8_WAIT_L(0); PG8_MMA(1, 0, At, B0); PG8_BAR; PG8_SCHED;
            PG8_STAGE(PG8_SB(0, 1), b2 + hstep, voffB);
            PG8_WAIT_V(6); PG8_BAR; PG8_MMA(1, 1, At, B1); PG8_BAR;
            PG8_LDB(B0, 1, 0); PG8_SCHED; PG8_LDA(At, 1, 0); PG8_STAGE(PG8_SA(0, 1), a2 + hstep, voffA);
            PG8_WAIT_L(8); PG8_BAR; PG8_WAIT_L(0); PG8_MMA(0, 0, At, B0); PG8_BAR; PG8_SCHED;
            PG8_LDB(B1, 1, 1); PG8_STAGE(PG8_SB(1, 0), b3, voffB);
            PG8_BAR; PG8_WAIT_L(0); PG8_MMA(0, 1, At, B1); PG8_BAR;
            PG8_LDA(At, 1, 1); PG8_STAGE(PG8_SA(1, 0), a3, voffA);
            PG8_BAR; PG8_WAIT_L(0); PG8_MMA(1, 0, At, B0); PG8_BAR; PG8_SCHED;
            PG8_STAGE(PG8_SB(1, 1), b3 + hstep, voffB);
            PG8_WAIT_V(6); PG8_BAR; PG8_MMA(1, 1, At, B1); PG8_BAR;
            }
        }
        if constexpr (ALIGN_EPI) { if (wr == 0) PG8_BAR; }
        if constexpr (!Epi::AFTER_DRAIN) { E(acc, cur, wr, wc, fr, fq); S.done(cur); }
        if (!has_next) break;
#pragma unroll
        for (int a = 0; a < 2; ++a)
#pragma unroll
            for (int b = 0; b < 2; ++b)
#pragma unroll
                for (int m = 0; m < 4; ++m)
#pragma unroll
                    for (int n = 0; n < 2; ++n) acc[a][b][m][n] = (f32x4){0.f, 0.f, 0.f, 0.f};
        cur = nxt; cA = nA; cB = nB; ++ui;
        if constexpr (ALIGN_EPI) { if (wr == 1) PG8_BAR; }
    }
    PG8_WAIT_V(0);
    if constexpr (!ALIGN_EPI) { if (wr == 0) PG8_BAR; }
    PG8_BAR;
    if constexpr (Epi::AFTER_DRAIN) { E.fused(acc, cur, wr, wc, fr, fq, lds, wid, lane); S.done(cur); }
#undef PG8_SA
#undef PG8_SB
#undef PG8_STAGE
#undef PG8_LDA
#undef PG8_LDB
#undef PG8_MMA
#undef PG8_WAIT_V
#undef PG8_WAIT_L
#undef PG8_BAR
#undef PG8_SCHED
}
}
#include <hip/hip_bf16.h>
#include <cmath>
namespace attn_body {
using bf16=__hip_bfloat16;
using bf16x8=__attribute__((ext_vector_type(8)))short;
using s16x4=__attribute__((ext_vector_type(4)))short;
using f32x16=__attribute__((ext_vector_type(16)))float;
using u32x4=__attribute__((ext_vector_type(4)))unsigned;
using f32x4_t=__attribute__((ext_vector_type(4)))float;
constexpr int BATCH=8,NHEAD=8,SEQ=8192,D=64,DM=3584,DMO=1024;
constexpr int NW=8,QBLK=32,QB=QBLK*NW,KVBLK=64,NQB=SEQ/QB;
constexpr int ATTN_PITCH=DM, ATTN_UNIT_ROWS=QB;
__device__ __forceinline__ int crow(int r,int hi){return (r&3)+8*(r>>2)+4*hi;}
#define SBAR() __builtin_amdgcn_sched_barrier(0)
__device__ __forceinline__ void cmask(f32x16&p0,f32x16&p1,int jb,int qrel,int hi){
  const float NEG=-INFINITY; int dq=qrel-64*jb-4*hi; asm volatile("":"+v"(dq));
  #pragma unroll
  for(int r=0;r<16;++r){const int c=(r&3)+8*(r>>2); if(c>dq)p0[r]=NEG; if(c+32>dq)p1[r]=NEG;}
}

constexpr int NSLOT=3, SLOTB=8192;
constexpr int LDS_K=0, LDS_V=NSLOT*SLOTB, LDS_WS=2*NSLOT*SLOTB, LDS_OST=LDS_WS+NW*64*4, LDS_CN=LDS_OST+NW*4096, LDS_BYTES=LDS_CN+SEQ*4;
constexpr float C2=0.125f*1.4426950408889634f;
__device__ __forceinline__ void glds16(const void*gsrc,unsigned lds_dst){unsigned keep;
  asm volatile("s_mov_b32 %0, m0\n\ts_mov_b32 m0, %2\n\ts_nop 0\n\tglobal_load_lds_dwordx4 %1, off\n\ts_mov_b32 m0, %0":"=&s"(keep):"v"(gsrc),"s"(lds_dst):"memory");}
__device__ __forceinline__ float max3f(float a,float b,float c){float r;asm("v_max3_f32 %0, %1, %2, %3":"=v"(r):"v"(a),"v"(b),"v"(c));return r;}
__device__ __forceinline__ float max2f(float a,float b){float r;asm("v_max_f32_e32 %0, %1, %2":"=v"(r):"v"(a),"v"(b));return r;}
__device__ __forceinline__ float fadd_s(float a,float b){float r;asm("v_add_f32_e32 %0, %1, %2":"=v"(r):"v"(a),"v"(b));return r;}
__device__ __forceinline__ float fsub_s(float a,float b){float r;asm("v_sub_f32_e32 %0, %1, %2":"=v"(r):"v"(a),"v"(b));return r;}
typedef float f32x2_t __attribute__((ext_vector_type(2))); typedef __bf16 bf16x2_t __attribute__((ext_vector_type(2)));
__device__ __forceinline__ unsigned cvtpk_s(float lo,float hi){f32x2_t v={lo,hi};bf16x2_t b=__builtin_convertvector(v,bf16x2_t);return __builtin_bit_cast(unsigned,b);}
#define WAIT_BAR(N) asm volatile("s_waitcnt vmcnt(" #N ") lgkmcnt(0)\n\ts_barrier":::"memory")

__device__ __forceinline__ void qkt(f32x16&p0,f32x16&p1,const char*Kslot,const bf16x8*qr,int r32,int hi){
  const char*kb=Kslot+hi*1024+r32*16;
  #pragma unroll
  for(int d0=0;d0<4;++d0){
    const bf16x8 b0=*reinterpret_cast<const bf16x8*>(kb+d0*2048);
    const bf16x8 b1=*reinterpret_cast<const bf16x8*>(kb+d0*2048+512);
    {p0=__builtin_amdgcn_mfma_f32_32x32x16_bf16(b0,qr[d0],p0,0,0,0);p1=__builtin_amdgcn_mfma_f32_32x32x16_bf16(b1,qr[d0],p1,0,0,0);}}
}
typedef __attribute__((address_space(3))) const char* lds_cptr;
typedef short v4i16_t __attribute__((ext_vector_type(4)));
__device__ __forceinline__ void kload8(bf16x8*kf,lds_cptr kp){
  kf[0]=*(const __attribute__((address_space(3))) bf16x8*)(kp);      kf[1]=*(const __attribute__((address_space(3))) bf16x8*)(kp+512);
  kf[2]=*(const __attribute__((address_space(3))) bf16x8*)(kp+2048); kf[3]=*(const __attribute__((address_space(3))) bf16x8*)(kp+2560);
  kf[4]=*(const __attribute__((address_space(3))) bf16x8*)(kp+4096); kf[5]=*(const __attribute__((address_space(3))) bf16x8*)(kp+4608);
  kf[6]=*(const __attribute__((address_space(3))) bf16x8*)(kp+6144); kf[7]=*(const __attribute__((address_space(3))) bf16x8*)(kp+6656);
}
__device__ __forceinline__ void kload2(bf16x8*kf,lds_cptr kp,int j){ kf[2*j]=*(const __attribute__((address_space(3))) bf16x8*)(kp+j*2048); kf[2*j+1]=*(const __attribute__((address_space(3))) bf16x8*)(kp+j*2048+512); }
__device__ __forceinline__ s16x4 vtr(lds_cptr p){ return __builtin_bit_cast(s16x4,__builtin_amdgcn_ds_read_tr16_b64_v4i16((__attribute__((address_space(3))) v4i16_t*)p)); }
__device__ __forceinline__ float rowmax(const f32x16&p0,const f32x16&p1){
  float a=max3f(p0[0],p0[1],p1[0]),b=max3f(p0[2],p0[3],p1[1]);a=max3f(a,p1[2],p1[3]);
  #pragma unroll
  for(int r=4;r<16;r+=4){a=max3f(a,p0[r],p0[r+1]);b=max3f(b,p0[r+2],p0[r+3]);a=max3f(a,p1[r],p1[r+1]);b=max3f(b,p1[r+2],p1[r+3]);}
  const float m=max2f(a,b);
  auto rr=__builtin_amdgcn_permlane32_swap(__float_as_uint(m),__float_as_uint(m),false,false);
  return max2f(__uint_as_float(rr[0]),__uint_as_float(rr[1]));
}
__device__ __forceinline__ void pv(f32x16*o,int vb,bf16x8 pa0,bf16x8 pa1,bf16x8 pa2,bf16x8 pa3){
  #pragma unroll
  for(int d0=0;d0<2;++d0){s16x4 lo[4],hi[4];
    #pragma unroll
    for(int ks=0;ks<4;++ks){
      asm volatile("ds_read_b64_tr_b16 %0,%1 offset:%c2":"=&v"(lo[ks]):"v"(vb),"i"(d0*4096+ks*1024):"memory");
      asm volatile("ds_read_b64_tr_b16 %0,%1 offset:%c2":"=&v"(hi[ks]):"v"(vb),"i"(d0*4096+ks*1024+512):"memory");}
    asm volatile("s_waitcnt lgkmcnt(0)":::"memory");SBAR();
    #define PK(k) (bf16x8){lo[k][0],lo[k][1],lo[k][2],lo[k][3],hi[k][0],hi[k][1],hi[k][2],hi[k][3]}
    o[d0]=__builtin_amdgcn_mfma_f32_32x32x16_bf16(pa0,PK(0),o[d0],0,0,0);
    o[d0]=__builtin_amdgcn_mfma_f32_32x32x16_bf16(pa1,PK(1),o[d0],0,0,0);
    o[d0]=__builtin_amdgcn_mfma_f32_32x32x16_bf16(pa2,PK(2),o[d0],0,0,0);
    o[d0]=__builtin_amdgcn_mfma_f32_32x32x16_bf16(pa3,PK(3),o[d0],0,0,0);
    #undef PK
  }
}

#ifndef ATTN_STORE16
#define ATTN_STORE16(p,v) (*(u32x4*)(p)=(v))
#endif
template<int THRL> __device__ __forceinline__ void attn_unit(int b,int h,int qb,const bf16*Q,const bf16*__restrict__ K,const bf16*__restrict__ V,bf16*O,const float*__restrict__ cng,char*shm,const int tid_in){
  const int tid=tid_in,lane=tid&63,r32=lane&31,hi=lane>>5; const int wid=__builtin_amdgcn_readfirstlane(tid>>6);
  const long rowbase=(long)b*SEQ; const int q0=qb*QB;
  typedef __attribute__((address_space(3))) float lds_f32; typedef __attribute__((address_space(3))) const f32x4_t lds_cf4;
  { lds_f32* cl=(lds_f32*)((__attribute__((address_space(3))) char*)shm+LDS_CN); const int ncn=q0+QB;
    for(int i=tid*4;i<ncn;i+=NW*64*4){ const f32x4_t v=*reinterpret_cast<const f32x4_t*>(cng+i); *(__attribute__((address_space(3))) f32x4_t*)(cl+i)=v; } }
  const __attribute__((address_space(3))) char* cnr=(const __attribute__((address_space(3))) char*)shm+LDS_CN+r32*4;
  #define BFRAG(F,x_) do{ const unsigned xb_=__float_as_uint(x_), xh_=xb_&0xffff0000u; const float r1_=(x_)-__uint_as_float(xh_); const unsigned mb_=__float_as_uint(r1_)&0xffff0000u; \
      const float r2_=r1_-__uint_as_float(mb_); u32x4 w_; w_.x=hi?0u:((xh_>>16)|mb_); w_.y=hi?0u:((__float_as_uint(r2_)>>16)|0x3f800000u); w_.z=hi?0u:0x3f803f80u; w_.w=0u; F=__builtin_bit_cast(bf16x8,w_); }while(0)
  #define BFR(t) do{ const float c0_=*(const __attribute__((address_space(3))) float*)(cnr+(t)*256), c1_=*(const __attribute__((address_space(3))) float*)(cnr+(t)*256+128); BFRAG(bfa,c0_); BFRAG(bfb,c1_); }while(0)
  #define MFRAG_SET() do{ const float x_=-mhat; const unsigned xb_=__float_as_uint(x_), xh_=xb_&0xffff0000u; const float r1_=x_-__uint_as_float(xh_); const unsigned mb_=__float_as_uint(r1_)&0xffff0000u; \
      const float r2_=r1_-__uint_as_float(mb_); u32x4 w_; w_.x=0x3f803f80u; w_.y=0x3f80u|xh_; w_.z=(mb_>>16)|(__float_as_uint(r2_)&0xffff0000u); w_.w=0u; mfrag=__builtin_bit_cast(bf16x8,w_); asm volatile("":"+v"(mfrag)); }while(0)
  const bf16*Qw=Q+(rowbase+q0+wid*QBLK)*DM+h*D;
  const bf16*Kh=K+rowbase*DM+h*D,*Vh=V+rowbase*DM+h*D;
  const unsigned lds0=(unsigned)(uintptr_t)shm;
  float*wsf=(float*)(shm+LDS_WS)+wid*64;
  const bf16*ksrc=Kh+(long)lane*DM+wid*8;
  const bf16*vsrc=Vh+(long)(16*(wid&3)+(lane>>2))*DM+(wid>>2)*32+(lane&3)*8;
  const unsigned kdst=lds0+LDS_K+wid*1024, vdst=lds0+LDS_V+wid*1024;
  #define DMA_K(t,slot) glds16(ksrc+(long)(t)*KVBLK*DM,(unsigned)__builtin_amdgcn_readfirstlane(kdst+(slot)))
  #define DMA_V(t,slot) glds16(vsrc+(long)(t)*KVBLK*DM,(unsigned)__builtin_amdgcn_readfirstlane(vdst+(slot)))
  const int vb0=(int)(lds0+LDS_V)+((lane>>4)&1)*32+(lane&3)*8+(4*hi+((lane&15)>>2))*64;
  const char*Kbase=shm+LDS_K; bf16x8 kf[8];
  const lds_cptr shm3=(lds_cptr)shm; const lds_cptr kp0=shm3+LDS_K+hi*1024+r32*16; const lds_cptr vp0=shm3+LDS_V+((lane>>4)&1)*32+(lane&3)*8+(4*hi+((lane&15)>>2))*64;
  const int NT=(q0+QB)/KVBLK;
  DMA_K(0,0);DMA_V(0,0);DMA_K(1,SLOTB);
  bf16x8 qr[4];
  #pragma unroll
  for(int d0=0;d0<4;++d0)qr[d0]=*reinterpret_cast<const bf16x8*>(&Qw[(long)r32*DM+d0*16+hi*8]);
  const __attribute__((address_space(3))) char* qlp=(const __attribute__((address_space(3))) char*)shm+LDS_OST+wid*4096+lane*16;
  #pragma unroll
  for(int d0=0;d0<4;++d0)*(__attribute__((address_space(3))) bf16x8*)(qlp+d0*1024)=qr[d0];
  #define QLD() do{ _Pragma("unroll") for(int d_=0;d_<4;++d_)qr[d_]=*(const __attribute__((address_space(3))) bf16x8*)(qlp+d_*1024); }while(0)
  float mhat=0.f,l_reg=0.f;f32x16 o[2];o[0]=f32x16{};o[1]=f32x16{};bf16x8 mfrag,bfa,bfb; const f32x16 zero16=f32x16{}; MFRAG_SET();
  const int qrel=wid*QBLK+r32;
  #define CMASK(P0,P1,t) do{int jb_=(t)-(NT-4); if(jb_>=0)cmask(P0,P1,jb_,qrel,hi);}while(0)
  bool resc=false;
  #define START(P0,P1) do{ const float rm=rowmax(P0,P1); resc=false; \
    { const float dl=rm; mhat=fadd_s(mhat,dl); \
      _Pragma("unroll") for(int r=0;r<16;++r){P0[r]=fsub_s(P0[r],dl);P1[r]=fsub_s(P1[r],dl);} \
      MFRAG_SET(); } \
    _Pragma("unroll") for(int r=0;r<16;++r)P0[r]=__builtin_amdgcn_exp2f(P0[r]); }while(0)
  #define RESC() do{ if(resc){ asm volatile("s_waitcnt lgkmcnt(0)":::"memory"); \
      _Pragma("unroll") for(int d_=0;d_<2;++d_) _Pragma("unroll") for(int r=0;r<16;++r)o[d_][r]*=wsf[crow(r,hi)]; } }while(0)
  f32x16 pA0,pA1,pB0,pB1;
  int sl_prev=0,sl_cur=0,sl_next=SLOTB;
  #define ROT() do{sl_prev=sl_cur;sl_cur=sl_next;sl_next=(sl_next==(NSLOT-1)*SLOTB)?0:sl_next+SLOTB;}while(0)
  DMA_K(2,2*SLOTB);
  WAIT_BAR(3);
  BFR(0); pA0=__builtin_amdgcn_mfma_f32_32x32x16_bf16(bfa,mfrag,zero16,0,0,0); pA1=__builtin_amdgcn_mfma_f32_32x32x16_bf16(bfb,mfrag,zero16,0,0,0);
  qkt(pA0,pA1,Kbase,qr,r32,hi);asm volatile("s_nop 15\n\ts_nop 7":"+v"(pA0),"+v"(pA1));CMASK(pA0,pA1,0);
  START(pA0,pA1);
  _Pragma("unroll") for(int r=0;r<16;++r)pA1[r]=__builtin_amdgcn_exp2f(pA1[r]);
  WAIT_BAR(0);
  DMA_K(3,0);DMA_V(1,SLOTB);
  ROT();
  kload8(kf,kp0+sl_cur);
  BFR(1);
  WAIT_BAR(2);
  s16x4 vlo[8],vhi[8]; u32x4 pw0,pw1,pw2,pw3;
  #define PKW(P,B) cvtpk_s(P[B],P[B+1])
  #define PAF(k) __builtin_bit_cast(bf16x8,pw##k)
  #define VFR(i) (bf16x8){vlo[i][0],vlo[i][1],vlo[i][2],vlo[i][3],vhi[i][0],vhi[i][1],vhi[i][2],vhi[i][3]}
  #define PIN(x) asm volatile("":"+v"(x))
  #define MX3(a,b,c) __builtin_fmaxf(__builtin_fmaxf((a),(b)),(c))
  #define GAPA(MF,A0,A1,A2,A3,W0,W1,PW) do{ MF; sacc+=A0; sacc+=A1; sacc+=A2; sacc+=A3; PIN(sacc); W0; W1; PIN(PW); SBAR(); }while(0)
  #define EX(v) __builtin_amdgcn_exp2f(v)
  #define GAPB(MF,X,B) do{ MF; X[B]=EX(X[B]); X[B+1]=EX(X[B+1]); X[B+2]=EX(X[B+2]); X[B+3]=EX(X[B+3]); PIN(X); SBAR(); }while(0)
  #define VRD(i) do{ vlo[i]=vtr(vp_+(((i)>>2)*4096+((i)&3)*1024)); vhi[i]=vtr(vp_+(((i)>>2)*4096+((i)&3)*1024+512)); }while(0)
  #define KRD(G,j) do{ if(G){ kload2(kf,kp0+sl_next,j); SBAR(); } }while(0)
  #define STEP(C0,C1,P0,P1,t,GK,GV,GL) do{ SBAR(); \
    const lds_cptr vp_=vp0+sl_prev; \
    VRD(0); SBAR(); float sacc=(P0[0]+P0[1]); \
    C0=__builtin_amdgcn_mfma_f32_32x32x16_bf16(bfa,mfrag,zero16,0,0,0); C1=__builtin_amdgcn_mfma_f32_32x32x16_bf16(bfb,mfrag,zero16,0,0,0); SBAR(); \
    GAPA(C0=__builtin_amdgcn_mfma_f32_32x32x16_bf16(kf[0],qr[0],C0,0,0,0), P0[2],P0[3],P0[4],P0[5],     pw0[0]=PKW(P0,0), pw0[1]=PKW(P0,2), pw0); \
    VRD(4); SBAR(); GAPA(C1=__builtin_amdgcn_mfma_f32_32x32x16_bf16(kf[1],qr[0],C1,0,0,0), P0[6],P0[7],P0[8],P0[9],     pw0[2]=PKW(P0,4), pw0[3]=PKW(P0,6), pw0); \
    VRD(1); SBAR(); GAPA(C0=__builtin_amdgcn_mfma_f32_32x32x16_bf16(kf[2],qr[1],C0,0,0,0),   P0[10],P0[11],P0[12],P0[13], pw1[0]=PKW(P0,8), pw1[1]=PKW(P0,10), pw1); \
    VRD(5); SBAR(); GAPA(C1=__builtin_amdgcn_mfma_f32_32x32x16_bf16(kf[3],qr[1],C1,0,0,0),   P0[14],P0[15],P1[0],P1[1],   pw1[2]=PKW(P0,12),pw1[3]=PKW(P0,14), pw1); \
    VRD(2); SBAR(); GAPA(C0=__builtin_amdgcn_mfma_f32_32x32x16_bf16(kf[4],qr[2],C0,0,0,0),   P1[2],P1[3],P1[4],P1[5],     pw2[0]=PKW(P1,0), pw2[1]=PKW(P1,2), pw2); \
    VRD(6); SBAR(); GAPA(C1=__builtin_amdgcn_mfma_f32_32x32x16_bf16(kf[5],qr[2],C1,0,0,0),   P1[6],P1[7],P1[8],P1[9],     pw2[2]=PKW(P1,4), pw2[3]=PKW(P1,6), pw2); \
    VRD(3); SBAR(); GAPA(C0=__builtin_amdgcn_mfma_f32_32x32x16_bf16(kf[6],qr[3],C0,0,0,0),   P1[10],P1[11],P1[12],P1[13], pw3[0]=PKW(P1,8), pw3[1]=PKW(P1,10), pw3); \
    VRD(7); SBAR(); GAPA(C1=__builtin_amdgcn_mfma_f32_32x32x16_bf16(kf[7],qr[3],C1,0,0,0),   P1[14],P1[15],0.f,0.f,       pw3[2]=PKW(P1,12),pw3[3]=PKW(P1,14), pw3); \
    l_reg+=sacc; \
    if(GK){DMA_K((t)+3,sl_cur);} if(GV){DMA_V((t)+1,sl_next);} \
    CMASK(C0,C1,t); \
    { float a=MX3(C0[0],C0[1],C1[0]),b=MX3(C0[2],C0[3],C1[1]); a=MX3(a,C1[2],C1[3]); \
      _Pragma("unroll") for(int r=4;r<16;r+=4){a=MX3(a,C0[r],C0[r+1]);b=MX3(b,C0[r+2],C0[r+3]);a=MX3(a,C1[r],C1[r+1]);b=MX3(b,C1[r+2],C1[r+3]);} \
      float rm=__builtin_fmaxf(a,b); { auto rr=__builtin_amdgcn_permlane32_swap(__float_as_uint(rm),__float_as_uint(rm),false,false); rm=__builtin_fmaxf(__uint_as_float(rr[0]),__uint_as_float(rr[1])); } \
      resc=false; \
      if(__builtin_expect(__any(rm>(float)THRL),0)){ const float dl=__builtin_fmaxf(rm,0.f); mhat+=dl; \
        _Pragma("unroll") for(int r=0;r<16;++r){C0[r]-=dl;C1[r]-=dl;} \
        MFRAG_SET(); \
        const float f=__builtin_amdgcn_exp2f(-dl); l_reg*=f; if(hi==0)wsf[r32]=f; resc=true; } } \
    SBAR(); \
    GAPB(o[0]=__builtin_amdgcn_mfma_f32_32x32x16_bf16(PAF(0),VFR(0),o[0],0,0,0), C0,0); \
    GAPB(o[1]=__builtin_amdgcn_mfma_f32_32x32x16_bf16(PAF(0),VFR(4),o[1],0,0,0), C0,4); \
    KRD(GL,0); GAPB(o[0]=__builtin_amdgcn_mfma_f32_32x32x16_bf16(PAF(1),VFR(1),o[0],0,0,0), C0,8); \
    KRD(GL,1); GAPB(o[1]=__builtin_amdgcn_mfma_f32_32x32x16_bf16(PAF(1),VFR(5),o[1],0,0,0), C0,12); \
    KRD(GL,2); GAPB(o[0]=__builtin_amdgcn_mfma_f32_32x32x16_bf16(PAF(2),VFR(2),o[0],0,0,0), C1,0); \
    KRD(GL,3); GAPB(o[1]=__builtin_amdgcn_mfma_f32_32x32x16_bf16(PAF(2),VFR(6),o[1],0,0,0), C1,4); \
    GAPB(o[0]=__builtin_amdgcn_mfma_f32_32x32x16_bf16(PAF(3),VFR(3),o[0],0,0,0), C1,8); \
    GAPB(o[1]=__builtin_amdgcn_mfma_f32_32x32x16_bf16(PAF(3),VFR(7),o[1],0,0,0), C1,12); \
    BFR((t)+1); \
    }while(0)
  int t=1;
  #undef CMASK
  #define CMASK(P0,P1,t) do{}while(0)
  for(;t+5<NT;t+=2){
    STEP(pB0,pB1,pA0,pA1,t,true,true,true);     WAIT_BAR(2); RESC(); ROT();
    STEP(pA0,pA1,pB0,pB1,t+1,true,true,true);   WAIT_BAR(2); RESC(); ROT();
  }
  #undef CMASK
  #define CMASK(P0,P1,t) do{int jb_=(t)-(NT-4); if(jb_>=0)cmask(P0,P1,jb_,qrel,hi);}while(0)
  #define ENDW(tt) do{ if((tt)+3<NT){WAIT_BAR(2);} else if((tt)+2<NT){WAIT_BAR(1);} else {WAIT_BAR(0);} }while(0)
  for(;t+1<NT;t+=2){
    STEP(pB0,pB1,pA0,pA1,t,(t+3<NT),(t+1<NT),(t+1<NT));       ENDW(t);   RESC(); ROT();
    STEP(pA0,pA1,pB0,pB1,t+1,(t+4<NT),(t+2<NT),(t+2<NT));     ENDW(t+1); RESC(); ROT();
  }
  STEP(pB0,pB1,pA0,pA1,NT-1,false,false,false); RESC();
  { float sacc=pB0[0]+pB0[1]; _Pragma("unroll") for(int r=2;r<16;++r)sacc+=pB0[r]; _Pragma("unroll") for(int r=0;r<16;++r)sacc+=pB1[r]; l_reg+=sacc;
    pw0=(u32x4){PKW(pB0,0),PKW(pB0,2),PKW(pB0,4),PKW(pB0,6)};pw1=(u32x4){PKW(pB0,8),PKW(pB0,10),PKW(pB0,12),PKW(pB0,14)};pw2=(u32x4){PKW(pB1,0),PKW(pB1,2),PKW(pB1,4),PKW(pB1,6)};pw3=(u32x4){PKW(pB1,8),PKW(pB1,10),PKW(pB1,12),PKW(pB1,14)};
    SBAR(); pv(o,vb0+sl_cur,PAF(0),PAF(1),PAF(2),PAF(3)); }
  #undef PKW
  #undef PAF
  #undef VFR
  #undef PIN
  #undef MX3
  #undef GAPA
  #undef GAPB
  #undef EX
  #undef VRD
  #undef KRD
  #undef STEP
  #undef ENDW
  {auto rr=__builtin_amdgcn_permlane32_swap(__float_as_uint(l_reg),__float_as_uint(l_reg),false,false);l_reg=__uint_as_float(rr[0])+__uint_as_float(rr[1]);}
  if(hi==0)wsf[32+r32]=l_reg;asm volatile("s_waitcnt lgkmcnt(0)":::"memory");
  float rli[16];
  #pragma unroll
  for(int r=0;r<16;++r)rli[r]=__builtin_amdgcn_rcpf(wsf[32+crow(r,hi)]);
  bf16*Ow=O+(rowbase+q0+wid*QBLK)*DMO+h*D;
  { bf16*stg=(bf16*)(shm+LDS_OST)+wid*2048;
    #pragma unroll
    for(int r=0;r<16;++r){const int orow=crow(r,hi);
      #pragma unroll
      for(int d0=0;d0<2;++d0)stg[orow*64+d0*32+r32]=__float2bfloat16(o[d0][r]*rli[r]);}
    asm volatile("s_waitcnt lgkmcnt(0)":::"memory");
    #pragma unroll
    for(int i=0;i<4;++i){const int row=i*8+(lane>>3),ch=lane&7; const u32x4 v=*(const u32x4*)(stg+row*64+ch*8); ATTN_STORE16(Ow+(long)row*DMO+ch*8,v);} }
  asm volatile("s_waitcnt lgkmcnt(0)\n\ts_barrier":::"memory");
  #undef BFRAG
  #undef BFR
  #undef MFRAG_SET
  #undef QLD
  #undef DMA_K
  #undef DMA_V
  #undef CMASK
  #undef START
  #undef RESC
  #undef ROT
}
constexpr int ATTN_LDS_BYTES=LDS_BYTES;
#undef SBAR
#undef WAIT_BAR
}
#define LAS __attribute__((address_space(3)))
typedef unsigned short bf16;
typedef unsigned v4u __attribute__((ext_vector_type(4)));
typedef unsigned v2u __attribute__((ext_vector_type(2)));
typedef float f32x4 __attribute__((ext_vector_type(4)));
typedef short bf16x8 __attribute__((ext_vector_type(8)));
typedef float f32x16 __attribute__((ext_vector_type(16)));
typedef LAS unsigned char* ldsp;
constexpr int NWAVES = 8;
constexpr int BATCH = 8, SEQ = 8192, D = 1024, M = BATCH * SEQ, NMEM = 256, MM = BATCH * NMEM, FF = 4096;
constexpr int ZW = 3584, NIN = 3840;
constexpr int ZC_MLQ = 0, ZC_MLK = 512, ZC_MLV = 1024, ZC_MLO = 1536, ZC_FXQ = 2048, ZC_FXK = 2560, ZC_FXV = 3072;
constexpr float LOG2E = 1.4426950408889634f;
constexpr float C2_FOX = 0.125f * LOG2E, C2_X = 0.0625f * LOG2E;
constexpr size_t MiB = 1u << 20;
constexpr size_t WS_CTL = 0, CTL_ZERO_BYTES = 131072;
constexpr size_t WS_WIN = 2 * MiB, WS_WOUT = 10 * MiB, WS_WXQ = 12 * MiB, WS_WXKV = 14 * MiB, WS_WXO = 18 * MiB, WS_W1 = 20 * MiB, WS_W2 = 28 * MiB;
constexpr size_t WS_MEMN = 36 * MiB, WS_KX = 40 * MiB, WS_VXT = 44 * MiB, WS_G = 48 * MiB, WS_CNEG = 52 * MiB, WS_SS1 = 54 * MiB, WS_SS2 = 58 * MiB, WS_SS3 = 62 * MiB;
constexpr size_t WS_XN = 72 * MiB, WS_MIX = 200 * MiB, WS_Z = 328 * MiB, WS_U = 328 * MiB, WS_VTG = 776 * MiB, WS_END = 840 * MiB;
constexpr int RING_BYTES = 131072, MISC_OFF = RING_BYTES, LDS_BYTES = 147456;

__device__ __forceinline__ unsigned f2bf(float f) { unsigned u = __builtin_bit_cast(unsigned, f); return (u + 0x7fffu + ((u >> 16) & 1u)) >> 16; }
__device__ __forceinline__ unsigned pk2(float lo, float hi) { return pg8::cvt_pk_bf16(lo, hi); }
__device__ __forceinline__ float bf_lo(unsigned w) { return __uint_as_float(w << 16); }
__device__ __forceinline__ float bf_hi(unsigned w) { return __uint_as_float(w & 0xffff0000u); }
__device__ __forceinline__ float wave_sum(float v) {
#pragma unroll
    for (int o = 1; o < 64; o <<= 1) v += __shfl_xor(v, o);
    return v;
}
__device__ __forceinline__ float logsig(float x) { const float e = __builtin_amdgcn_exp2f(-fabsf(x) * LOG2E); return fminf(x, 0.f) - __builtin_amdgcn_logf(1.0f + e) * 0.6931471805599453f; }
#define LDS_WAIT() asm volatile("s_waitcnt lgkmcnt(0)" ::: "memory")
#define LBAR() asm volatile("s_waitcnt lgkmcnt(0)\n\ts_barrier" ::: "memory")

template <class F> __device__ __forceinline__ void p0_transpose_item(const float* W, int K, int N, int ND, bf16* WT, LAS float* scr, int item, int lane, F srcmap) {
    const int nblk = ND / 32, kb = item / nblk, nb = item % nblk, k0 = 64 * kb, n0 = 32 * nb;
    const int sc = srcmap(n0 + (lane & 31));
#pragma unroll 8
    for (int i = 0; i < 32; ++i) { const int kk = 2 * i + (lane >> 5); scr[kk * 33 + (lane & 31)] = sc >= 0 ? W[(size_t)(k0 + kk) * N + sc] : 0.f; }
    LDS_WAIT(); asm volatile("" ::: "memory");
    const int c = lane & 7;
#pragma unroll
    for (int j = 0; j < 4; ++j) { const int n = (lane >> 3) + 8 * j; const LAS float* s = scr + (8 * c) * 33 + n;
        v4u o; o.x = pk2(s[0 * 33], s[1 * 33]); o.y = pk2(s[2 * 33], s[3 * 33]); o.z = pk2(s[4 * 33], s[5 * 33]); o.w = pk2(s[6 * 33], s[7 * 33]);
        *(v4u*)(WT + (size_t)(n0 + n) * K + k0 + 8 * c) = o; }
    LDS_WAIT(); asm volatile("" ::: "memory");
}
__device__ __forceinline__ void rms_row_to_bf16(const float* xrow, const float* gain, bf16* orow, int lane) {
    const f32x4* xr = (const f32x4*)xrow + lane; const f32x4* gr = (const f32x4*)gain + lane;
    f32x4 v[4]; float s = 0.f;
#pragma unroll
    for (int j = 0; j < 4; ++j) { v[j] = xr[64 * j]; s += (v[j].x * v[j].x + v[j].y * v[j].y) + (v[j].z * v[j].z + v[j].w * v[j].w); }
    const float r = 1.0f / sqrtf(wave_sum(s) * (1.f / 1024.f) + 1e-6f);
    unsigned long long* o8 = (unsigned long long*)orow + lane;
#pragma unroll
    for (int j = 0; j < 4; ++j) { const f32x4 g = gr[64 * j]; o8[64 * j] = (unsigned long long)pk2(v[j].x * r * g.x, v[j].y * r * g.y) | ((unsigned long long)pk2(v[j].z * r * g.z, v[j].w * r * g.w) << 32); }
}
template <int NR> __device__ __forceinline__ void rms_rows_to_bf16(const float* x0, size_t row_stride, const float* gain, bf16* o0, int lane) {
    f32x4 v[NR][4]; float s[NR];
#pragma unroll
    for (int r = 0; r < NR; ++r) { const f32x4* xr = (const f32x4*)(x0 + r * row_stride) + lane;
#pragma unroll
        for (int j = 0; j < 4; ++j) v[r][j] = xr[64 * j]; }
    f32x4 g[4];
#pragma unroll
    for (int j = 0; j < 4; ++j) g[j] = ((const f32x4*)gain)[lane + 64 * j];
#pragma unroll
    for (int r = 0; r < NR; ++r) { s[r] = 0.f;
#pragma unroll
        for (int j = 0; j < 4; ++j) s[r] += (v[r][j].x * v[r][j].x + v[r][j].y * v[r][j].y) + (v[r][j].z * v[r][j].z + v[r][j].w * v[r][j].w); }
#pragma unroll
    for (int o = 1; o < 64; o <<= 1) {
#pragma unroll
        for (int r = 0; r < NR; ++r) s[r] += __shfl_xor(s[r], o); }
#pragma unroll
    for (int r = 0; r < NR; ++r) { const float rs = 1.0f / sqrtf(s[r] * (1.f / 1024.f) + 1e-6f); unsigned long long* o8 = (unsigned long long*)(o0 + r * row_stride) + lane;
#pragma unroll
        for (int j = 0; j < 4; ++j) o8[64 * j] = (unsigned long long)pk2(v[r][j].x * rs * g[j].x, v[r][j].y * rs * g[j].y) | ((unsigned long long)pk2(v[r][j].z * rs * g[j].z, v[r][j].w * rs * g[j].w) << 32); }
}
namespace ml {
constexpr int QS = 0, KS = QS + 64 * 272, KWT = KS + 64 * 272, VT = KWT + 128 * 144, PS = VT + 128 * 144, RSP = PS + 64 * 144, CWL = RSP + 512, PRE_END = CWL + 5120;
constexpr int SB_Q = 0, SB_KW = 64 * 272, SB_VT = SB_KW + 128 * 144, SB_BYTES = SB_VT + 128 * 144, NQ = 2 * SB_BYTES, NV = NQ + 256, SSQ = NV + 512, ST_END = SSQ + 2048;
static_assert(PRE_END <= RING_BYTES && ST_END <= RING_BYTES, "mlstm LDS");
__device__ __forceinline__ float scan_add(float v, int lane) {
#pragma unroll
    for (int o = 1; o < 64; o <<= 1) { const float t = __shfl_up(v, o); if (lane >= o) v += t; }
    return v;
}
__device__ __forceinline__ float scan_max(float v, int lane) {
#pragma unroll
    for (int o = 1; o < 64; o <<= 1) { const float t = __shfl_up(v, o); if (lane >= o) v = fmaxf(v, t); }
    return v;
}
#define MFMA16(a, b, c) __builtin_amdgcn_mfma_f32_16x16x32_bf16(a, b, c, 0, 0, 0)
struct PreOut { bf16* QF; bf16* KWTg; bf16* VTg; float* HI; float* SC; float* SC2; };
struct PreRegs { v4u rq[7]; v4u rv[2]; float g_i, g_f; };
__device__ __forceinline__ void pre_load(int u, const bf16* __restrict__ Z, const float* __restrict__ G, PreRegs& R, const int tid) {
    const int lane = tid & 63, bh = u >> 7, c = u & 127, b = bh >> 2, h = bh & 3;
    const int g8 = tid & 15, isK = tid >> 8, tb = (tid >> 4) & 15, sb = tid >> 4;
    const int ch0 = (isK ? 512 : 0) + h * 128 + 8 * g8;
    const size_t rb = (size_t)b * SEQ + (size_t)c * 64;
    const bf16* zq = Z + rb * ZW + ch0; const bf16* zv = Z + rb * ZW + ZC_MLV + h * 128 + 8 * g8; const float* gp = G + rb * 16 + h;
#pragma unroll
    for (int i = 0; i < 7; ++i) { const int t = 4 * tb - 3 + i; R.rq[i] = (c == 0 && t < 0) ? (v4u){0u, 0u, 0u, 0u} : *(const v4u*)(zq + t * ZW); }
#pragma unroll
    for (int j = 0; j < 2; ++j) R.rv[j] = *(const v4u*)(zv + (2 * sb + j) * ZW);
    R.g_i = gp[lane * 16]; R.g_f = gp[lane * 16 + 4];
}
__device__ __forceinline__ void pre_unit(int u, const bf16* __restrict__ Z, const float* __restrict__ G, const PreOut& O,
        const float* __restrict__ conv_w, const float* __restrict__ conv_b, const float* __restrict__ b_i, const float* __restrict__ b_f, ldsp L, const int tid_in, int& cw_head, PreRegs& R, const int u_next) {
    const int tid = tid_in, lane = tid & 63, w = __builtin_amdgcn_readfirstlane(tid >> 6), fr = lane & 15, fq = lane >> 4;
    const int bh = u >> 7, c = u & 127, b = bh >> 2, h = bh & 3;
    const int g8 = tid & 15, isK = tid >> 8, tb = (tid >> 4) & 15, sb = tid >> 4;
    const int ch0 = (isK ? 512 : 0) + h * 128 + 8 * g8;
    const size_t rb = (size_t)b * SEQ + (size_t)c * 64;
    if (cw_head != h) {
        for (int idx = tid; idx < 1280; idx += 512) { const int which = idx / 640, j = (idx % 640) >> 7, ch = idx & 127;
            *(LAS float*)(L + CWL + idx * 4) = j < 4 ? conv_w[j * 1024 + which * 512 + h * 128 + ch] : conv_b[which * 512 + h * 128 + ch]; }
        cw_head = h;
        __syncthreads();
    }
    const int cwo = CWL + (isK * 640 + 8 * g8) * 4;
    const float lf = logsig(R.g_f + b_f[h]), ig = R.g_i + b_i[h];
    const float bc = scan_add(lf, lane), uu = ig - bc, pm = scan_max(uu, lane);
    const float umax = __shfl(pm, 63), gl = __shfl(bc, 63);
    const float wl = __expf(uu - umax);
    {
        float y[4][8];
        { const f32x4 c0 = *(const LAS f32x4*)(L + cwo + 4 * 512), c1 = *(const LAS f32x4*)(L + cwo + 4 * 512 + 16);
#pragma unroll
          for (int tt = 0; tt < 4; ++tt) { y[tt][0] = c0[0]; y[tt][1] = c0[1]; y[tt][2] = c0[2]; y[tt][3] = c0[3]; y[tt][4] = c1[0]; y[tt][5] = c1[1]; y[tt][6] = c1[2]; y[tt][7] = c1[3]; } }
#pragma unroll
        for (int j = 0; j < 4; ++j) {
            const f32x4 c0 = *(const LAS f32x4*)(L + cwo + j * 512), c1 = *(const LAS f32x4*)(L + cwo + j * 512 + 16);
            const float cwj[8] = {c0[0], c0[1], c0[2], c0[3], c1[0], c1[1], c1[2], c1[3]};
#pragma unroll
            for (int tt = 0; tt < 4; ++tt) { const int r = tt + j;
                const float x[8] = {bf_lo(R.rq[r].x), bf_hi(R.rq[r].x), bf_lo(R.rq[r].y), bf_hi(R.rq[r].y), bf_lo(R.rq[r].z), bf_hi(R.rq[r].z), bf_lo(R.rq[r].w), bf_hi(R.rq[r].w)};
#pragma unroll
                for (int i = 0; i < 8; ++i) y[tt][i] += cwj[i] * x[i]; }
        }
        const float ksc = isK ? 0.08838834764831845f : 1.0f;
#pragma unroll
        for (int tt = 0; tt < 4; ++tt)
#pragma unroll
            for (int i = 0; i < 8; ++i) { const float a = y[tt][i]; y[tt][i] = a * __builtin_amdgcn_rcpf(1.0f + __expf(-a)) * ksc; }
        const int base = isK ? KS : QS;
#pragma unroll
        for (int tt = 0; tt < 4; ++tt) { v4u o; o.x = pk2(y[tt][0], y[tt][1]); o.y = pk2(y[tt][2], y[tt][3]); o.z = pk2(y[tt][4], y[tt][5]); o.w = pk2(y[tt][6], y[tt][7]);
            *(LAS v4u*)(L + base + (4 * tb + tt) * 272 + 16 * g8) = o;
            if (!isK) *(v4u*)(O.QF + ((size_t)u * 64 + 4 * tb + tt) * 128 + 8 * g8) = o; }
        if (isK) {
            float was[4];
#pragma unroll
            for (int tt = 0; tt < 4; ++tt) was[tt] = __shfl(wl, 4 * tb + tt);
#pragma unroll
            for (int i = 0; i < 8; ++i) { v2u o; o.x = pk2(y[0][i] * was[0], y[1][i] * was[1]); o.y = pk2(y[2][i] * was[2], y[3][i] * was[3]);
                *(LAS v2u*)(L + KWT + (8 * g8 + i) * 144 + 8 * tb) = o; }
        }
        {
            const unsigned a0[4] = {R.rv[0].x, R.rv[0].y, R.rv[0].z, R.rv[0].w}, a1[4] = {R.rv[1].x, R.rv[1].y, R.rv[1].z, R.rv[1].w};
#pragma unroll
            for (int i = 0; i < 4; ++i) {
                const unsigned lo = (a0[i] & 0xffffu) | (a1[i] << 16), hi = (a0[i] >> 16) | (a1[i] & 0xffff0000u);
                *(LAS unsigned*)(L + VT + (8 * g8 + 2 * i) * 144 + 4 * sb) = lo;
                *(LAS unsigned*)(L + VT + (8 * g8 + 2 * i + 1) * 144 + 4 * sb) = hi; }
        }
    }
    if (u_next >= 0) pre_load(u_next, Z, G, R, tid);
    LBAR();
    {
        const int tt = w >> 1, half = w & 1, t = 16 * tt + fr; const float Pt = __shfl(pm, t); float rs = 0.f;
#pragma unroll
        for (int j = 0; j < 2; ++j) { const int st = 2 * half + j; f32x4 a = (f32x4){0.f, 0.f, 0.f, 0.f};
            if (st <= tt) {
#pragma unroll
                for (int ks = 0; ks < 4; ++ks) { const bf16x8 kf = *(const LAS bf16x8*)(L + KS + (16 * st + fr) * 272 + (32 * ks + 8 * fq) * 2); const bf16x8 qf = *(const LAS bf16x8*)(L + QS + t * 272 + (32 * ks + 8 * fq) * 2); a = MFMA16(kf, qf, a); }
            }
            float p[4];
#pragma unroll
            for (int i = 0; i < 4; ++i) { const int s = 16 * st + 4 * fq + i; const float us = __shfl(uu, s); p[i] = (s <= t) ? a[i] * __expf(us - Pt) : 0.f; rs += p[i]; }
            v2u o; o.x = pk2(p[0], p[1]); o.y = pk2(p[2], p[3]);
            *(LAS v2u*)(L + PS + t * 144 + (16 * st + 4 * fq) * 2) = o; }
        rs += __shfl_xor(rs, 16); rs += __shfl_xor(rs, 32);
        if (fq == 0) *(LAS float*)(L + RSP + (t * 2 + half) * 4) = rs;
    }
#pragma unroll
    for (int i = 0; i < 2; ++i) { const int it = tid + 512 * i, row = it >> 3, chk = it & 7;
        *(v4u*)(O.KWTg + ((size_t)u * 128 + row) * 64 + 8 * chk) = *(const LAS v4u*)(L + KWT + row * 144 + 16 * chk);
        *(v4u*)(O.VTg + ((size_t)u * 128 + row) * 64 + 8 * chk) = *(const LAS v4u*)(L + VT + row * 144 + 16 * chk); }
    LBAR();
    {
        bf16x8 vf[2];
#pragma unroll
        for (int ks = 0; ks < 2; ++ks) vf[ks] = *(const LAS bf16x8*)(L + VT + (16 * w + fr) * 144 + (32 * ks + 8 * fq) * 2);
#pragma unroll
        for (int t4 = 0; t4 < 4; ++t4) { const int t = 16 * t4 + fr; f32x4 a = (f32x4){0.f, 0.f, 0.f, 0.f};
#pragma unroll
            for (int ks = 0; ks < 2; ++ks) { const bf16x8 pf = *(const LAS bf16x8*)(L + PS + t * 144 + (32 * ks + 8 * fq) * 2); a = MFMA16(vf[ks], pf, a); }
            *(f32x4*)(O.HI + ((size_t)u * 64 + t) * 128 + 16 * w + 4 * fq) = a; }
        if (w == 0) { const float rsum = *(const LAS float*)(L + RSP + lane * 8) + *(const LAS float*)(L + RSP + lane * 8 + 4);
            *(f32x4*)(O.SC + ((size_t)u * 64 + lane) * 4) = (f32x4){bc, pm, rsum, 0.f};
            if (lane == 0) { O.SC2[(size_t)u * 2] = umax; O.SC2[(size_t)u * 2 + 1] = gl; } }
    }
    LBAR();
}
__device__ __forceinline__ void stream(int b, int h, const bf16* __restrict__ Z, const PreOut& O, bf16* __restrict__ MIX, const float* __restrict__ ml_norm, ldsp L, const int tid_in, const int c_begin, const int c_end) {
    const int tid = tid_in, lane = tid & 63, w = __builtin_amdgcn_readfirstlane(tid >> 6), fr = lane & 15, fq = lane >> 4;
    const int bh = b * 4 + h;
    const f32x4 mln = *(const f32x4*)(ml_norm + h * 128 + 16 * w + 4 * fq);
    f32x4 accC[8];
#pragma unroll
    for (int i = 0; i < 8; ++i) accC[i] = (f32x4){0.f, 0.f, 0.f, 0.f};
    if (tid < 128) *(LAS float*)(L + NV + tid * 4) = 0.f;
    float mcar = 0.f;
    const size_t row0 = (size_t)b * SEQ;
    v4u st[6]; f32x4 hi[4]; v2u ro[4]; f32x4 sc4 = (f32x4){0.f, 0.f, 0.f, 0.f}; float umax, gch;
#pragma unroll
    for (int i = 0; i < 6; ++i) st[i] = (v4u){0u, 0u, 0u, 0u};
#pragma unroll
    for (int i = 0; i < 4; ++i) { hi[i] = (f32x4){0.f, 0.f, 0.f, 0.f}; ro[i] = (v2u){0u, 0u}; }
#define ML_LOAD(cc) do { const size_t u_ = (size_t)bh * 128 + (cc); \
        const bf16* pk_ = O.KWTg + u_ * 8192; const bf16* pv_ = O.VTg + u_ * 8192; \
        _Pragma("unroll") for (int i_ = 0; i_ < 2; ++i_) { const int it_ = tid + 512 * i_; st[2 + i_] = *(const v4u*)(pk_ + it_ * 8); st[4 + i_] = *(const v4u*)(pv_ + it_ * 8); } \
        umax = O.SC2[u_ * 2]; gch = O.SC2[u_ * 2 + 1]; \
        if ((cc) >= c_begin) { const bf16* pq_ = O.QF + u_ * 8192; const float* ph_ = O.HI + u_ * 8192; const bf16* po_ = Z + (row0 + (size_t)(cc) * 64) * ZW + ZC_MLO + h * 128; const float* ps_ = O.SC + u_ * 256; \
        _Pragma("unroll") for (int i_ = 0; i_ < 2; ++i_) { const int it_ = tid + 512 * i_; st[i_] = *(const v4u*)(pq_ + it_ * 8); } \
        _Pragma("unroll") for (int t4_ = 0; t4_ < 4; ++t4_) { hi[t4_] = *(const f32x4*)(ph_ + (16 * t4_ + fr) * 128 + 16 * w + 4 * fq); \
            ro[t4_] = *(const v2u*)(po_ + (16 * t4_ + fr) * ZW + 16 * w + 4 * fq); } \
        sc4 = *(const f32x4*)(ps_ + lane * 4); } } while (0)
    ML_LOAD(0);
    for (int c = 0; c < c_end; ++c) {
        const bool full = c >= c_begin;
        const int sbo = (c & 1) * SB_BYTES;
#pragma unroll
        for (int i = 0; i < 2; ++i) { const int it = tid + 512 * i;
            *(LAS v4u*)(L + sbo + SB_Q + (it >> 4) * 272 + (it & 15) * 16) = st[i];
            *(LAS v4u*)(L + sbo + SB_KW + (it >> 3) * 144 + (it & 7) * 16) = st[2 + i];
            *(LAS v4u*)(L + sbo + SB_VT + (it >> 3) * 144 + (it & 7) * 16) = st[4 + i]; }
        const float bc = sc4[0], pm = sc4[1], rsl = sc4[2];
        const float Mv = fmaxf(mcar, pm), Ml = fmaxf(mcar, umax);
        const float r1 = __expf(pm - Mv), inter = __expf(mcar - Mv), flo = __expf(-(bc + Mv));
        const float scl = __expf(umax - Ml), decay = __expf(mcar - Ml);
        mcar = gch + Ml;
        f32x4 acch[4]; v2u og[4];
#pragma unroll
        for (int t4 = 0; t4 < 4; ++t4) { acch[t4] = hi[t4]; og[t4] = ro[t4]; }
        if (c + 1 < c_end) ML_LOAD(c + 1);
        LBAR();
        if (full) {
            bf16x8 cx[4];
#pragma unroll
            for (int ks = 0; ks < 4; ++ks) { v4u o; o.x = pk2(accC[2 * ks][0], accC[2 * ks][1]); o.y = pk2(accC[2 * ks][2], accC[2 * ks][3]); o.z = pk2(accC[2 * ks + 1][0], accC[2 * ks + 1][1]); o.w = pk2(accC[2 * ks + 1][2], accC[2 * ks + 1][3]);
                cx[ks] = __builtin_bit_cast(bf16x8, o); }
#pragma unroll
            for (int t4 = 0; t4 < 4; ++t4) { const int t = 16 * t4 + fr; const float it = __shfl(inter, t), r1t = __shfl(r1, t);
                f32x4 a = (f32x4){0.f, 0.f, 0.f, 0.f};
#pragma unroll
                for (int ks = 0; ks < 4; ++ks) { const v2u qlo = *(const LAS v2u*)(L + sbo + SB_Q + t * 272 + (32 * ks + 4 * fq) * 2), qhi = *(const LAS v2u*)(L + sbo + SB_Q + t * 272 + (32 * ks + 16 + 4 * fq) * 2);
                    const v4u qq = {qlo.x, qlo.y, qhi.x, qhi.y}; a = MFMA16(cx[ks], __builtin_bit_cast(bf16x8, qq), a); }
                acch[t4] = acch[t4] * r1t + a * it;
                float sq = (acch[t4][0] * acch[t4][0] + acch[t4][1] * acch[t4][1]) + (acch[t4][2] * acch[t4][2] + acch[t4][3] * acch[t4][3]);
                sq += __shfl_xor(sq, 16); sq += __shfl_xor(sq, 32);
                if (fq == 0) *(LAS float*)(L + SSQ + (t * 8 + w) * 4) = sq; }
        }
        if (full) {
            const int ft = tid >> 3, part = tid & 7; float s = 0.f;
#pragma unroll
            for (int j = 0; j < 2; ++j) { const v4u qv = *(const LAS v4u*)(L + sbo + SB_Q + ft * 272 + (16 * part + 8 * j) * 2); const f32x4 n0 = *(const LAS f32x4*)(L + NV + (16 * part + 8 * j) * 4), n1 = *(const LAS f32x4*)(L + NV + (16 * part + 8 * j + 4) * 4);
                s += bf_lo(qv.x) * n0[0] + bf_hi(qv.x) * n0[1] + bf_lo(qv.y) * n0[2] + bf_hi(qv.y) * n0[3] + bf_lo(qv.z) * n1[0] + bf_hi(qv.z) * n1[1] + bf_lo(qv.w) * n1[2] + bf_hi(qv.w) * n1[3]; }
            s += __shfl_xor(s, 1); s += __shfl_xor(s, 2); s += __shfl_xor(s, 4);
            if (part == 0) *(LAS float*)(L + NQ + ft * 4) = s;
        }
        float nsum;
        {
            bf16x8 vf[2];
#pragma unroll
            for (int ks = 0; ks < 2; ++ks) vf[ks] = *(const LAS bf16x8*)(L + sbo + SB_VT + (16 * w + fr) * 144 + (32 * ks + 8 * fq) * 2);
#pragma unroll
            for (int dt = 0; dt < 8; ++dt) { f32x4 a = (f32x4){0.f, 0.f, 0.f, 0.f};
#pragma unroll
                for (int ks = 0; ks < 2; ++ks) { const bf16x8 kwf = *(const LAS bf16x8*)(L + sbo + SB_KW + (16 * dt + fr) * 144 + (32 * ks + 8 * fq) * 2); a = MFMA16(kwf, vf[ks], a); }
                accC[dt] = accC[dt] * decay + a * scl; }
            const int d = tid >> 2, part = tid & 3; float s = 0.f;
#pragma unroll
            for (int j = 0; j < 2; ++j) { const v4u kv = *(const LAS v4u*)(L + sbo + SB_KW + d * 144 + (16 * part + 8 * j) * 2);
                s += (bf_lo(kv.x) + bf_hi(kv.x)) + (bf_lo(kv.y) + bf_hi(kv.y)) + (bf_lo(kv.z) + bf_hi(kv.z)) + (bf_lo(kv.w) + bf_hi(kv.w)); }
            s += __shfl_xor(s, 1); s += __shfl_xor(s, 2);
            nsum = s;
        }
        LBAR();
        { const int d = tid >> 2, part = tid & 3; if (part == 0) { LAS float* np = (LAS float*)(L + NV + d * 4); *np = decay * *np + scl * nsum; } }
        if (full) {
#pragma unroll
        for (int t4 = 0; t4 < 4; ++t4) { const int t = 16 * t4 + fr;
            const float it = __shfl(inter, t), r1t = __shfl(r1, t), fl = __shfl(flo, t), rst = __shfl(rsl, t);
            const float den = r1t * rst + it * *(const LAS float*)(L + NQ + t * 4);
            const float dn = __builtin_amdgcn_rcpf(fmaxf(fabsf(den), fl));
            const f32x4 s0 = *(const LAS f32x4*)(L + SSQ + t * 32), s1 = *(const LAS f32x4*)(L + SSQ + t * 32 + 16);
            const float ss = (((s0[0] + s0[1]) + (s0[2] + s0[3])) + ((s1[0] + s1[1]) + (s1[2] + s1[3]))) * dn * dn;
            const float r = dn * __builtin_amdgcn_rsqf(ss * (1.0f / 128.0f) + 1e-6f);
            const float o0 = bf_lo(og[t4].x), o1 = bf_hi(og[t4].x), o2 = bf_lo(og[t4].y), o3 = bf_hi(og[t4].y);
            const float e0 = acch[t4][0] * r * mln[0] * __builtin_amdgcn_rcpf(1.0f + __expf(-o0)), e1 = acch[t4][1] * r * mln[1] * __builtin_amdgcn_rcpf(1.0f + __expf(-o1));
            const float e2 = acch[t4][2] * r * mln[2] * __builtin_amdgcn_rcpf(1.0f + __expf(-o2)), e3 = acch[t4][3] * r * mln[3] * __builtin_amdgcn_rcpf(1.0f + __expf(-o3));
            v2u o; o.x = pk2(e0, e1); o.y = pk2(e2, e3);
            *(v2u*)(MIX + (row0 + (size_t)c * 64 + t) * 1024 + h * 128 + 16 * w + 4 * fq) = o; }
        }
    }
#undef ML_LOAD
    __syncthreads();
}
}
namespace xa {
constexpr int BUFB = 36864;
#define MFMA32(a, b, c) __builtin_amdgcn_mfma_f32_32x32x16_bf16(a, b, c, 0, 0, 0)
__device__ __forceinline__ void xattn_unit(int pt, int hx, bf16* __restrict__ QO, const bf16* __restrict__ KX, const bf16* __restrict__ VXT, ldsp L, const int tid_in) {
    const int tid = tid_in, lane = tid & 63, w = __builtin_amdgcn_readfirstlane(tid >> 6), r32 = lane & 31, hi = lane >> 5;
    const int b = pt >> 5;
    bf16* qrow = QO + ((size_t)pt * 256 + w * 32 + r32) * 1024 + hx * 256;
    bf16x8 qf[16];
#pragma unroll
    for (int d0 = 0; d0 < 16; ++d0) qf[d0] = *(const bf16x8*)(qrow + 16 * d0 + 8 * hi);
    const bf16* kbase = KX + (size_t)b * 256 * 1024 + hx * 256;
    const bf16* vbase = VXT + (size_t)hx * 256 * 2048 + b * 256;
    v4u st[4];
#define XA_LOAD(j) do { if ((j) < 4) { _Pragma("unroll") for (int i_ = 0; i_ < 4; ++i_) { const int it_ = tid + 512 * i_, row_ = it_ >> 5, ch_ = it_ & 31; st[i_] = *(const v4u*)(kbase + (size_t)(64 * (j) + row_) * 1024 + 8 * ch_); } } \
        else { _Pragma("unroll") for (int i_ = 0; i_ < 2; ++i_) { const int it_ = tid + 512 * i_, row_ = it_ >> 3, ch_ = it_ & 7; st[i_] = *(const v4u*)(vbase + (size_t)(128 * (((j) - 4) >> 2) + row_) * 2048 + 64 * (((j) - 4) & 3) + 8 * ch_); } } } while (0)
#define XA_STORE(j) do { const int bo_ = ((j) & 1) * BUFB; if ((j) < 4) { _Pragma("unroll") for (int i_ = 0; i_ < 4; ++i_) { const int it_ = tid + 512 * i_, row_ = it_ >> 5, ch_ = it_ & 31; *(LAS v4u*)(L + bo_ + row_ * 528 + 16 * ch_) = st[i_]; } } \
        else { _Pragma("unroll") for (int i_ = 0; i_ < 2; ++i_) { const int it_ = tid + 512 * i_, row_ = it_ >> 3, ch_ = it_ & 7; *(LAS v4u*)(L + bo_ + row_ * 144 + 16 * ch_) = st[i_]; } } } while (0)
#define XA_QK(a0, a1, bo) do { a0 = (f32x16){}; a1 = (f32x16){}; _Pragma("unroll") for (int d0 = 0; d0 < 16; ++d0) { \
        const bf16x8 k0_ = *(const LAS bf16x8*)(L + (bo) + r32 * 528 + (16 * d0 + 8 * hi) * 2), k1_ = *(const LAS bf16x8*)(L + (bo) + (32 + r32) * 528 + (16 * d0 + 8 * hi) * 2); \
        a0 = MFMA32(k0_, qf[d0], a0); a1 = MFMA32(k1_, qf[d0], a1); } } while (0)
    XA_LOAD(0); XA_STORE(0);
    LBAR();
    float mt[4], lt[4];
    v4u pw[4][4];
#pragma unroll
    for (int j = 0; j < 4; ++j) {
        XA_LOAD(j + 1);
        f32x16 a0, a1; XA_QK(a0, a1, (j & 1) * BUFB);
        float mx = fmaxf(a0[0], a1[0]);
#pragma unroll
        for (int r = 1; r < 16; ++r) mx = fmaxf(mx, fmaxf(a0[r], a1[r]));
        mx = fmaxf(mx, __shfl_xor(mx, 32));
        float p[16], q[16], l = 0.f;
#pragma unroll
        for (int r = 0; r < 16; ++r) { p[r] = __builtin_amdgcn_exp2f(a0[r] - mx); q[r] = __builtin_amdgcn_exp2f(a1[r] - mx); l += p[r] + q[r]; }
        mt[j] = mx; lt[j] = l;
        pw[j][0] = (v4u){pk2(p[0], p[1]), pk2(p[2], p[3]), pk2(p[4], p[5]), pk2(p[6], p[7])};
        pw[j][1] = (v4u){pk2(p[8], p[9]), pk2(p[10], p[11]), pk2(p[12], p[13]), pk2(p[14], p[15])};
        pw[j][2] = (v4u){pk2(q[0], q[1]), pk2(q[2], q[3]), pk2(q[4], q[5]), pk2(q[6], q[7])};
        pw[j][3] = (v4u){pk2(q[8], q[9]), pk2(q[10], q[11]), pk2(q[12], q[13]), pk2(q[14], q[15])};
        XA_STORE(j + 1);
        LBAR();
    }
    const float mg = fmaxf(fmaxf(mt[0], mt[1]), fmaxf(mt[2], mt[3]));
    float l = 0.f;
#pragma unroll
    for (int j = 0; j < 4; ++j) { const float f = __builtin_amdgcn_exp2f(mt[j] - mg); l += f * lt[j];
#pragma unroll
        for (int k = 0; k < 4; ++k) { unsigned w4[4] = {pw[j][k].x, pw[j][k].y, pw[j][k].z, pw[j][k].w};
#pragma unroll
            for (int e = 0; e < 4; ++e) w4[e] = pk2(bf_lo(w4[e]) * f, bf_hi(w4[e]) * f);
            pw[j][k] = (v4u){w4[0], w4[1], w4[2], w4[3]}; } }
    l += __shfl_xor(l, 32);
    const float rl = 1.0f / l;
    bf16* obase = QO + ((size_t)pt * 256 + w * 32) * 1024 + hx * 256;
#pragma unroll
    for (int hd = 0; hd < 2; ++hd) {
        f32x16 o[4];
#pragma unroll
        for (int i = 0; i < 4; ++i) o[i] = (f32x16){};
#pragma unroll
        for (int vt = 0; vt < 4; ++vt) {
            const int j = 4 + 4 * hd + vt;
            if (j < 11) XA_LOAD(j + 1);
            const int bo = (j & 1) * BUFB;
#pragma unroll
            for (int db = 0; db < 4; ++db)
#pragma unroll
                for (int j4 = 0; j4 < 4; ++j4) { const v2u lo = *(const LAS v2u*)(L + bo + (32 * db + r32) * 144 + (16 * j4 + 4 * hi) * 2), hh = *(const LAS v2u*)(L + bo + (32 * db + r32) * 144 + (16 * j4 + 8 + 4 * hi) * 2);
                    const v4u vv = {lo.x, lo.y, hh.x, hh.y}; o[db] = MFMA32(__builtin_bit_cast(bf16x8, pw[vt][j4]), __builtin_bit_cast(bf16x8, vv), o[db]); }
            if (j < 11) { XA_STORE(j + 1); }
            LBAR();
        }
#pragma unroll
        for (int r = 0; r < 16; ++r) { const int q = (r & 3) + 8 * (r >> 2) + 4 * hi; const float rq = __shfl(rl, q);
#pragma unroll
            for (int db = 0; db < 4; ++db) obase[(size_t)q * 1024 + 128 * hd + 32 * db + r32] = (bf16)f2bf(o[db][r] * rq); }
    }
#undef XA_QK
#undef XA_LOAD
#undef XA_STORE
}
}
#define XB_TMO      128
#define XB_XCNT(j)  (256  + 64 * (j))
#define XB_XSUB(j)  (1280 + 64 * (j))
#define XB_XGEN(j)  (2304 + 64 * (j))
#define XB_TOP      3328
#define XB_TOPGEN   3392
#define XCD_BAR_WORDS 3456
#define XB_SPIN_CAP (1u << 18)

__device__ __forceinline__ unsigned xb_ld(unsigned* p)              { return __hip_atomic_load(p, __ATOMIC_RELAXED, __HIP_MEMORY_SCOPE_AGENT); }
__device__ __forceinline__ unsigned xb_add(unsigned* p, unsigned v) { return __hip_atomic_fetch_add(p, v, __ATOMIC_RELAXED, __HIP_MEMORY_SCOPE_AGENT); }
__device__ __forceinline__ unsigned xb_xcc_id() { return (unsigned)__builtin_amdgcn_s_getreg((3 << 11) | 20) & 0xFu; }
#define XB_SPIN(cond, bar) do { unsigned _sp = 0; while (cond) { __builtin_amdgcn_s_sleep(1); \
    if ((++_sp & 255u) == 0u) { if (xb_ld(&(bar)[XB_TMO])) break; if (_sp > XB_SPIN_CAP) { atomicAdd(&(bar)[XB_TMO], 1u); break; } } } } while (0)

struct XcdBarrier {
    unsigned* bar; unsigned x;
    volatile LAS unsigned* st;
};

__device__ __forceinline__ XcdBarrier xcd_barrier_post(unsigned* bar, volatile LAS unsigned* st) {
    XcdBarrier b; b.bar = bar; b.x = xb_xcc_id(); b.st = st;
    if (threadIdx.x == 0) (void)xb_add(&bar[XB_XCNT(b.x)], 1u);
    return b;
}
__device__ __forceinline__ void xcd_barrier_complete(unsigned* bar, unsigned x, unsigned& nloc, unsigned& nx) {
    const unsigned G = gridDim.x * gridDim.y * gridDim.z;
    unsigned sum, cnt, mine, sp = 0u;
    for (;;) {
        sum = 0u; cnt = 0u; mine = 0u;
#pragma unroll
        for (unsigned j = 0; j < 16; ++j) { const unsigned c = xb_ld(&bar[XB_XCNT(j)]); sum += c; cnt += (c > 0u) ? 1u : 0u; mine = (j == x) ? c : mine; }
        if (sum == G) break;
        __builtin_amdgcn_s_sleep(1);
        if ((++sp & 255u) == 0u) { if (xb_ld(&bar[XB_TMO])) break; if (sp > XB_SPIN_CAP) { atomicAdd(&bar[XB_TMO], 1u); break; } }
    }
    nloc = mine > 0u ? mine : 1u; nx = cnt > 0u ? cnt : 1u;
}

__device__ __forceinline__ void xcd_barrier(const XcdBarrier& b) {
    asm volatile("s_waitcnt vmcnt(0)" ::: "memory");
    __syncthreads();
    if (threadIdx.x == 0) {
        unsigned* bar = b.bar;
        __builtin_amdgcn_s_waitcnt(0);
        unsigned nloc = b.st[0], nx = b.st[1];
        if (nloc == 0u) { xcd_barrier_complete(bar, b.x, nloc, nx); b.st[0] = nloc; b.st[1] = nx; }
        const unsigned old = xb_add(&bar[XB_XSUB(b.x)], 1u);
        const unsigned gen = old / nloc;
        if (old + 1u == (gen + 1u) * nloc) {
            __builtin_amdgcn_fence(__ATOMIC_RELEASE, "agent");
            asm volatile("s_waitcnt vmcnt(0)" ::: "memory");
            const unsigned og = xb_add(&bar[XB_TOP], 1u);
            const unsigned tg = og / nx;
            if (og + 1u == (tg + 1u) * nx) xb_add(&bar[XB_TOPGEN], 1u);
            else XB_SPIN(xb_ld(&bar[XB_TOPGEN]) == tg, bar);
            __builtin_amdgcn_fence(__ATOMIC_ACQUIRE, "agent");
            xb_add(&bar[XB_XGEN(b.x)], 1u);
            asm volatile("s_waitcnt vmcnt(0)" ::: "memory");
        } else {
            XB_SPIN(xb_ld(&bar[XB_XGEN(b.x)]) == gen, bar);
            __builtin_amdgcn_fence(__ATOMIC_ACQUIRE, "agent");
            asm volatile("s_waitcnt vmcnt(0)" ::: "memory");
        }
    }
    __syncthreads();
}

struct Args { const float* in[20]; float* out; unsigned char* ws; int ph_lo, ph_hi, coop, pad; };
constexpr int N_PHASES = 10;
__global__ void __launch_bounds__(NWAVES * 64, 2) mk_fwd(Args args) {
    __builtin_assume(__builtin_amdgcn_workitem_id_y() == 0); __builtin_assume(__builtin_amdgcn_workitem_id_z() == 0);
    extern __shared__ __attribute__((aligned(16))) unsigned char lds[];
    const ldsp L = (ldsp)lds;
    volatile LAS unsigned* MISC = (volatile LAS unsigned*)(L + MISC_OFF);
    const int tid = threadIdx.x, lane = tid & 63, wave = __builtin_amdgcn_readfirstlane(tid >> 6);
    const int G = gridDim.x, bid = blockIdx.x;
#define x (args.in[0])
#define mem (args.in[1])
#define ln1 (args.in[2])
#define w_in (args.in[3])
#define conv_w (args.in[4])
#define conv_b (args.in[5])
#define ml_b_i (args.in[6])
#define ml_b_f (args.in[7])
#define ml_norm (args.in[8])
#define fx_b_f (args.in[9])
#define w_out (args.in[10])
#define ln_x (args.in[11])
#define ln_mem (args.in[12])
#define w_xq (args.in[13])
#define w_xkv (args.in[14])
#define w_xo (args.in[15])
#define ln2 (args.in[16])
#define w_ff1 (args.in[17])
#define w_ff2 (args.in[18])
#define ln_f (args.in[19])
    float* const out = args.out;
#define ctl ((unsigned*)(args.ws + WS_CTL))
#define Win_t ((bf16*)(args.ws + WS_WIN))
#define Wout_t ((bf16*)(args.ws + WS_WOUT))
#define Wxq_t ((bf16*)(args.ws + WS_WXQ))
#define Wxkv_t ((bf16*)(args.ws + WS_WXKV))
#define Wxo_t ((bf16*)(args.ws + WS_WXO))
#define W1_t ((bf16*)(args.ws + WS_W1))
#define W2_t ((bf16*)(args.ws + WS_W2))
#define MEMN ((bf16*)(args.ws + WS_MEMN))
#define KX ((bf16*)(args.ws + WS_KX))
#define VXT ((bf16*)(args.ws + WS_VXT))
#define GT ((float*)(args.ws + WS_G))
#define CNEG ((float*)(args.ws + WS_CNEG))
#define SS1 ((float*)(args.ws + WS_SS1))
#define SS2 ((float*)(args.ws + WS_SS2))
#define SS3 ((float*)(args.ws + WS_SS3))
#define XN ((bf16*)(args.ws + WS_XN))
#define MIX ((bf16*)(args.ws + WS_MIX))
#define Zb ((bf16*)(args.ws + WS_Z))
#define Ub ((bf16*)(args.ws + WS_U))
    const int lo = args.ph_lo, hi = args.ph_hi;
    if (tid < 16) MISC[tid] = 0u;
    __syncthreads();
    const XcdBarrier xbar = xcd_barrier_post((unsigned*)(ctl + 24576), MISC + 8);
#ifndef PH_MASK
#define PH_MASK 0x7ff
#endif
#define IN(k) ((((PH_MASK) >> (k)) & 1) && lo <= (k) && (k) < hi)
#ifndef DIL_MASK
#define DIL_MASK 0
#endif
#ifndef DIL_MUL
#define DIL_MUL 3
#endif
    unsigned long long tprev = (DIL_MASK) ? __builtin_amdgcn_s_memrealtime() : 0ull;
#define SEAM(k) do { if (IN(k) && IN((k) + 1)) { if (args.coop == 0x7fff0001) cg::this_grid().sync(); xcd_barrier(xbar); } \
    if (DIL_MASK) { unsigned long long t1_ = __builtin_amdgcn_s_memrealtime(); if (((DIL_MASK) >> (k)) & 1) { const unsigned long long w_ = (t1_ - tprev) * (DIL_MUL); while (__builtin_amdgcn_s_memrealtime() - t1_ < w_) __builtin_amdgcn_s_sleep(8); t1_ = __builtin_amdgcn_s_memrealtime(); } tprev = t1_; } } while (0)

    if (IN(0)) {
        LAS float* scr = (LAS float*)(L + wave * 16384);
        const int gw = bid * NWAVES + wave, NGW = G * NWAVES;
        constexpr int I_IN = 16 * (NIN / 32), I_SQ = 16 * 32, I_KV = 16 * 64, I_1 = 16 * 128, I_2 = 64 * 32;
        constexpr int NITEMS = I_IN + 3 * I_SQ + I_KV + I_1 + I_2;
        auto ident = [](int n) { return n; };
        auto inmap = [](int n) { return n < 2048 ? n : (n < 3584 ? n + 8 : (n < 3592 ? n - 1536 : (n < 3600 ? n : -1))); };
        for (int it = gw; it < NITEMS; it += NGW) {
            int r = it;
            if (r < I_IN) { p0_transpose_item(w_in, 1024, 3600, NIN, Win_t, scr, r, lane, inmap); continue; } r -= I_IN;
            if (r < I_SQ) { p0_transpose_item(w_out, 1024, 1024, 1024, Wout_t, scr, r, lane, ident); continue; } r -= I_SQ;
            if (r < I_SQ) { p0_transpose_item(w_xq, 1024, 1024, 1024, Wxq_t, scr, r, lane, ident); continue; } r -= I_SQ;
            if (r < I_KV) { p0_transpose_item(w_xkv, 1024, 2048, 2048, Wxkv_t, scr, r, lane, ident); continue; } r -= I_KV;
            if (r < I_SQ) { p0_transpose_item(w_xo, 1024, 1024, 1024, Wxo_t, scr, r, lane, ident); continue; } r -= I_SQ;
            if (r < I_1) { p0_transpose_item(w_ff1, 1024, 4096, 4096, W1_t, scr, r, lane, ident); continue; } r -= I_1;
            p0_transpose_item(w_ff2, 4096, 1024, 1024, W2_t, scr, r, lane, ident);
        }
        { int m = gw; for (; m + 3 * NGW < M; m += 4 * NGW) rms_rows_to_bf16<4>(x + (size_t)m * D, (size_t)NGW * D, ln1, XN + (size_t)m * D, lane);
          for (; m < M; m += NGW) rms_row_to_bf16(x + (size_t)m * D, ln1, XN + (size_t)m * D, lane); }
        for (int m = gw; m < MM; m += NGW) rms_row_to_bf16(mem + (size_t)m * D, ln_mem, MEMN + (size_t)m * D, lane);
        __syncthreads();
    }
    SEAM(0);
    if (IN(1)) {
        pg8::Gemm g{XN, Win_t, M, NIN, D}; pg8::StaticOrder S; S.init(M, NIN, G, bid);
        pg8::EpiZ E{Zb, GT, C2_FOX};
        pg8::gemm_phase<pg8::EpiZ, pg8::StaticOrder, true, true>(L, g, S, E, tid);
    }
    SEAM(1);
    if (IN(2)) {
        if (bid < 64) {
            const int b = bid >> 3, h = bid & 7; const float bfv = fx_b_f[h];
            float v[16]; float run = 0.f;
#pragma unroll
            for (int j = 0; j < 16; ++j) { const int s = 16 * tid + j; run += logsig(GT[((size_t)b * SEQ + s) * 16 + 8 + h] + bfv); v[j] = run; }
            const float inc = ml::scan_add(run, lane);
            LAS float* wt = (LAS float*)(L);
            if (lane == 63) wt[wave] = inc;
            __syncthreads();
            float off = inc - run;
            for (int ww = 0; ww < wave; ++ww) off += wt[ww];
#pragma unroll
            for (int j4 = 0; j4 < 4; ++j4) { f32x4 o;
#pragma unroll
                for (int i = 0; i < 4; ++i) o[i] = -(off + v[4 * j4 + i]) * LOG2E;
                *(f32x4*)(CNEG + (size_t)bid * SEQ + 16 * tid + 4 * j4) = o; }
            __syncthreads();
        } else if (bid < 96) {
            pg8::Gemm g{MEMN, Wxkv_t, MM, 1024, D}; pg8::StaticOrder S; S.init(MM, 1024, 32, bid - 64);
            pg8::EpiPlain E{KX, 1024};
            pg8::gemm_phase<pg8::EpiPlain, pg8::StaticOrder, true, true>(L, g, S, E, tid);
        } else if (bid < 128) {
            pg8::Gemm g{Wxkv_t + (size_t)1024 * 1024, MEMN, 1024, MM, D}; pg8::StaticOrder S; S.init(1024, MM, 32, bid - 96);
            pg8::EpiPlain E{VXT, 2048};
            pg8::gemm_phase<pg8::EpiPlain, pg8::StaticOrder, true, true>(L, g, S, E, tid);
        }
        {
            const ml::PreOut PO{XN, XN + (size_t)32 * 1024 * 1024, (bf16*)(args.ws + WS_VTG), out, SS2, SS3};
            int cw_head = -1;
            const int u0 = bid < 128 ? 14 * bid : 1792 + 18 * (bid - 128), nu = (G == 256) ? (bid < 128 ? 14 : 18) : 0;
            ml::PreRegs PR;
            if (nu > 0) ml::pre_load(u0, Zb, GT, PR, tid);
            for (int i = 0; i < nu; ++i) ml::pre_unit(u0 + i, Zb, GT, PO, conv_w, conv_b, ml_b_i, ml_b_f, L, tid, cw_head, PR, i + 1 < nu ? u0 + i + 1 : -1);
            if (G != 256) { for (int u = bid; u < 4096; u += G) { ml::pre_load(u, Zb, GT, PR, tid); ml::pre_unit(u, Zb, GT, PO, conv_w, conv_b, ml_b_i, ml_b_f, L, tid, cw_head, PR, -1); } }
        }
    }
    SEAM(2);
    if (IN(3)) {
#ifndef NO_ML
        if (bid < 64) { const ml::PreOut PO{XN, XN + (size_t)32 * 1024 * 1024, (bf16*)(args.ws + WS_VTG), out, SS2, SS3}; const int sg = 1 - (bid >> 5), sbh = bid & 31; ml::stream(sbh >> 2, sbh & 3, Zb, PO, MIX, ml_norm, L, tid, 64 * sg, 64 * sg + 64); }
#endif
#if defined(ML_SEP)
        cg::this_grid().sync();
        if (DIL_MASK) { unsigned long long t1_ = __builtin_amdgcn_s_memrealtime(); if (((DIL_MASK) >> 11) & 1) { const unsigned long long w_ = (t1_ - tprev) * (DIL_MUL); while (__builtin_amdgcn_s_memrealtime() - t1_ < w_) __builtin_amdgcn_s_sleep(8); t1_ = __builtin_amdgcn_s_memrealtime(); } tprev = t1_; }
#endif
        {
            if (tid == 0) { MISC[2] = (unsigned)__builtin_amdgcn_s_getreg((3 << 11) | 20) & 7u; MISC[3] = 0u; }
            for (;;) {
                if (tid == 0) { unsigned qi = MISC[3], u = 0xffffffffu;
                    while (qi < 8u) { const unsigned qx = (MISC[2] + qi) & 7u; const unsigned v = atomicAdd(ctl + 64 + 16 * qx, 1u); if (v < 256u) { u = qx * 256u + v; break; } ++qi; }
                    MISC[3] = qi; MISC[0] = u; }
                LBAR();
                const unsigned u = MISC[0];
                LBAR();
                if (u == 0xffffffffu) break;
                const int bh = (int)(u >> 5), qb = 31 - (int)(u & 31); int tq = tid; asm volatile("" : "+v"(tq));
#ifndef NO_FOX
                attn_body::attn_unit<100>(bh >> 3, bh & 7, qb, (const attn_body::bf16*)(Zb + ZC_FXQ), (const attn_body::bf16*)(Zb + ZC_FXK), (const attn_body::bf16*)(Zb + ZC_FXV),
                                        (attn_body::bf16*)(MIX + 512), CNEG + (size_t)bh * SEQ, (char*)lds, tq);
#endif
            }
        }
    }
    SEAM(3);
    if (IN(4)) {
        pg8::Gemm g{MIX, Wout_t, M, D, D}; pg8::StaticOrder S; S.init(M, D, G, bid);
        pg8::EpiRes E{x, out, XN, ln_x, SS1};
        pg8::gemm_phase<pg8::EpiRes, pg8::StaticOrder, true, true>(L, g, S, E, tid);
    }
    SEAM(4);
    if (IN(5)) {
        pg8::Gemm g{XN, Wxq_t, M, D, D}; pg8::StaticOrder S; S.init(M, D, G, bid);
        pg8::EpiRowScale<0> E{MIX, 1024, SS1, C2_X};
        pg8::gemm_phase<pg8::EpiRowScale<0>, pg8::StaticOrder, true, true>(L, g, S, E, tid);
    }
    if (IN(6)) {
#ifndef NO_XA
        { pg8::StaticOrder S; S.init(M, D, G, bid); pg8::Unit uu; for (int i = 0; S.next(i, uu); ++i) xa::xattn_unit(uu.pm, uu.pn, MIX, KX, VXT, L, tid); }
#endif
    }
    SEAM(6);
    if (IN(7)) {
        pg8::Gemm g{MIX, Wxo_t, M, D, D}; pg8::StaticOrder S; S.init(M, D, G, bid);
        pg8::EpiRes E{out, out, XN, ln2, SS2};
        pg8::gemm_phase<pg8::EpiRes, pg8::StaticOrder, true, true>(L, g, S, E, tid);
    }
    SEAM(7);
    if (IN(8)) {
        pg8::Gemm g{XN, W1_t, M, FF, D}; pg8::StaticOrder S; S.init(M, FF, G, bid);
        pg8::EpiRowScale<1> E{Ub, FF, SS2, 1.0f};
        pg8::gemm_phase<pg8::EpiRowScale<1>, pg8::StaticOrder, true, true>(L, g, S, E, tid);
    }
    SEAM(8);
    if (IN(9)) {
        pg8::Gemm g{Ub, W2_t, M, D, FF}; pg8::StaticOrder S; S.init(M, D, G, bid);
        if (G == 256) {
            pg8::EpiResNorm E{out, out, ln_f, SS3, ctl + 4096};
            pg8::gemm_phase<pg8::EpiResNorm, pg8::StaticOrder, true, true>(L, g, S, E, tid);
        } else {
            pg8::EpiRes E{out, out, nullptr, nullptr, SS3};
            pg8::gemm_phase<pg8::EpiRes, pg8::StaticOrder, true, true>(L, g, S, E, tid);
            xcd_barrier(xbar);
            const int gw = bid * NWAVES + wave, NGW = G * NWAVES;
            for (int m = gw; m < M; m += NGW) { const float r = pg8::row_rs(SS3, m); f32x4* p = (f32x4*)(out + (size_t)m * D) + lane;
#pragma unroll
                for (int j = 0; j < 4; ++j) p[64 * j] = p[64 * j] * ((const f32x4*)ln_f)[lane + 64 * j] * r; }
        }
    }
    SEAM(9);
#undef IN
#undef SEAM
}
#undef x
#undef mem
#undef ln1
#undef w_in
#undef conv_w
#undef conv_b
#undef ml_b_i
#undef ml_b_f
#undef ml_norm
#undef fx_b_f
#undef w_out
#undef ln_x
#undef ln_mem
#undef w_xq
#undef w_xkv
#undef w_xo
#undef ln2
#undef w_ff1
#undef w_ff2
#undef ln_f
#undef ctl
#undef Win_t
#undef Wout_t
#undef Wxq_t
#undef Wxkv_t
#undef Wxo_t
#undef W1_t
#undef W2_t
#undef MEMN
#undef KX
#undef VXT
#undef GT
#undef CNEG
#undef SS1
#undef SS2
#undef SS3
#undef XN
#undef MIX
#undef Zb
#undef Ub

#ifndef MK_SPLIT
#define MK_SPLIT 0
#endif
extern "C" void kernel_launch(void* const* d_in, const int* in_sizes, int n_in, void* d_out, int out_size, void* d_ws, size_t ws_size, hipStream_t stream) {
    static int grid = 0;
    if (grid == 0) {
        if (n_in != 20 || out_size != M * D || ws_size < WS_END) { fprintf(stderr, "kernel_launch: unexpected problem (n_in %d out %d ws %zu)\n", n_in, out_size, ws_size); grid = -1; return; }
        int dev = 0, cus = 0, per_cu = 0;
        hipGetDevice(&dev); hipDeviceGetAttribute(&cus, hipDeviceAttributeMultiprocessorCount, dev);
        if (hipFuncSetAttribute((const void*)mk_fwd, hipFuncAttributeMaxDynamicSharedMemorySize, LDS_BYTES) != hipSuccess) { fprintf(stderr, "kernel_launch: hipFuncSetAttribute failed\n"); grid = -1; return; }
        if (hipOccupancyMaxActiveBlocksPerMultiprocessor(&per_cu, (const void*)mk_fwd, NWAVES * 64, LDS_BYTES) != hipSuccess || per_cu < 1) { fprintf(stderr, "kernel_launch: occupancy query says %d\n", per_cu); per_cu = 1; }
        (void)hipGetLastError();
        grid = cus;
        if (grid > 256) grid = 256;
    }
    if (grid < 0) return;
    hipMemsetAsync((char*)d_ws + WS_CTL, 0, CTL_ZERO_BYTES, stream);
    Args a{};
    for (int i = 0; i < 20; ++i) a.in[i] = (const float*)d_in[i];
    a.out = (float*)d_out; a.ws = (unsigned char*)d_ws;
#if MK_SPLIT
    for (int p = 0; p < N_PHASES; ++p) { a.ph_lo = p; a.ph_hi = p + 1; a.coop = 0; hipLaunchKernelGGL(mk_fwd, dim3(grid), dim3(NWAVES * 64), LDS_BYTES, stream, a); }
#else
    a.ph_lo = 0; a.ph_hi = N_PHASES; a.coop = 1;
    void* kargs[] = {&a};
    hipError_t e = hipLaunchCooperativeKernel((const void*)mk_fwd, dim3(grid), dim3(NWAVES * 64), kargs, LDS_BYTES, stream);
    if (e != hipSuccess) fprintf(stderr, "cooperative launch failed: %s (grid %d)\n", hipGetErrorString(e), grid);
#endif
}
```

```cpp
#include <hip/hip_runtime.h>
#include <hip/hip_cooperative_groups.h>
#include <hip/hip_bf16.h>
#include <cstdio>
#include <cstdint>
#include <cmath>
namespace cg = cooperative_groups;
namespace pg8 {
#define PG8_LAS __attribute__((address_space(3)))
typedef unsigned short bf16_t;
typedef short bf16x8 __attribute__((ext_vector_type(8)));
typedef float f32x4 __attribute__((ext_vector_type(4)));
typedef unsigned u32x4 __attribute__((ext_vector_type(4)));
constexpr int BM = 256, BK = 64, HALF = 128, HTB = HALF * BK * 2  , STAGE_BYTES = 8 * HTB, NXCD = 8, WGM = 8;

__host__ __device__ __forceinline__ int lds_byte(int r, int c) { const int st = (r >> 4) * 2 + (c >> 5), rr = r & 15, cc = c & 31, ob = rr * 64 + cc * 2; return st * 1024 + (ob ^ (((ob >> 9) & 1) << 5)); }
__host__ __device__ __forceinline__ void stage_rc(int b, int& R, int& C) { const int st = b / 1024, sb = b % 1024, swz = sb ^ (((sb >> 9) & 1) << 5); R = (st >> 1) * 16 + swz / 64; C = (st & 1) * 32 + (swz % 64) / 2; }
__host__ __device__ __forceinline__ int perm32(int rho) { const int n = rho >> 4, i = rho & 15; return 8 * (i >> 2) + 4 * n + (i & 3); }

struct Unit { int pm, pn; };
struct Gemm { const bf16_t* A; const bf16_t* Bt; int M, N, K; };

struct StaticOrder {
    int nM, nN, nwg, G, c;
    __host__ __device__ void init(int M, int N, int G_, int c_) { nM = M / BM; nN = N / BM; nwg = nM * nN; G = G_; c = c_; }
    __host__ __device__ bool next(int i, Unit& u) const {
        const long L = (long)i * G + c; if (L >= nwg) return false;
        int wgid = (int)L; { const int q = nwg / NXCD, r = nwg % NXCD, xcd = wgid % NXCD, off = wgid / NXCD; wgid = (xcd < r ? xcd * (q + 1) : r * (q + 1) + (xcd - r) * q) + off; }
        const int nig = WGM * nN, gid = wgid / nig, fm = gid * WGM, gsz = (nM - fm) < WGM ? (nM - fm) : WGM;
        u.pm = fm + ((wgid % nig) % gsz); u.pn = (wgid % nig) / gsz; return true;
    }
    __device__ __forceinline__ void a_ready(const Unit&) const {}
    __device__ __forceinline__ void done(const Unit&) const {}
};

__device__ __forceinline__ unsigned cvt_pk_bf16(float lo, float hi) { unsigned r; asm volatile("v_cvt_pk_bf16_f32 %0, %1, %2" : "=v"(r) : "v"(lo), "v"(hi)); return r; }
typedef float f32x2 __attribute__((ext_vector_type(2)));
typedef unsigned u32x2 __attribute__((ext_vector_type(2)));
constexpr float RMS_EPS = 1e-6f;
__device__ __forceinline__ float row_rs(const float* ss, int row) {
    const f32x4* p = (const f32x4*)(ss + (size_t)row * 16);
    const f32x4 a = p[0], b = p[1], c = p[2], d = p[3];
    const float s = ((a[0] + a[1]) + (a[2] + a[3])) + ((b[0] + b[1]) + (b[2] + b[3])) + ((c[0] + c[1]) + (c[2] + c[3])) + ((d[0] + d[1]) + (d[2] + d[3]));
    return 1.0f / sqrtf(s * (1.0f / 1024.0f) + RMS_EPS);
}
struct EpiZ {
    static constexpr bool PERM = true, AFTER_DRAIN = false;
    bf16_t* Z; float* G; float c2;
    __device__ __forceinline__ void operator()(const f32x4 (&acc)[2][2][4][2], const Unit& u, int wr, int wc, int fr, int fq) const {
        const int row0 = u.pm * BM + wr * 64 + fr;
        if (u.pn < 14) {
            const float sc = (u.pn == 8 || u.pn == 9) ? c2 : 1.0f;
            const int col0 = u.pn * BM + wc * 32 + 8 * fq;
#pragma unroll
            for (int ai = 0; ai < 2; ++ai)
#pragma unroll
                for (int m = 0; m < 4; ++m) { bf16_t* rowp = Z + (size_t)(row0 + ai * HALF + m * 16) * 3584 + col0;
#pragma unroll
                    for (int bj = 0; bj < 2; ++bj) { const f32x4 v0 = acc[ai][bj][m][0] * sc, v1 = acc[ai][bj][m][1] * sc;
                        u32x4 w; w.x = cvt_pk_bf16(v0[0], v0[1]); w.y = cvt_pk_bf16(v0[2], v0[3]); w.z = cvt_pk_bf16(v1[0], v1[1]); w.w = cvt_pk_bf16(v1[2], v1[3]);
                        *(u32x4*)(rowp + bj * HALF) = w; } }
        } else if (wc == 0 && fq < 2) {
#pragma unroll
            for (int ai = 0; ai < 2; ++ai)
#pragma unroll
                for (int m = 0; m < 4; ++m) { float* gp = G + (size_t)(row0 + ai * HALF + m * 16) * 16 + 8 * fq;
                    *(f32x4*)(gp) = acc[ai][0][m][0]; *(f32x4*)(gp + 4) = acc[ai][0][m][1]; }
        }
    }
};
struct EpiPlain {
    static constexpr bool PERM = true, AFTER_DRAIN = false;
    bf16_t* O; int ldc;
    __device__ __forceinline__ void operator()(const f32x4 (&acc)[2][2][4][2], const Unit& u, int wr, int wc, int fr, int fq) const {
        const int row0 = u.pm * BM + wr * 64 + fr; const int col0 = u.pn * BM + wc * 32 + 8 * fq;
#pragma unroll
        for (int ai = 0; ai < 2; ++ai)
#pragma unroll
            for (int m = 0; m < 4; ++m) { bf16_t* rowp = O + (size_t)(row0 + ai * HALF + m * 16) * ldc + col0;
#pragma unroll
                for (int bj = 0; bj < 2; ++bj) { const f32x4 v0 = acc[ai][bj][m][0], v1 = acc[ai][bj][m][1];
                    u32x4 w; w.x = cvt_pk_bf16(v0[0], v0[1]); w.y = cvt_pk_bf16(v0[2], v0[3]); w.z = cvt_pk_bf16(v1[0], v1[1]); w.w = cvt_pk_bf16(v1[2], v1[3]);
                    *(u32x4*)(rowp + bj * HALF) = w; } }
    }
};
template <int ACT> struct EpiRowScale {
    static constexpr bool PERM = true, AFTER_DRAIN = false;
    bf16_t* O; int ldc; const float* ss; float sc;
    __device__ __forceinline__ void operator()(const f32x4 (&acc)[2][2][4][2], const Unit& u, int wr, int wc, int fr, int fq) const {
        const int row0 = u.pm * BM + wr * 64 + fr; const int col0 = u.pn * BM + wc * 32 + 8 * fq;
#pragma unroll
        for (int ai = 0; ai < 2; ++ai)
#pragma unroll
            for (int m = 0; m < 4; ++m) { const int row = row0 + ai * HALF + m * 16; const float r = row_rs(ss, row) ; bf16_t* rowp = O + (size_t)row * ldc + col0;
#pragma unroll
                for (int bj = 0; bj < 2; ++bj) { f32x4 v0 = acc[ai][bj][m][0] * r, v1 = acc[ai][bj][m][1] * r;
                    if (ACT == 1) {
#pragma unroll
                        for (int e = 0; e < 4; ++e) { const float a = fmaxf(v0[e], 0.f), b = fmaxf(v1[e], 0.f); v0[e] = a * a; v1[e] = b * b; }
                    } else { v0 = v0 * sc; v1 = v1 * sc; }
                    u32x4 w; w.x = cvt_pk_bf16(v0[0], v0[1]); w.y = cvt_pk_bf16(v0[2], v0[3]); w.z = cvt_pk_bf16(v1[0], v1[1]); w.w = cvt_pk_bf16(v1[2], v1[3]);
                    *(u32x4*)(rowp + bj * HALF) = w; } }
    }
};
struct EpiRes {
    static constexpr bool PERM = true, AFTER_DRAIN = false;
    const float* base; float* out; bf16_t* xn; const float* gain; float* ssout;
    __device__ __forceinline__ void operator()(const f32x4 (&acc)[2][2][4][2], const Unit& u, int wr, int wc, int fr, int fq) const {
        const int row0 = u.pm * BM + wr * 64 + fr; const int col0 = u.pn * BM + wc * 32 + 8 * fq;
        f32x4 gv[2][2];
#pragma unroll
        for (int bj = 0; bj < 2; ++bj)
#pragma unroll
            for (int n = 0; n < 2; ++n) { if (xn) gv[bj][n] = *(const f32x4*)(gain + col0 + bj * HALF + n * 4); else gv[bj][n] = (f32x4){1.f, 1.f, 1.f, 1.f}; }
#pragma unroll
        for (int ai = 0; ai < 2; ++ai) {
            f32x4 bs[4][2][2];
#pragma unroll
            for (int m = 0; m < 4; ++m) { const size_t off = (size_t)(row0 + ai * HALF + m * 16) * 1024 + col0;
#pragma unroll
                for (int bj = 0; bj < 2; ++bj) { bs[m][bj][0] = *(const f32x4*)(base + off + bj * HALF); bs[m][bj][1] = *(const f32x4*)(base + off + bj * HALF + 4); } }
#pragma unroll
            for (int m = 0; m < 4; ++m) { const int row = row0 + ai * HALF + m * 16; const size_t off = (size_t)row * 1024 + col0; float sq = 0.f;
#pragma unroll
                for (int bj = 0; bj < 2; ++bj) {
                    const f32x4 o0 = bs[m][bj][0] + acc[ai][bj][m][0], o1 = bs[m][bj][1] + acc[ai][bj][m][1];
                    *(f32x4*)(out + off + bj * HALF) = o0; *(f32x4*)(out + off + bj * HALF + 4) = o1;
                    sq += ((o0[0] * o0[0] + o0[1] * o0[1]) + (o0[2] * o0[2] + o0[3] * o0[3])) + ((o1[0] * o1[0] + o1[1] * o1[1]) + (o1[2] * o1[2] + o1[3] * o1[3]));
                    if (xn) { const f32x4 g0 = o0 * gv[bj][0], g1 = o1 * gv[bj][1]; u32x4 w; w.x = cvt_pk_bf16(g0[0], g0[1]); w.y = cvt_pk_bf16(g0[2], g0[3]); w.z = cvt_pk_bf16(g1[0], g1[1]); w.w = cvt_pk_bf16(g1[2], g1[3]);
                        *(u32x4*)(xn + off + bj * HALF) = w; } }
                sq += __shfl_xor(sq, 16); sq += __shfl_xor(sq, 32);
                if (fq == 0) ssout[(size_t)row * 16 + u.pn * 4 + wc] = sq; }
            asm volatile("" ::: "memory"); }
    }
};
struct EpiResNorm {
    static constexpr bool PERM = true, AFTER_DRAIN = false;
    const float* base; float* out; const float* gain; float* ss; unsigned* cnt;
    __device__ __forceinline__ void operator()(const f32x4 (&acc_c)[2][2][4][2], const Unit& u, int wr, int wc, int fr, int fq) const {
        f32x4 (&acc)[2][2][4][2] = const_cast<f32x4 (&)[2][2][4][2]>(acc_c);
        const int row0 = u.pm * BM + wr * 64 + fr; const int col0 = u.pn * BM + wc * 32 + 8 * fq;
#pragma unroll
        for (int ai = 0; ai < 2; ++ai)
#pragma unroll
            for (int m = 0; m < 4; ++m) { const int row = row0 + ai * HALF + m * 16; const size_t off = (size_t)row * 1024 + col0; float sq = 0.f;
#pragma unroll
                for (int bj = 0; bj < 2; ++bj) {
                    const f32x4 b0 = *(const f32x4*)(base + off + bj * HALF), b1 = *(const f32x4*)(base + off + bj * HALF + 4);
                    const f32x4 o0 = b0 + acc[ai][bj][m][0], o1 = b1 + acc[ai][bj][m][1];
                    acc[ai][bj][m][0] = o0; acc[ai][bj][m][1] = o1;
                    sq += ((o0[0] * o0[0] + o0[1] * o0[1]) + (o0[2] * o0[2] + o0[3] * o0[3])) + ((o1[0] * o1[0] + o1[1] * o1[1]) + (o1[2] * o1[2] + o1[3] * o1[3])); }
                sq += __shfl_xor(sq, 16); sq += __shfl_xor(sq, 32);
                if (fq == 0) __hip_atomic_store(ss + (size_t)row * 16 + u.pn * 4 + wc, sq, __ATOMIC_RELAXED, __HIP_MEMORY_SCOPE_AGENT);
                if (m == 3) asm volatile("" ::: "memory"); }
        asm volatile("s_waitcnt vmcnt(0)" ::: "memory");
        unsigned* c = cnt + 64 * u.pm;
        if ((fr | fq) == 0) __hip_atomic_fetch_add(c, 1u, __ATOMIC_RELAXED, __HIP_MEMORY_SCOPE_AGENT);
        { unsigned spins = 0;
          while ((unsigned)__builtin_amdgcn_readfirstlane(__hip_atomic_load(c, __ATOMIC_RELAXED, __HIP_MEMORY_SCOPE_AGENT)) < 32u) { __builtin_amdgcn_s_sleep(2); if (++spins > (1u << 22)) break; } }
        asm volatile("" ::: "memory");
        f32x4 gv[2][2];
#pragma unroll
        for (int bj = 0; bj < 2; ++bj)
#pragma unroll
            for (int n = 0; n < 2; ++n) gv[bj][n] = *(const f32x4*)(gain + col0 + bj * HALF + n * 4);
#pragma unroll
        for (int ai = 0; ai < 2; ++ai)
#pragma unroll
            for (int m = 0; m < 4; ++m) { const int row = row0 + ai * HALF + m * 16; const size_t off = (size_t)row * 1024 + col0;
                const unsigned long long* sp = (const unsigned long long*)(ss + (size_t)row * 16); float tot = 0.f;
#pragma unroll
                for (int k = 0; k < 8; ++k) { const unsigned long long v = __hip_atomic_load(sp + k, __ATOMIC_RELAXED, __HIP_MEMORY_SCOPE_AGENT); tot += __uint_as_float((unsigned)v) + __uint_as_float((unsigned)(v >> 32)); }
                const float r = 1.0f / sqrtf(tot * (1.0f / 1024.0f) + RMS_EPS);
#pragma unroll
                for (int bj = 0; bj < 2; ++bj) { *(f32x4*)(out + off + bj * HALF) = acc[ai][bj][m][0] * gv[bj][0] * r; *(f32x4*)(out + off + bj * HALF + 4) = acc[ai][bj][m][1] * gv[bj][1] * r; }
                asm volatile("" ::: "memory"); }
    }
};
template <class Epi, class Sched, bool ALIGN_EPI = false, bool SP2 = false>
__device__ __forceinline__ void gemm_phase(PG8_LAS unsigned char* lds, const Gemm g, const Sched& S, const Epi& E, const int tid_in) {
    const int tid = tid_in, wid = __builtin_amdgcn_readfirstlane(tid >> 6), lane = tid & 63, wr = wid >> 2, wc = wid & 3, fr = lane & 15, fq = lane >> 4;
    const int K = g.K, nt = K / BK;
    unsigned voffA[2], voffB[2];
#pragma unroll
    for (int i = 0; i < 2; ++i) { int R, C; stage_rc(tid * 16 + i * 8192, R, C); const int Rb = Epi::PERM ? ((R & ~31) + perm32(R & 31)) : R;
        voffA[i] = (unsigned)(R * K + C) * 2u; voffB[i] = (unsigned)(Rb * K + C) * 2u; }
    const size_t kstep = (size_t)(BK * 2);
    const size_t hstep = (size_t)HALF * K * 2;
    const size_t tstep = 2 * hstep;
    const unsigned ldsw = (unsigned)wid * 1024u;
    const int aoff = lds_byte(wr * 64 + fr, fq * 8), boff = lds_byte(wc * 32 + fr, fq * 8);
#define PG8_SA(b, h) (((b) * 2 + (h)) * HTB)
#define PG8_SB(b, h) ((4 + (b) * 2 + (h)) * HTB)
#define PG8_STAGE(bufoff, gbase, voff) do { _Pragma("unroll") for (int _i = 0; _i < 2; ++_i) \
        __builtin_amdgcn_global_load_lds((const unsigned*)((const char*)(gbase) + (voff)[_i]), (PG8_LAS unsigned*)(lds + (bufoff) + ldsw + _i * 8192), 16, 0, 0); } while (0)
#define PG8_LDA(dst, b, h) do { _Pragma("unroll") for (int m = 0; m < 4; ++m) _Pragma("unroll") for (int k = 0; k < 2; ++k) dst[m][k] = *(const PG8_LAS bf16x8*)(lds + PG8_SA(b, h) + aoff + m * 2048 + k * 1024); } while (0)
#define PG8_LDB(dst, b, h) do { _Pragma("unroll") for (int n = 0; n < 2; ++n) _Pragma("unroll") for (int k = 0; k < 2; ++k) dst[n][k] = *(const PG8_LAS bf16x8*)(lds + PG8_SB(b, h) + boff + n * 2048 + k * 1024); } while (0)
#define PG8_MMA(ai, bj, At, Bt) do { __builtin_amdgcn_s_setprio(1); _Pragma("unroll") for (int m = 0; m < 4; ++m) _Pragma("unroll") for (int n = 0; n < 2; ++n) _Pragma("unroll") for (int k = 0; k < 2; ++k) \
        acc[ai][bj][m][n] = __builtin_amdgcn_mfma_f32_16x16x32_bf16(Bt[n][k], At[m][k], acc[ai][bj][m][n], 0, 0, 0); __builtin_amdgcn_s_setprio(0); } while (0)
#define PG8_WAIT_V(n) asm volatile("s_waitcnt vmcnt(" #n ")" ::: "memory")
#define PG8_WAIT_L(n) asm volatile("s_waitcnt lgkmcnt(" #n ")" ::: "memory")
#define PG8_BAR __builtin_amdgcn_s_barrier()
#define PG8_SCHED __builtin_amdgcn_sched_barrier(0)
    Unit cur, nxt; int ui = 0;
    if (!S.next(0, cur)) return;
    f32x4 acc[2][2][4][2];
#pragma unroll
    for (int a = 0; a < 2; ++a)
#pragma unroll
        for (int b = 0; b < 2; ++b)
#pragma unroll
            for (int m = 0; m < 4; ++m)
#pragma unroll
                for (int n = 0; n < 2; ++n) acc[a][b][m][n] = (f32x4){0.f, 0.f, 0.f, 0.f};
    bf16x8 At[4][2], B0[2][2], B1[2][2];
    const char* cA = (const char*)g.A + (size_t)cur.pm * tstep; const char* cB = (const char*)g.Bt + (size_t)cur.pn * tstep;
    S.a_ready(cur);
    if constexpr (SP2) {
        PG8_STAGE(PG8_SB(0, 0), cB, voffB); PG8_STAGE(PG8_SB(0, 1), cB + hstep, voffB); PG8_STAGE(PG8_SA(0, 0), cA, voffA); PG8_STAGE(PG8_SA(0, 1), cA + hstep, voffA);
        if (wr == 1) PG8_BAR;
        PG8_WAIT_V(2); PG8_BAR;
        PG8_STAGE(PG8_SB(1, 0), cB + kstep, voffB); PG8_STAGE(PG8_SA(1, 0), cA + kstep, voffA); PG8_STAGE(PG8_SB(1, 1), cB + hstep + kstep, voffB);
        PG8_WAIT_V(6); PG8_BAR;
    } else {
        PG8_STAGE(PG8_SB(0, 0), cB, voffB); PG8_STAGE(PG8_SA(0, 0), cA, voffA); PG8_STAGE(PG8_SB(0, 1), cB + hstep, voffB); PG8_STAGE(PG8_SA(0, 1), cA + hstep, voffA);
        if (wr == 1) PG8_BAR;
        PG8_WAIT_V(4); PG8_BAR;
        PG8_STAGE(PG8_SB(1, 0), cB + kstep, voffB); PG8_STAGE(PG8_SA(1, 0), cA + kstep, voffA); PG8_STAGE(PG8_SB(1, 1), cB + hstep + kstep, voffB);
        PG8_WAIT_V(6); PG8_BAR;
    }
    for (;;) {
        const bool has_next = S.next(ui + 1, nxt);
        const char* nA = has_next ? (const char*)g.A + (size_t)nxt.pm * tstep : cA; const char* nB = has_next ? (const char*)g.Bt + (size_t)nxt.pn * tstep : cB;
        for (int t = 0; t < nt; t += 2) {
            const bool last = (t == nt - 2);
            const char* a1 = cA + (size_t)(t + 1) * kstep;
            const char* a2 = last ? nA : cA + (size_t)(t + 2) * kstep; const char* b2 = last ? nB : cB + (size_t)(t + 2) * kstep;
            const char* a3 = a2 + kstep; const char* b3 = b2 + kstep;
            if (last && has_next) S.a_ready(nxt);
            if constexpr (SP2) {
            PG8_LDB(B0, 0, 0); PG8_LDB(B1, 0, 1); PG8_SCHED; PG8_LDA(At, 0, 0); PG8_STAGE(PG8_SA(1, 1), a1 + hstep, voffA);
            PG8_WAIT_V(8); PG8_WAIT_L(0); PG8_BAR; PG8_MMA(0, 0, At, B0); PG8_MMA(0, 1, At, B1); PG8_BAR; PG8_SCHED;
            PG8_LDA(At, 0, 1); PG8_STAGE(PG8_SB(0, 0), b2, voffB); PG8_STAGE(PG8_SB(0, 1), b2 + hstep, voffB); PG8_STAGE(PG8_SA(0, 0), a2, voffA);
            PG8_WAIT_V(8); PG8_WAIT_L(0); PG8_BAR; PG8_MMA(1, 0, At, B0); PG8_MMA(1, 1, At, B1); PG8_BAR; PG8_SCHED;
            PG8_LDB(B0, 1, 0); PG8_LDB(B1, 1, 1); PG8_SCHED; PG8_LDA(At, 1, 0); PG8_STAGE(PG8_SA(0, 1), a2 + hstep, voffA);
            PG8_WAIT_V(8); PG8_WAIT_L(0); PG8_BAR; PG8_MMA(0, 0, At, B0); PG8_MMA(0, 1, At, B1); PG8_BAR; PG8_SCHED;
            PG8_LDA(At, 1, 1); PG8_STAGE(PG8_SB(1, 0), b3, voffB); PG8_STAGE(PG8_SB(1, 1), b3 + hstep, voffB); PG8_STAGE(PG8_SA(1, 0), a3, voffA);
            PG8_WAIT_V(8); PG8_WAIT_L(0); PG8_BAR; PG8_MMA(1, 0, At, B0); PG8_MMA(1, 1, At, B1); PG8_BAR; PG8_SCHED;
            } else {
            PG8_LDB(B0, 0, 0); PG8_SCHED; PG8_LDA(At, 0, 0); PG8_STAGE(PG8_SA(1, 1), a1 + hstep, voffA);
            PG8_WAIT_L(8); PG8_BAR; PG8_WAIT_L(0); PG8_MMA(0, 0, At, B0); PG8_BAR; PG8_SCHED;
            PG8_LDB(B1, 0, 1); PG8_STAGE(PG8_SB(0, 0), b2, voffB);
            PG8_BAR; PG8_WAIT_L(0); PG8_MMA(0, 1, At, B1); PG8_BAR;
            PG8_LDA(At, 0, 1); PG8_STAGE(PG8_SA(0, 0), a2, voffA);
            PG8_BAR; PG8_WAIT_L(0); PG8_MMA(1, 0, At, B0); PG8_BAR; PG8_SCHED;
            PG8_STAGE(PG8_SB(0, 1), b2 + hstep, voffB);
            PG8_WAIT_V(6); PG8_BAR; PG8_MMA(1, 1, At, B1); PG8_BAR;
            PG8_LDB(B0, 1, 0); PG8_SCHED; PG8_LDA(At, 1, 0); PG8_STAGE(PG8_SA(0, 1), a2 + hstep, voffA);
            PG8_WAIT_L(8); PG8_BAR; PG8_WAIT_L(0); PG8_MMA(0, 0, At, B0); PG8_BAR; PG8_SCHED;
            PG8_LDB(B1, 1, 1); PG8_STAGE(PG8_SB(1, 0), b3, voffB);
            PG8_BAR; PG8_WAIT_L(0); PG8_MMA(0, 1, At, B1); PG8_BAR;
            PG8_LDA(At, 1, 1); PG8_STAGE(PG8_SA(1, 0), a3, voffA);
            PG8_BAR; PG8_WAIT_L(0); PG8_MMA(1, 0, At, B0); PG8_BAR; PG8_SCHED;
            PG8_STAGE(PG8_SB(1, 1), b3 + hstep, voffB);
            PG8_WAIT_V(6); PG8_BAR; PG8_MMA(1, 1, At, B1); PG8_BAR;
            }
        }
        if constexpr (ALIGN_EPI) { if (wr == 0) PG8_BAR; }
        if constexpr (!Epi::AFTER_DRAIN) { E(acc, cur, wr, wc, fr, fq); S.done(cur); }
        if (!has_next) break;
#pragma unroll
        for (int a = 0; a < 2; ++a)
#pragma unroll
            for (int b = 0; b < 2; ++b)
#pragma unroll
                for (int m = 0; m < 4; ++m)
#pragma unroll
                    for (int n = 0; n < 2; ++n) acc[a][b][m][n] = (f32x4){0.f, 0.f, 0.f, 0.f};
        cur = nxt; cA = nA; cB = nB; ++ui;
        if constexpr (ALIGN_EPI) { if (wr == 1) PG8_BAR; }
    }
    PG8_WAIT_V(0);
    if constexpr (!ALIGN_EPI) { if (wr == 0) PG8_BAR; }
    PG8_BAR;
    if constexpr (Epi::AFTER_DRAIN) { E.fused(acc, cur, wr, wc, fr, fq, lds, wid, lane); S.done(cur); }
#undef PG8_SA
#undef PG8_SB
#undef PG8_STAGE
#undef PG8_LDA
#undef PG8_LDB
#undef PG8_MMA
#undef PG8_WAIT_V
#undef PG8_WAIT_L
#undef PG8_BAR
#undef PG8_SCHED
}
}
#include <hip/hip_bf16.h>
#include <cmath>
namespace attn_body {
using bf16=__hip_bfloat16;
using bf16x8=__attribute__((ext_vector_type(8)))short;
using s16x4=__attribute__((ext_vector_type(4)))short;
using f32x16=__attribute__((ext_vector_type(16)))float;
using u32x4=__attribute__((ext_vector_type(4)))unsigned;
using f32x4_t=__attribute__((ext_vector_type(4)))float;
constexpr int BATCH=8,NHEAD=8,SEQ=8192,D=64,DM=3584,DMO=1024;
constexpr int NW=8,QBLK=32,QB=QBLK*NW,KVBLK=64,NQB=SEQ/QB;
constexpr int ATTN_PITCH=DM, ATTN_UNIT_ROWS=QB;
__device__ __forceinline__ int crow(int r,int hi){return (r&3)+8*(r>>2)+4*hi;}
#define SBAR() __builtin_amdgcn_sched_barrier(0)
__device__ __forceinline__ void cmask(f32x16&p0,f32x16&p1,int jb,int qrel,int hi){
  const float NEG=-INFINITY; int dq=qrel-64*jb-4*hi; asm volatile("":"+v"(dq));
  #pragma unroll
  for(int r=0;r<16;++r){const int c=(r&3)+8*(r>>2); if(c>dq)p0[r]=NEG; if(c+32>dq)p1[r]=NEG;}
}

constexpr int NSLOT=3, SLOTB=8192;
constexpr int LDS_K=0, LDS_V=NSLOT*SLOTB, LDS_WS=2*NSLOT*SLOTB, LDS_OST=LDS_WS+NW*64*4, LDS_CN=LDS_OST+NW*4096, LDS_BYTES=LDS_CN+SEQ*4;
constexpr float C2=0.125f*1.4426950408889634f;
__device__ __forceinline__ void glds16(const void*gsrc,unsigned lds_dst){unsigned keep;
  asm volatile("s_mov_b32 %0, m0\n\ts_mov_b32 m0, %2\n\ts_nop 0\n\tglobal_load_lds_dwordx4 %1, off\n\ts_mov_b32 m0, %0":"=&s"(keep):"v"(gsrc),"s"(lds_dst):"memory");}
__device__ __forceinline__ float max3f(float a,float b,float c){float r;asm("v_max3_f32 %0, %1, %2, %3":"=v"(r):"v"(a),"v"(b),"v"(c));return r;}
__device__ __forceinline__ float max2f(float a,float b){float r;asm("v_max_f32_e32 %0, %1, %2":"=v"(r):"v"(a),"v"(b));return r;}
__device__ __forceinline__ float fadd_s(float a,float b){float r;asm("v_add_f32_e32 %0, %1, %2":"=v"(r):"v"(a),"v"(b));return r;}
__device__ __forceinline__ float fsub_s(float a,float b){float r;asm("v_sub_f32_e32 %0, %1, %2":"=v"(r):"v"(a),"v"(b));return r;}
typedef float f32x2_t __attribute__((ext_vector_type(2))); typedef __bf16 bf16x2_t __attribute__((ext_vector_type(2)));
__device__ __forceinline__ unsigned cvtpk_s(float lo,float hi){f32x2_t v={lo,hi};bf16x2_t b=__builtin_convertvector(v,bf16x2_t);return __builtin_bit_cast(unsigned,b);}
#define WAIT_BAR(N) asm volatile("s_waitcnt vmcnt(" #N ") lgkmcnt(0)\n\ts_barrier":::"memory")

__device__ __forceinline__ void qkt(f32x16&p0,f32x16&p1,const char*Kslot,const bf16x8*qr,int r32,int hi){
  const char*kb=Kslot+hi*1024+r32*16;
  #pragma unroll
  for(int d0=0;d0<4;++d0){
    const bf16x8 b0=*reinterpret_cast<const bf16x8*>(kb+d0*2048);
    const bf16x8 b1=*reinterpret_cast<const bf16x8*>(kb+d0*2048+512);
    {p0=__builtin_amdgcn_mfma_f32_32x32x16_bf16(b0,qr[d0],p0,0,0,0);p1=__builtin_amdgcn_mfma_f32_32x32x16_bf16(b1,qr[d0],p1,0,0,0);}}
}
typedef __attribute__((address_space(3))) const char* lds_cptr;
typedef short v4i16_t __attribute__((ext_vector_type(4)));
__device__ __forceinline__ void kload8(bf16x8*kf,lds_cptr kp){
  kf[0]=*(const __attribute__((address_space(3))) bf16x8*)(kp);      kf[1]=*(const __attribute__((address_space(3))) bf16x8*)(kp+512);
  kf[2]=*(const __attribute__((address_space(3))) bf16x8*)(kp+2048); kf[3]=*(const __attribute__((address_space(3))) bf16x8*)(kp+2560);
  kf[4]=*(const __attribute__((address_space(3))) bf16x8*)(kp+4096); kf[5]=*(const __attribute__((address_space(3))) bf16x8*)(kp+4608);
  kf[6]=*(const __attribute__((address_space(3))) bf16x8*)(kp+6144); kf[7]=*(const __attribute__((address_space(3))) bf16x8*)(kp+6656);
}
__device__ __forceinline__ void kload2(bf16x8*kf,lds_cptr kp,int j){ kf[2*j]=*(const __attribute__((address_space(3))) bf16x8*)(kp+j*2048); kf[2*j+1]=*(const __attribute__((address_space(3))) bf16x8*)(kp+j*2048+512); }
__device__ __forceinline__ s16x4 vtr(lds_cptr p){ return __builtin_bit_cast(s16x4,__builtin_amdgcn_ds_read_tr16_b64_v4i16((__attribute__((address_space(3))) v4i16_t*)p)); }
__device__ __forceinline__ float rowmax(const f32x16&p0,const f32x16&p1){
  float a=max3f(p0[0],p0[1],p1[0]),b=max3f(p0[2],p0[3],p1[1]);a=max3f(a,p1[2],p1[3]);
  #pragma unroll
  for(int r=4;r<16;r+=4){a=max3f(a,p0[r],p0[r+1]);b=max3f(b,p0[r+2],p0[r+3]);a=max3f(a,p1[r],p1[r+1]);b=max3f(b,p1[r+2],p1[r+3]);}
  const float m=max2f(a,b);
  auto rr=__builtin_amdgcn_permlane32_swap(__float_as_uint(m),__float_as_uint(m),false,false);
  return max2f(__uint_as_float(rr[0]),__uint_as_float(rr[1]));
}
__device__ __forceinline__ void pv(f32x16*o,int vb,bf16x8 pa0,bf16x8 pa1,bf16x8 pa2,bf16x8 pa3){
  #pragma unroll
  for(int d0=0;d0<2;++d0){s16x4 lo[4],hi[4];
    #pragma unroll
    for(int ks=0;ks<4;++ks){
      asm volatile("ds_read_b64_tr_b16 %0,%1 offset:%c2":"=&v"(lo[ks]):"v"(vb),"i"(d0*4096+ks*1024):"memory");
      asm volatile("ds_read_b64_tr_b16 %0,%1 offset:%c2":"=&v"(hi[ks]):"v"(vb),"i"(d0*4096+ks*1024+512):"memory");}
    asm volatile("s_waitcnt lgkmcnt(0)":::"memory");SBAR();
    #define PK(k) (bf16x8){lo[k][0],lo[k][1],lo[k][2],lo[k][3],hi[k][0],hi[k][1],hi[k][2],hi[k][3]}
    o[d0]=__builtin_amdgcn_mfma_f32_32x32x16_bf16(pa0,PK(0),o[d0],0,0,0);
    o[d0]=__builtin_amdgcn_mfma_f32_32x32x16_bf16(pa1,PK(1),o[d0],0,0,0);
    o[d0]=__builtin_amdgcn_mfma_f32_32x32x16_bf16(pa2,PK(2),o[d0],0,0,0);
    o[d0]=__builtin_amdgcn_mfma_f32_32x32x16_bf16(pa3,PK(3),o[d0],0,0,0);
    #undef PK
  }
}

#ifndef ATTN_STORE16
#define ATTN_STORE16(p,v) (*(u32x4*)(p)=(v))
#endif
template<int THRL> __device__ __forceinline__ void attn_unit(int b,int h,int qb,const bf16*Q,const bf16*__restrict__ K,const bf16*__restrict__ V,bf16*O,const float*__restrict__ cng,char*shm,const int tid_in){
  const int tid=tid_in,lane=tid&63,r32=lane&31,hi=lane>>5; const int wid=__builtin_amdgcn_readfirstlane(tid>>6);
  const long rowbase=(long)b*SEQ; const int q0=qb*QB;
  typedef __attribute__((address_space(3))) float lds_f32; typedef __attribute__((address_space(3))) const f32x4_t lds_cf4;
  { lds_f32* cl=(lds_f32*)((__attribute__((address_space(3))) char*)shm+LDS_CN); const int ncn=q0+QB;
    for(int i=tid*4;i<ncn;i+=NW*64*4){ const f32x4_t v=*reinterpret_cast<const f32x4_t*>(cng+i); *(__attribute__((address_space(3))) f32x4_t*)(cl+i)=v; } }
  const __attribute__((address_space(3))) char* cnr=(const __attribute__((address_space(3))) char*)shm+LDS_CN+r32*4;
  #define BFRAG(F,x_) do{ const unsigned xb_=__float_as_uint(x_), xh_=xb_&0xffff0000u; const float r1_=(x_)-__uint_as_float(xh_); const unsigned mb_=__float_as_uint(r1_)&0xffff0000u; \
      const float r2_=r1_-__uint_as_float(mb_); u32x4 w_; w_.x=hi?0u:((xh_>>16)|mb_); w_.y=hi?0u:((__float_as_uint(r2_)>>16)|0x3f800000u); w_.z=hi?0u:0x3f803f80u; w_.w=0u; F=__builtin_bit_cast(bf16x8,w_); }while(0)
  #define BFR(t) do{ const float c0_=*(const __attribute__((address_space(3))) float*)(cnr+(t)*256), c1_=*(const __attribute__((address_space(3))) float*)(cnr+(t)*256+128); BFRAG(bfa,c0_); BFRAG(bfb,c1_); }while(0)
  #define MFRAG_SET() do{ const float x_=-mhat; const unsigned xb_=__float_as_uint(x_), xh_=xb_&0xffff0000u; const float r1_=x_-__uint_as_float(xh_); const unsigned mb_=__float_as_uint(r1_)&0xffff0000u; \
      const float r2_=r1_-__uint_as_float(mb_); u32x4 w_; w_.x=0x3f803f80u; w_.y=0x3f80u|xh_; w_.z=(mb_>>16)|(__float_as_uint(r2_)&0xffff0000u); w_.w=0u; mfrag=__builtin_bit_cast(bf16x8,w_); asm volatile("":"+v"(mfrag)); }while(0)
  const bf16*Qw=Q+(rowbase+q0+wid*QBLK)*DM+h*D;
  const bf16*Kh=K+rowbase*DM+h*D,*Vh=V+rowbase*DM+h*D;
  const unsigned lds0=(unsigned)(uintptr_t)shm;
  float*wsf=(float*)(shm+LDS_WS)+wid*64;
  const bf16*ksrc=Kh+(long)lane*DM+wid*8;
  const bf16*vsrc=Vh+(long)(16*(wid&3)+(lane>>2))*DM+(wid>>2)*32+(lane&3)*8;
  const unsigned kdst=lds0+LDS_K+wid*1024, vdst=lds0+LDS_V+wid*1024;
  #define DMA_K(t,slot) glds16(ksrc+(long)(t)*KVBLK*DM,(unsigned)__builtin_amdgcn_readfirstlane(kdst+(slot)))
  #define DMA_V(t,slot) glds16(vsrc+(long)(t)*KVBLK*DM,(unsigned)__builtin_amdgcn_readfirstlane(vdst+(slot)))
  const int vb0=(int)(lds0+LDS_V)+((lane>>4)&1)*32+(lane&3)*8+(4*hi+((lane&15)>>2))*64;
  const char*Kbase=shm+LDS_K; bf16x8 kf[8];
  const lds_cptr shm3=(lds_cptr)shm; const lds_cptr kp0=shm3+LDS_K+hi*1024+r32*16; const lds_cptr vp0=shm3+LDS_V+((lane>>4)&1)*32+(lane&3)*8+(4*hi+((lane&15)>>2))*64;
  const int NT=(q0+QB)/KVBLK;
  DMA_K(0,0);DMA_V(0,0);DMA_K(1,SLOTB);
  bf16x8 qr[4];
  #pragma unroll
  for(int d0=0;d0<4;++d0)qr[d0]=*reinterpret_cast<const bf16x8*>(&Qw[(long)r32*DM+d0*16+hi*8]);
  const __attribute__((address_space(3))) char* qlp=(const __attribute__((address_space(3))) char*)shm+LDS_OST+wid*4096+lane*16;
  #pragma unroll
  for(int d0=0;d0<4;++d0)*(__attribute__((address_space(3))) bf16x8*)(qlp+d0*1024)=qr[d0];
  #define QLD() do{ _Pragma("unroll") for(int d_=0;d_<4;++d_)qr[d_]=*(const __attribute__((address_space(3))) bf16x8*)(qlp+d_*1024); }while(0)
  float mhat=0.f,l_reg=0.f;f32x16 o[2];o[0]=f32x16{};o[1]=f32x16{};bf16x8 mfrag,bfa,bfb; const f32x16 zero16=f32x16{}; MFRAG_SET();
  const int qrel=wid*QBLK+r32;
  #define CMASK(P0,P1,t) do{int jb_=(t)-(NT-4); if(jb_>=0)cmask(P0,P1,jb_,qrel,hi);}while(0)
  bool resc=false;
  #define START(P0,P1) do{ const float rm=rowmax(P0,P1); resc=false; \
    { const float dl=rm; mhat=fadd_s(mhat,dl); \
      _Pragma("unroll") for(int r=0;r<16;++r){P0[r]=fsub_s(P0[r],dl);P1[r]=fsub_s(P1[r],dl);} \
      MFRAG_SET(); } \
    _Pragma("unroll") for(int r=0;r<16;++r)P0[r]=__builtin_amdgcn_exp2f(P0[r]); }while(0)
  #define RESC() do{ if(resc){ asm volatile("s_waitcnt lgkmcnt(0)":::"memory"); \
      _Pragma("unroll") for(int d_=0;d_<2;++d_) _Pragma("unroll") for(int r=0;r<16;++r)o[d_][r]*=wsf[crow(r,hi)]; } }while(0)
  f32x16 pA0,pA1,pB0,pB1;
  int sl_prev=0,sl_cur=0,sl_next=SLOTB;
  #define ROT() do{sl_prev=sl_cur;sl_cur=sl_next;sl_next=(sl_next==(NSLOT-1)*SLOTB)?0:sl_next+SLOTB;}while(0)
  DMA_K(2,2*SLOTB);
  WAIT_BAR(3);
  BFR(0); pA0=__builtin_amdgcn_mfma_f32_32x32x16_bf16(bfa,mfrag,zero16,0,0,0); pA1=__builtin_amdgcn_mfma_f32_32x32x16_bf16(bfb,mfrag,zero16,0,0,0);
  qkt(pA0,pA1,Kbase,qr,r32,hi);asm volatile("s_nop 15\n\ts_nop 7":"+v"(pA0),"+v"(pA1));CMASK(pA0,pA1,0);
  START(pA0,pA1);
  _Pragma("unroll") for(int r=0;r<16;++r)pA1[r]=__builtin_amdgcn_exp2f(pA1[r]);
  WAIT_BAR(0);
  DMA_K(3,0);DMA_V(1,SLOTB);
  ROT();
  kload8(kf,kp0+sl_cur);
  BFR(1);
  WAIT_BAR(2);
  s16x4 vlo[8],vhi[8]; u32x4 pw0,pw1,pw2,pw3;
  #define PKW(P,B) cvtpk_s(P[B],P[B+1])
  #define PAF(k) __builtin_bit_cast(bf16x8,pw##k)
  #define VFR(i) (bf16x8){vlo[i][0],vlo[i][1],vlo[i][2],vlo[i][3],vhi[i][0],vhi[i][1],vhi[i][2],vhi[i][3]}
  #define PIN(x) asm volatile("":"+v"(x))
  #define MX3(a,b,c) __builtin_fmaxf(__builtin_fmaxf((a),(b)),(c))
  #define GAPA(MF,A0,A1,A2,A3,W0,W1,PW) do{ MF; sacc+=A0; sacc+=A1; sacc+=A2; sacc+=A3; PIN(sacc); W0; W1; PIN(PW); SBAR(); }while(0)
  #define EX(v) __builtin_amdgcn_exp2f(v)
  #define GAPB(MF,X,B) do{ MF; X[B]=EX(X[B]); X[B+1]=EX(X[B+1]); X[B+2]=EX(X[B+2]); X[B+3]=EX(X[B+3]); PIN(X); SBAR(); }while(0)
  #define VRD(i) do{ vlo[i]=vtr(vp_+(((i)>>2)*4096+((i)&3)*1024)); vhi[i]=vtr(vp_+(((i)>>2)*4096+((i)&3)*1024+512)); }while(0)
  #define KRD(G,j) do{ if(G){ kload2(kf,kp0+sl_next,j); SBAR(); } }while(0)
  #define STEP(C0,C1,P0,P1,t,GK,GV,GL) do{ SBAR(); \
    const lds_cptr vp_=vp0+sl_prev; \
    VRD(0); SBAR(); float sacc=(P0[0]+P0[1]); \
    C0=__builtin_amdgcn_mfma_f32_32x32x16_bf16(bfa,mfrag,zero16,0,0,0); C1=__builtin_amdgcn_mfma_f32_32x32x16_bf16(bfb,mfrag,zero16,0,0,0); SBAR(); \
    GAPA(C0=__builtin_amdgcn_mfma_f32_32x32x16_bf16(kf[0],qr[0],C0,0,0,0), P0[2],P0[3],P0[4],P0[5],     pw0[0]=PKW(P0,0), pw0[1]=PKW(P0,2), pw0); \
    VRD(4); SBAR(); GAPA(C1=__builtin_amdgcn_mfma_f32_32x32x16_bf16(kf[1],qr[0],C1,0,0,0), P0[6],P0[7],P0[8],P0[9],     pw0[2]=PKW(P0,4), pw0[3]=PKW(P0,6), pw0); \
    VRD(1); SBAR(); GAPA(C0=__builtin_amdgcn_mfma_f32_32x32x16_bf16(kf[2],qr[1],C0,0,0,0),   P0[10],P0[11],P0[12],P0[13], pw1[0]=PKW(P0,8), pw1[1]=PKW(P0,10), pw1); \
    VRD(5); SBAR(); GAPA(C1=__builtin_amdgcn_mfma_f32_32x32x16_bf16(kf[3],qr[1],C1,0,0,0),   P0[14],P0[15],P1[0],P1[1],   pw1[2]=PKW(P0,12),pw1[3]=PKW(P0,14), pw1); \
    VRD(2); SBAR(); GAPA(C0=__builtin_amdgcn_mfma_f32_32x32x16_bf16(kf[4],qr[2],C0,0,0,0),   P1[2],P1[3],P1[4],P1[5],     pw2[0]=PKW(P1,0), pw2[1]=PKW(P1,2), pw2); \
    VRD(6); SBAR(); GAPA(C1=__builtin_amdgcn_mfma_f32_32x32x16_bf16(kf[5],qr[2],C1,0,0,0),   P1[6],P1[7],P1[8],P1[9],     pw2[2]=PKW(P1,4), pw2[3]=PKW(P1,6), pw2); \
    VRD(3); SBAR(); GAPA(C0=__builtin_amdgcn_mfma_f32_32x32x16_bf16(kf[6],qr[3],C0,0,0,0),   P1[10],P1[11],P1[12],P1[13], pw3[0]=PKW(P1,8), pw3[1]=PKW(P1,10), pw3); \
    VRD(7); SBAR(); GAPA(C1=__builtin_amdgcn_mfma_f32_32x32x16_bf16(kf[7],qr[3],C1,0,0,0),   P1[14],P1[15],0.f,0.f,       pw3[2]=PKW(P1,12),pw3[3]=PKW(P1,14), pw3); \
    l_reg+=sacc; \
    if(GK){DMA_K((t)+3,sl_cur);} if(GV){DMA_V((t)+1,sl_next);} \
    CMASK(C0,C1,t); \
    { float a=MX3(C0[0],C0[1],C1[0]),b=MX3(C0[2],C0[3],C1[1]); a=MX3(a,C1[2],C1[3]); \
      _Pragma("unroll") for(int r=4;r<16;r+=4){a=MX3(a,C0[r],C0[r+1]);b=MX3(b,C0[r+2],C0[r+3]);a=MX3(a,C1[r],C1[r+1]);b=MX3(b,C1[r+2],C1[r+3]);} \
      float rm=__builtin_fmaxf(a,b); { auto rr=__builtin_amdgcn_permlane32_swap(__float_as_uint(rm),__float_as_uint(rm),false,false); rm=__builtin_fmaxf(__uint_as_float(rr[0]),__uint_as_float(rr[1])); } \
      resc=false; \
      if(__builtin_expect(__any(rm>(float)THRL),0)){ const float dl=__builtin_fmaxf(rm,0.f); mhat+=dl; \
        _Pragma("unroll") for(int r=0;r<16;++r){C0[r]-=dl;C1[r]-=dl;} \
        MFRAG_SET(); \
        const float f=__builtin_amdgcn_exp2f(-dl); l_reg*=f; if(hi==0)wsf[r32]=f; resc=true; } } \
    SBAR(); \
    GAPB(o[0]=__builtin_amdgcn_mfma_f32_32x32x16_bf16(PAF(0),VFR(0),o[0],0,0,0), C0,0); \
    GAPB(o[1]=__builtin_amdgcn_mfma_f32_32x32x16_bf16(PAF(0),VFR(4),o[1],0,0,0), C0,4); \
    KRD(GL,0); GAPB(o[0]=__builtin_amdgcn_mfma_f32_32x32x16_bf16(PAF(1),VFR(1),o[0],0,0,0), C0,8); \
    KRD(GL,1); GAPB(o[1]=__builtin_amdgcn_mfma_f32_32x32x16_bf16(PAF(1),VFR(5),o[1],0,0,0), C0,12); \
    KRD(GL,2); GAPB(o[0]=__builtin_amdgcn_mfma_f32_32x32x16_bf16(PAF(2),VFR(2),o[0],0,0,0), C1,0); \
    KRD(GL,3); GAPB(o[1]=__builtin_amdgcn_mfma_f32_32x32x16_bf16(PAF(2),VFR(6),o[1],0,0,0), C1,4); \
    GAPB(o[0]=__builtin_amdgcn_mfma_f32_32x32x16_bf16(PAF(3),VFR(3),o[0],0,0,0), C1,8); \
    GAPB(o[1]=__builtin_amdgcn_mfma_f32_32x32x16_bf16(PAF(3),VFR(7),o[1],0,0,0), C1,12); \
    BFR((t)+1); \
    }while(0)
  int t=1;
  #undef CMASK
  #define CMASK(P0,P1,t) do{}while(0)
  for(;t+5<NT;t+=2){
    STEP(pB0,pB1,pA0,pA1,t,true,true,true);     WAIT_BAR(2); RESC(); ROT();
    STEP(pA0,pA1,pB0,pB1,t+1,true,true,true);   WAIT_BAR(2); RESC(); ROT();
  }
  #undef CMASK
  #define CMASK(P0,P1,t) do{int jb_=(t)-(NT-4); if(jb_>=0)cmask(P0,P1,jb_,qrel,hi);}while(0)
  #define ENDW(tt) do{ if((tt)+3<NT){WAIT_BAR(2);} else if((tt)+2<NT){WAIT_BAR(1);} else {WAIT_BAR(0);} }while(0)
  for(;t+1<NT;t+=2){
    STEP(pB0,pB1,pA0,pA1,t,(t+3<NT),(t+1<NT),(t+1<NT));       ENDW(t);   RESC(); ROT();
    STEP(pA0,pA1,pB0,pB1,t+1,(t+4<NT),(t+2<NT),(t+2<NT));     ENDW(t+1); RESC(); ROT();
  }
  STEP(pB0,pB1,pA0,pA1,NT-1,false,false,false); RESC();
  { float sacc=pB0[0]+pB0[1]; _Pragma("unroll") for(int r=2;r<16;++r)sacc+=pB0[r]; _Pragma("unroll") for(int r=0;r<16;++r)sacc+=pB1[r]; l_reg+=sacc;
    pw0=(u32x4){PKW(pB0,0),PKW(pB0,2),PKW(pB0,4),PKW(pB0,6)};pw1=(u32x4){PKW(pB0,8),PKW(pB0,10),PKW(pB0,12),PKW(pB0,14)};pw2=(u32x4){PKW(pB1,0),PKW(pB1,2),PKW(pB1,4),PKW(pB1,6)};pw3=(u32x4){PKW(pB1,8),PKW(pB1,10),PKW(pB1,12),PKW(pB1,14)};
    SBAR(); pv(o,vb0+sl_cur,PAF(0),PAF(1),PAF(2),PAF(3)); }
  #undef PKW
  #undef PAF
  #undef VFR
  #undef PIN
  #undef MX3
  #undef GAPA
  #undef GAPB
  #undef EX
  #undef VRD
  #undef KRD
  #undef STEP
  #undef ENDW
  {auto rr=__builtin_amdgcn_permlane32_swap(__float_as_uint(l_reg),__float_as_uint(l_reg),false,false);l_reg=__uint_as_float(rr[0])+__uint_as_float(rr[1]);}
  if(hi==0)wsf[32+r32]=l_reg;asm volatile("s_waitcnt lgkmcnt(0)":::"memory");
  float rli[16];
  #pragma unroll
  for(int r=0;r<16;++r)rli[r]=__builtin_amdgcn_rcpf(wsf[32+crow(r,hi)]);
  bf16*Ow=O+(rowbase+q0+wid*QBLK)*DMO+h*D;
  { bf16*stg=(bf16*)(shm+LDS_OST)+wid*2048;
    #pragma unroll
    for(int r=0;r<16;++r){const int orow=crow(r,hi);
      #pragma unroll
      for(int d0=0;d0<2;++d0)stg[orow*64+d0*32+r32]=__float2bfloat16(o[d0][r]*rli[r]);}
    asm volatile("s_waitcnt lgkmcnt(0)":::"memory");
    #pragma unroll
    for(int i=0;i<4;++i){const int row=i*8+(lane>>3),ch=lane&7; const u32x4 v=*(const u32x4*)(stg+row*64+ch*8); ATTN_STORE16(Ow+(long)row*DMO+ch*8,v);} }
  asm volatile("s_waitcnt lgkmcnt(0)\n\ts_barrier":::"memory");
  #undef BFRAG
  #undef BFR
  #undef MFRAG_SET
  #undef QLD
  #undef DMA_K
  #undef DMA_V
  #undef CMASK
  #undef START
  #undef RESC
  #undef ROT
}
constexpr int ATTN_LDS_BYTES=LDS_BYTES;
#undef SBAR
#undef WAIT_BAR
}
#define LAS __attribute__((address_space(3)))
typedef unsigned short bf16;
typedef unsigned v4u __attribute__((ext_vector_type(4)));
typedef unsigned v2u __attribute__((ext_vector_type(2)));
typedef float f32x4 __attribute__((ext_vector_type(4)));
typedef short bf16x8 __attribute__((ext_vector_type(8)));
typedef float f32x16 __attribute__((ext_vector_type(16)));
typedef LAS unsigned char* ldsp;
constexpr int NWAVES = 8;
constexpr int BATCH = 8, SEQ = 8192, D = 1024, M = BATCH * SEQ, NMEM = 256, MM = BATCH * NMEM, FF = 4096;
constexpr int ZW = 3584, NIN = 3840;
constexpr int ZC_MLQ = 0, ZC_MLK = 512, ZC_MLV = 1024, ZC_MLO = 1536, ZC_FXQ = 2048, ZC_FXK = 2560, ZC_FXV = 3072;
constexpr float LOG2E = 1.4426950408889634f;
constexpr float C2_FOX = 0.125f * LOG2E, C2_X = 0.0625f * LOG2E;
constexpr size_t MiB = 1u << 20;
constexpr size_t WS_CTL = 0, CTL_ZERO_BYTES = 131072;
constexpr size_t WS_WIN = 2 * MiB, WS_WOUT = 10 * MiB, WS_WXQ = 12 * MiB, WS_WXKV = 14 * MiB, WS_WXO = 18 * MiB, WS_W1 = 20 * MiB, WS_W2 = 28 * MiB;
constexpr size_t WS_MEMN = 36 * MiB, WS_KX = 40 * MiB, WS_VXT = 44 * MiB, WS_G = 48 * MiB, WS_CNEG = 52 * MiB, WS_SS1 = 54 * MiB, WS_SS2 = 58 * MiB, WS_SS3 = 62 * MiB;
constexpr size_t WS_XN = 72 * MiB, WS_MIX = 200 * MiB, WS_Z = 328 * MiB, WS_U = 328 * MiB, WS_VTG = 776 * MiB, WS_END = 840 * MiB;
constexpr int RING_BYTES = 131072, MISC_OFF = RING_BYTES, LDS_BYTES = 147456;

__device__ __forceinline__ unsigned f2bf(float f) { unsigned u = __builtin_bit_cast(unsigned, f); return (u + 0x7fffu + ((u >> 16) & 1u)) >> 16; }
__device__ __forceinline__ unsigned pk2(float lo, float hi) { return pg8::cvt_pk_bf16(lo, hi); }
__device__ __forceinline__ float bf_lo(unsigned w) { return __uint_as_float(w << 16); }
__device__ __forceinline__ float bf_hi(unsigned w) { return __uint_as_float(w & 0xffff0000u); }
__device__ __forceinline__ float wave_sum(float v) {
#pragma unroll
    for (int o = 1; o < 64; o <<= 1) v += __shfl_xor(v, o);
    return v;
}
__device__ __forceinline__ float logsig(float x) { const float e = __builtin_amdgcn_exp2f(-fabsf(x) * LOG2E); return fminf(x, 0.f) - __builtin_amdgcn_logf(1.0f + e) * 0.6931471805599453f; }
#define LDS_WAIT() asm volatile("s_waitcnt lgkmcnt(0)" ::: "memory")
#define LBAR() asm volatile("s_waitcnt lgkmcnt(0)\n\ts_barrier" ::: "memory")

template <class F> __device__ __forceinline__ void p0_transpose_item(const float* W, int K, int N, int ND, bf16* WT, LAS float* scr, int item, int lane, F srcmap) {
    const int nblk = ND / 32, kb = item / nblk, nb = item % nblk, k0 = 64 * kb, n0 = 32 * nb;
    const int sc = srcmap(n0 + (lane & 31));
#pragma unroll 8
    for (int i = 0; i < 32; ++i) { const int kk = 2 * i + (lane >> 5); scr[kk * 33 + (lane & 31)] = sc >= 0 ? W[(size_t)(k0 + kk) * N + sc] : 0.f; }
    LDS_WAIT(); asm volatile("" ::: "memory");
    const int c = lane & 7;
#pragma unroll
    for (int j = 0; j < 4; ++j) { const int n = (lane >> 3) + 8 * j; const LAS float* s = scr + (8 * c) * 33 + n;
        v4u o; o.x = pk2(s[0 * 33], s[1 * 33]); o.y = pk2(s[2 * 33], s[3 * 33]); o.z = pk2(s[4 * 33], s[5 * 33]); o.w = pk2(s[6 * 33], s[7 * 33]);
        *(v4u*)(WT + (size_t)(n0 + n) * K + k0 + 8 * c) = o; }
    LDS_WAIT(); asm volatile("" ::: "memory");
}
__device__ __forceinline__ void rms_row_to_bf16(const float* xrow, const float* gain, bf16* orow, int lane) {
    const f32x4* xr = (const f32x4*)xrow + lane; const f32x4* gr = (const f32x4*)gain + lane;
    f32x4 v[4]; float s = 0.f;
#pragma unroll
    for (int j = 0; j < 4; ++j) { v[j] = xr[64 * j]; s += (v[j].x * v[j].x + v[j].y * v[j].y) + (v[j].z * v[j].z + v[j].w * v[j].w); }
    const float r = 1.0f / sqrtf(wave_sum(s) * (1.f / 1024.f) + 1e-6f);
    unsigned long long* o8 = (unsigned long long*)orow + lane;
#pragma unroll
    for (int j = 0; j < 4; ++j) { const f32x4 g = gr[64 * j]; o8[64 * j] = (unsigned long long)pk2(v[j].x * r * g.x, v[j].y * r * g.y) | ((unsigned long long)pk2(v[j].z * r * g.z, v[j].w * r * g.w) << 32); }
}
template <int NR> __device__ __forceinline__ void rms_rows_to_bf16(const float* x0, size_t row_stride, const float* gain, bf16* o0, int lane) {
    f32x4 v[NR][4]; float s[NR];
#pragma unroll
    for (int r = 0; r < NR; ++r) { const f32x4* xr = (const f32x4*)(x0 + r * row_stride) + lane;
#pragma unroll
        for (int j = 0; j < 4; ++j) v[r][j] = xr[64 * j]; }
    f32x4 g[4];
#pragma unroll
    for (int j = 0; j < 4; ++j) g[j] = ((const f32x4*)gain)[lane + 64 * j];
#pragma unroll
    for (int r = 0; r < NR; ++r) { s[r] = 0.f;
#pragma unroll
        for (int j = 0; j < 4; ++j) s[r] += (v[r][j].x * v[r][j].x + v[r][j].y * v[r][j].y) + (v[r][j].z * v[r][j].z + v[r][j].w * v[r][j].w); }
#pragma unroll
    for (int o = 1; o < 64; o <<= 1) {
#pragma unroll
        for (int r = 0; r < NR; ++r) s[r] += __shfl_xor(s[r], o); }
#pragma unroll
    for (int r = 0; r < NR; ++r) { const float rs = 1.0f / sqrtf(s[r] * (1.f / 1024.f) + 1e-6f); unsigned long long* o8 = (unsigned long long*)(o0 + r * row_stride) + lane;
#pragma unroll
        for (int j = 0; j < 4; ++j) o8[64 * j] = (unsigned long long)pk2(v[r][j].x * rs * g[j].x, v[r][j].y * rs * g[j].y) | ((unsigned long long)pk2(v[r][j].z * rs * g[j].z, v[r][j].w * rs * g[j].w) << 32); }
}
namespace ml {
constexpr int QS = 0, KS = QS + 64 * 272, KWT = KS + 64 * 272, VT = KWT + 128 * 144, PS = VT + 128 * 144, RSP = PS + 64 * 144, CWL = RSP + 512, PRE_END = CWL + 5120;
constexpr int SB_Q = 0, SB_KW = 64 * 272, SB_VT = SB_KW + 128 * 144, SB_BYTES = SB_VT + 128 * 144, NQ = 2 * SB_BYTES, NV = NQ + 256, SSQ = NV + 512, ST_END = SSQ + 2048;
static_assert(PRE_END <= RING_BYTES && ST_END <= RING_BYTES, "mlstm LDS");
__device__ __forceinline__ float scan_add(float v, int lane) {
#pragma unroll
    for (int o = 1; o < 64; o <<= 1) { const float t = __shfl_up(v, o); if (lane >= o) v += t; }
    return v;
}
__device__ __forceinline__ float scan_max(float v, int lane) {
#pragma unroll
    for (int o = 1; o < 64; o <<= 1) { const float t = __shfl_up(v, o); if (lane >= o) v = fmaxf(v, t); }
    return v;
}
#define MFMA16(a, b, c) __builtin_amdgcn_mfma_f32_16x16x32_bf16(a, b, c, 0, 0, 0)
struct PreOut { bf16* QF; bf16* KWTg; bf16* VTg; float* HI; float* SC; float* SC2; };
struct PreRegs { v4u rq[7]; v4u rv[2]; float g_i, g_f; };
__device__ __forceinline__ void pre_load(int u, const bf16* __restrict__ Z, const float* __restrict__ G, PreRegs& R, const int tid) {
    const int lane = tid & 63, bh = u >> 7, c = u & 127, b = bh >> 2, h = bh & 3;
    const int g8 = tid & 15, isK = tid >> 8, tb = (tid >> 4) & 15, sb = tid >> 4;
    const int ch0 = (isK ? 512 : 0) + h * 128 + 8 * g8;
    const size_t rb = (size_t)b * SEQ + (size_t)c * 64;
    const bf16* zq = Z + rb * ZW + ch0; const bf16* zv = Z + rb * ZW + ZC_MLV + h * 128 + 8 * g8; const float* gp = G + rb * 16 + h;
#pragma unroll
    for (int i = 0; i < 7; ++i) { const int t = 4 * tb - 3 + i; R.rq[i] = (c == 0 && t < 0) ? (v4u){0u, 0u, 0u, 0u} : *(const v4u*)(zq + t * ZW); }
#pragma unroll
    for (int j = 0; j < 2; ++j) R.rv[j] = *(const v4u*)(zv + (2 * sb + j) * ZW);
    R.g_i = gp[lane * 16]; R.g_f = gp[lane * 16 + 4];
}
__device__ __forceinline__ void pre_unit(int u, const bf16* __restrict__ Z, const float* __restrict__ G, const PreOut& O,
        const float* __restrict__ conv_w, const float* __restrict__ conv_b, const float* __restrict__ b_i, const float* __restrict__ b_f, ldsp L, const int tid_in, int& cw_head, PreRegs& R, const int u_next) {
    const int tid = tid_in, lane = tid & 63, w = __builtin_amdgcn_readfirstlane(tid >> 6), fr = lane & 15, fq = lane >> 4;
    const int bh = u >> 7, c = u & 127, b = bh >> 2, h = bh & 3;
    const int g8 = tid & 15, isK = tid >> 8, tb = (tid >> 4) & 15, sb = tid >> 4;
    const int ch0 = (isK ? 512 : 0) + h * 128 + 8 * g8;
    const size_t rb = (size_t)b * SEQ + (size_t)c * 64;
    if (cw_head != h) {
        for (int idx = tid; idx < 1280; idx += 512) { const int which = idx / 640, j = (idx % 640) >> 7, ch = idx & 127;
            *(LAS float*)(L + CWL + idx * 4) = j < 4 ? conv_w[j * 1024 + which * 512 + h * 128 + ch] : conv_b[which * 512 + h * 128 + ch]; }
        cw_head = h;
        __syncthreads();
    }
    const int cwo = CWL + (isK * 640 + 8 * g8) * 4;
    const float lf = logsig(R.g_f + b_f[h]), ig = R.g_i + b_i[h];
    const float bc = scan_add(lf, lane), uu = ig - bc, pm = scan_max(uu, lane);
    const float umax = __shfl(pm, 63), gl = __shfl(bc, 63);
    const float wl = __expf(uu - umax);
    {
        float y[4][8];
        { const f32x4 c0 = *(const LAS f32x4*)(L + cwo + 4 * 512), c1 = *(const LAS f32x4*)(L + cwo + 4 * 512 + 16);
#pragma unroll
          for (int tt = 0; tt < 4; ++tt) { y[tt][0] = c0[0]; y[tt][1] = c0[1]; y[tt][2] = c0[2]; y[tt][3] = c0[3]; y[tt][4] = c1[0]; y[tt][5] = c1[1]; y[tt][6] = c1[2]; y[tt][7] = c1[3]; } }
#pragma unroll
        for (int j = 0; j < 4; ++j) {
            const f32x4 c0 = *(const LAS f32x4*)(L + cwo + j * 512), c1 = *(const LAS f32x4*)(L + cwo + j * 512 + 16);
            const float cwj[8] = {c0[0], c0[1], c0[2], c0[3], c1[0], c1[1], c1[2], c1[3]};
#pragma unroll
            for (int tt = 0; tt < 4; ++tt) { const int r = tt + j;
                const float x[8] = {bf_lo(R.rq[r].x), bf_hi(R.rq[r].x), bf_lo(R.rq[r].y), bf_hi(R.rq[r].y), bf_lo(R.rq[r].z), bf_hi(R.rq[r].z), bf_lo(R.rq[r].w), bf_hi(R.rq[r].w)};
#pragma unroll
                for (int i = 0; i < 8; ++i) y[tt][i] += cwj[i] * x[i]; }
        }
        const float ksc = isK ? 0.08838834764831845f : 1.0f;
#pragma unroll
        for (int tt = 0; tt < 4; ++tt)
#pragma unroll
            for (int i = 0; i < 8; ++i) { const float a = y[tt][i]; y[tt][i] = a * __builtin_amdgcn_rcpf(1.0f + __expf(-a)) * ksc; }
        const int base = isK ? KS : QS;
#pragma unroll
        for (int tt = 0; tt < 4; ++tt) { v4u o; o.x = pk2(y[tt][0], y[tt][1]); o.y = pk2(y[tt][2], y[tt][3]); o.z = pk2(y[tt][4], y[tt][5]); o.w = pk2(y[tt][6], y[tt][7]);
            *(LAS v4u*)(L + base + (4 * tb + tt) * 272 + 16 * g8) = o;
            if (!isK) *(v4u*)(O.QF + ((size_t)u * 64 + 4 * tb + tt) * 128 + 8 * g8) = o; }
        if (isK) {
            float was[4];
#pragma unroll
            for (int tt = 0; tt < 4; ++tt) was[tt] = __shfl(wl, 4 * tb + tt);
#pragma unroll
            for (int i = 0; i < 8; ++i) { v2u o; o.x = pk2(y[0][i] * was[0], y[1][i] * was[1]); o.y = pk2(y[2][i] * was[2], y[3][i] * was[3]);
                *(LAS v2u*)(L + KWT + (8 * g8 + i) * 144 + 8 * tb) = o; }
        }
        {
            const unsigned a0[4] = {R.rv[0].x, R.rv[0].y, R.rv[0].z, R.rv[0].w}, a1[4] = {R.rv[1].x, R.rv[1].y, R.rv[1].z, R.rv[1].w};
#pragma unroll
            for (int i = 0; i < 4; ++i) {
                const unsigned lo = (a0[i] & 0xffffu) | (a1[i] << 16), hi = (a0[i] >> 16) | (a1[i] & 0xffff0000u);
                *(LAS unsigned*)(L + VT + (8 * g8 + 2 * i) * 144 + 4 * sb) = lo;
                *(LAS unsigned*)(L + VT + (8 * g8 + 2 * i + 1) * 144 + 4 * sb) = hi; }
        }
    }
    if (u_next >= 0) pre_load(u_next, Z, G, R, tid);
    LBAR();
    {
        const int tt = w >> 1, half = w & 1, t = 16 * tt + fr; const float Pt = __shfl(pm, t); float rs = 0.f;
#pragma unroll
        for (int j = 0; j < 2; ++j) { const int st = 2 * half + j; f32x4 a = (f32x4){0.f, 0.f, 0.f, 0.f};
            if (st <= tt) {
#pragma unroll
                for (int ks = 0; ks < 4; ++ks) { const bf16x8 kf = *(const LAS bf16x8*)(L + KS + (16 * st + fr) * 272 + (32 * ks + 8 * fq) * 2); const bf16x8 qf = *(const LAS bf16x8*)(L + QS + t * 272 + (32 * ks + 8 * fq) * 2); a = MFMA16(kf, qf, a); }
            }
            float p[4];
#pragma unroll
            for (int i = 0; i < 4; ++i) { const int s = 16 * st + 4 * fq + i; const float us = __shfl(uu, s); p[i] = (s <= t) ? a[i] * __expf(us - Pt) : 0.f; rs += p[i]; }
            v2u o; o.x = pk2(p[0], p[1]); o.y = pk2(p[2], p[3]);
            *(LAS v2u*)(L + PS + t * 144 + (16 * st + 4 * fq) * 2) = o; }
        rs += __shfl_xor(rs, 16); rs += __shfl_xor(rs, 32);
        if (fq == 0) *(LAS float*)(L + RSP + (t * 2 + half) * 4) = rs;
    }
#pragma unroll
    for (int i = 0; i < 2; ++i) { const int it = tid + 512 * i, row = it >> 3, chk = it & 7;
        *(v4u*)(O.KWTg + ((size_t)u * 128 + row) * 64 + 8 * chk) = *(const LAS v4u*)(L + KWT + row * 144 + 16 * chk);
        *(v4u*)(O.VTg + ((size_t)u * 128 + row) * 64 + 8 * chk) = *(const LAS v4u*)(L + VT + row * 144 + 16 * chk); }
    LBAR();
    {
        bf16x8 vf[2];
#pragma unroll
        for (int ks = 0; ks < 2; ++ks) vf[ks] = *(const LAS bf16x8*)(L + VT + (16 * w + fr) * 144 + (32 * ks + 8 * fq) * 2);
#pragma unroll
        for (int t4 = 0; t4 < 4; ++t4) { const int t = 16 * t4 + fr; f32x4 a = (f32x4){0.f, 0.f, 0.f, 0.f};
#pragma unroll
            for (int ks = 0; ks < 2; ++ks) { const bf16x8 pf = *(const LAS bf16x8*)(L + PS + t * 144 + (32 * ks + 8 * fq) * 2); a = MFMA16(vf[ks], pf, a); }
            *(f32x4*)(O.HI + ((size_t)u * 64 + t) * 128 + 16 * w + 4 * fq) = a; }
        if (w == 0) { const float rsum = *(const LAS float*)(L + RSP + lane * 8) + *(const LAS float*)(L + RSP + lane * 8 + 4);
            *(f32x4*)(O.SC + ((size_t)u * 64 + lane) * 4) = (f32x4){bc, pm, rsum, 0.f};
            if (lane == 0) { O.SC2[(size_t)u * 2] = umax; O.SC2[(size_t)u * 2 + 1] = gl; } }
    }
    LBAR();
}
__device__ __forceinline__ void stream(int b, int h, const bf16* __restrict__ Z, const PreOut& O, bf16* __restrict__ MIX, const float* __restrict__ ml_norm, ldsp L, const int tid_in, const int c_begin, const int c_end) {
    const int tid = tid_in, lane = tid & 63, w = __builtin_amdgcn_readfirstlane(tid >> 6), fr = lane & 15, fq = lane >> 4;
    const int bh = b * 4 + h;
    const f32x4 mln = *(const f32x4*)(ml_norm + h * 128 + 16 * w + 4 * fq);
    f32x4 accC[8];
#pragma unroll
    for (int i = 0; i < 8; ++i) accC[i] = (f32x4){0.f, 0.f, 0.f, 0.f};
    if (tid < 128) *(LAS float*)(L + NV + tid * 4) = 0.f;
    float mcar = 0.f;
    const size_t row0 = (size_t)b * SEQ;
    v4u st[6]; f32x4 hi[4]; v2u ro[4]; f32x4 sc4 = (f32x4){0.f, 0.f, 0.f, 0.f}; float umax, gch;
#pragma unroll
    for (int i = 0; i < 6; ++i) st[i] = (v4u){0u, 0u, 0u, 0u};
#pragma unroll
    for (int i = 0; i < 4; ++i) { hi[i] = (f32x4){0.f, 0.f, 0.f, 0.f}; ro[i] = (v2u){0u, 0u}; }
#define ML_LOAD(cc) do { const size_t u_ = (size_t)bh * 128 + (cc); \
        const bf16* pk_ = O.KWTg + u_ * 8192; const bf16* pv_ = O.VTg + u_ * 8192; \
        _Pragma("unroll") for (int i_ = 0; i_ < 2; ++i_) { const int it_ = tid + 512 * i_; st[2 + i_] = *(const v4u*)(pk_ + it_ * 8); st[4 + i_] = *(const v4u*)(pv_ + it_ * 8); } \
        umax = O.SC2[u_ * 2]; gch = O.SC2[u_ * 2 + 1]; \
        if ((cc) >= c_begin) { const bf16* pq_ = O.QF + u_ * 8192; const float* ph_ = O.HI + u_ * 8192; const bf16* po_ = Z + (row0 + (size_t)(cc) * 64) * ZW + ZC_MLO + h * 128; const float* ps_ = O.SC + u_ * 256; \
        _Pragma("unroll") for (int i_ = 0; i_ < 2; ++i_) { const int it_ = tid + 512 * i_; st[i_] = *(const v4u*)(pq_ + it_ * 8); } \
        _Pragma("unroll") for (int t4_ = 0; t4_ < 4; ++t4_) { hi[t4_] = *(const f32x4*)(ph_ + (16 * t4_ + fr) * 128 + 16 * w + 4 * fq); \
            ro[t4_] = *(const v2u*)(po_ + (16 * t4_ + fr) * ZW + 16 * w + 4 * fq); } \
        sc4 = *(const f32x4*)(ps_ + lane * 4); } } while (0)
    ML_LOAD(0);
    for (int c = 0; c < c_end; ++c) {
        const bool full = c >= c_begin;
        const int sbo = (c & 1) * SB_BYTES;
#pragma unroll
        for (int i = 0; i < 2; ++i) { const int it = tid + 512 * i;
            *(LAS v4u*)(L + sbo + SB_Q + (it >> 4) * 272 + (it & 15) * 16) = st[i];
            *(LAS v4u*)(L + sbo + SB_KW + (it >> 3) * 144 + (it & 7) * 16) = st[2 + i];
            *(LAS v4u*)(L + sbo + SB_VT + (it >> 3) * 144 + (it & 7) * 16) = st[4 + i]; }
        const float bc = sc4[0], pm = sc4[1], rsl = sc4[2];
        const float Mv = fmaxf(mcar, pm), Ml = fmaxf(mcar, umax);
        const float r1 = __expf(pm - Mv), inter = __expf(mcar - Mv), flo = __expf(-(bc + Mv));
        const float scl = __expf(umax - Ml), decay = __expf(mcar - Ml);
        mcar = gch + Ml;
        f32x4 acch[4]; v2u og[4];
#pragma unroll
        for (int t4 = 0; t4 < 4; ++t4) { acch[t4] = hi[t4]; og[t4] = ro[t4]; }
        if (c + 1 < c_end) ML_LOAD(c + 1);
        LBAR();
        if (full) {
            bf16x8 cx[4];
#pragma unroll
            for (int ks = 0; ks < 4; ++ks) { v4u o; o.x = pk2(accC[2 * ks][0], accC[2 * ks][1]); o.y = pk2(accC[2 * ks][2], accC[2 * ks][3]); o.z = pk2(accC[2 * ks + 1][0], accC[2 * ks + 1][1]); o.w = pk2(accC[2 * ks + 1][2], accC[2 * ks + 1][3]);
                cx[ks] = __builtin_bit_cast(bf16x8, o); }
#pragma unroll
            for (int t4 = 0; t4 < 4; ++t4) { const int t = 16 * t4 + fr; const float it = __shfl(inter, t), r1t = __shfl(r1, t);
                f32x4 a = (f32x4){0.f, 0.f, 0.f, 0.f};
#pragma unroll
                for (int ks = 0; ks < 4; ++ks) { const v2u qlo = *(const LAS v2u*)(L + sbo + SB_Q + t * 272 + (32 * ks + 4 * fq) * 2), qhi = *(const LAS v2u*)(L + sbo + SB_Q + t * 272 + (32 * ks + 16 + 4 * fq) * 2);
                    const v4u qq = {qlo.x, qlo.y, qhi.x, qhi.y}; a = MFMA16(cx[ks], __builtin_bit_cast(bf16x8, qq), a); }
                acch[t4] = acch[t4] * r1t + a * it;
                float sq = (acch[t4][0] * acch[t4][0] + acch[t4][1] * acch[t4][1]) + (acch[t4][2] * acch[t4][2] + acch[t4][3] * acch[t4][3]);
                sq += __shfl_xor(sq, 16); sq += __shfl_xor(sq, 32);
                if (fq == 0) *(LAS float*)(L + SSQ + (t * 8 + w) * 4) = sq; }
        }
        if (full) {
            const int ft = tid >> 3, part = tid & 7; float s = 0.f;
#pragma unroll
            for (int j = 0; j < 2; ++j) { const v4u qv = *(const LAS v4u*)(L + sbo + SB_Q + ft * 272 + (16 * part + 8 * j) * 2); const f32x4 n0 = *(const LAS f32x4*)(L + NV + (16 * part + 8 * j) * 4), n1 = *(const LAS f32x4*)(L + NV + (16 * part + 8 * j + 4) * 4);
                s += bf_lo(qv.x) * n0[0] + bf_hi(qv.x) * n0[1] + bf_lo(qv.y) * n0[2] + bf_hi(qv.y) * n0[3] + bf_lo(qv.z) * n1[0] + bf_hi(qv.z) * n1[1] + bf_lo(qv.w) * n1[2] + bf_hi(qv.w) * n1[3]; }
            s += __shfl_xor(s, 1); s += __shfl_xor(s, 2); s += __shfl_xor(s, 4);
            if (part == 0) *(LAS float*)(L + NQ + ft * 4) = s;
        }
        float nsum;
        {
            bf16x8 vf[2];
#pragma unroll
            for (int ks = 0; ks < 2; ++ks) vf[ks] = *(const LAS bf16x8*)(L + sbo + SB_VT + (16 * w + fr) * 144 + (32 * ks + 8 * fq) * 2);
#pragma unroll
            for (int dt = 0; dt < 8; ++dt) { f32x4 a = (f32x4){0.f, 0.f, 0.f, 0.f};
#pragma unroll
                for (int ks = 0; ks < 2; ++ks) { const bf16x8 kwf = *(const LAS bf16x8*)(L + sbo + SB_KW + (16 * dt + fr) * 144 + (32 * ks + 8 * fq) * 2); a = MFMA16(kwf, vf[ks], a); }
                accC[dt] = accC[dt] * decay + a * scl; }
            const int d = tid >> 2, part = tid & 3; float s = 0.f;
#pragma unroll
            for (int j = 0; j < 2; ++j) { const v4u kv = *(const LAS v4u*)(L + sbo + SB_KW + d * 144 + (16 * part + 8 * j) * 2);
                s += (bf_lo(kv.x) + bf_hi(kv.x)) + (bf_lo(kv.y) + bf_hi(kv.y)) + (bf_lo(kv.z) + bf_hi(kv.z)) + (bf_lo(kv.w) + bf_hi(kv.w)); }
            s += __shfl_xor(s, 1); s += __shfl_xor(s, 2);
            nsum = s;
        }
        LBAR();
        { const int d = tid >> 2, part = tid & 3; if (part == 0) { LAS float* np = (LAS float*)(L + NV + d * 4); *np = decay * *np + scl * nsum; } }
        if (full) {
#pragma unroll
        for (int t4 = 0; t4 < 4; ++t4) { const int t = 16 * t4 + fr;
            const float it = __shfl(inter, t), r1t = __shfl(r1, t), fl = __shfl(flo, t), rst = __shfl(rsl, t);
            const float den = r1t * rst + it * *(const LAS float*)(L + NQ + t * 4);
            const float dn = __builtin_amdgcn_rcpf(fmaxf(fabsf(den), fl));
            const f32x4 s0 = *(const LAS f32x4*)(L + SSQ + t * 32), s1 = *(const LAS f32x4*)(L + SSQ + t * 32 + 16);
            const float ss = (((s0[0] + s0[1]) + (s0[2] + s0[3])) + ((s1[0] + s1[1]) + (s1[2] + s1[3]))) * dn * dn;
            const float r = dn * __builtin_amdgcn_rsqf(ss * (1.0f / 128.0f) + 1e-6f);
            const float o0 = bf_lo(og[t4].x), o1 = bf_hi(og[t4].x), o2 = bf_lo(og[t4].y), o3 = bf_hi(og[t4].y);
            const float e0 = acch[t4][0] * r * mln[0] * __builtin_amdgcn_rcpf(1.0f + __expf(-o0)), e1 = acch[t4][1] * r * mln[1] * __builtin_amdgcn_rcpf(1.0f + __expf(-o1));
            const float e2 = acch[t4][2] * r * mln[2] * __builtin_amdgcn_rcpf(1.0f + __expf(-o2)), e3 = acch[t4][3] * r * mln[3] * __builtin_amdgcn_rcpf(1.0f + __expf(-o3));
            v2u o; o.x = pk2(e0, e1); o.y = pk2(e2, e3);
            *(v2u*)(MIX + (row0 + (size_t)c * 64 + t) * 1024 + h * 128 + 16 * w + 4 * fq) = o; }
        }
    }
#undef ML_LOAD
    __syncthreads();
}
}
namespace xa {
constexpr int BUFB = 36864;
#define MFMA32(a, b, c) __builtin_amdgcn_mfma_f32_32x32x16_bf16(a, b, c, 0, 0, 0)
__device__ __forceinline__ void xattn_unit(int pt, int hx, bf16* __restrict__ QO, const bf16* __restrict__ KX, const bf16* __restrict__ VXT, ldsp L, const int tid_in) {
    const int tid = tid_in, lane = tid & 63, w = __builtin_amdgcn_readfirstlane(tid >> 6), r32 = lane & 31, hi = lane >> 5;
    const int b = pt >> 5;
    bf16* qrow = QO + ((size_t)pt * 256 + w * 32 + r32) * 1024 + hx * 256;
    bf16x8 qf[16];
#pragma unroll
    for (int d0 = 0; d0 < 16; ++d0) qf[d0] = *(const bf16x8*)(qrow + 16 * d0 + 8 * hi);
    const bf16* kbase = KX + (size_t)b * 256 * 1024 + hx * 256;
    const bf16* vbase = VXT + (size_t)hx * 256 * 2048 + b * 256;
    v4u st[4];
#define XA_LOAD(j) do { if ((j) < 4) { _Pragma("unroll") for (int i_ = 0; i_ < 4; ++i_) { const int it_ = tid + 512 * i_, row_ = it_ >> 5, ch_ = it_ & 31; st[i_] = *(const v4u*)(kbase + (size_t)(64 * (j) + row_) * 1024 + 8 * ch_); } } \
        else { _Pragma("unroll") for (int i_ = 0; i_ < 2; ++i_) { const int it_ = tid + 512 * i_, row_ = it_ >> 3, ch_ = it_ & 7; st[i_] = *(const v4u*)(vbase + (size_t)(128 * (((j) - 4) >> 2) + row_) * 2048 + 64 * (((j) - 4) & 3) + 8 * ch_); } } } while (0)
#define XA_STORE(j) do { const int bo_ = ((j) & 1) * BUFB; if ((j) < 4) { _Pragma("unroll") for (int i_ = 0; i_ < 4; ++i_) { const int it_ = tid + 512 * i_, row_ = it_ >> 5, ch_ = it_ & 31; *(LAS v4u*)(L + bo_ + row_ * 528 + 16 * ch_) = st[i_]; } } \
        else { _Pragma("unroll") for (int i_ = 0; i_ < 2; ++i_) { const int it_ = tid + 512 * i_, row_ = it_ >> 3, ch_ = it_ & 7; *(LAS v4u*)(L + bo_ + row_ * 144 + 16 * ch_) = st[i_]; } } } while (0)
#define XA_QK(a0, a1, bo) do { a0 = (f32x16){}; a1 = (f32x16){}; __builtin_amdgcn_s_setprio(1); _Pragma("unroll") for (int d0 = 0; d0 < 16; ++d0) { \
        const bf16x8 k0_ = *(const LAS bf16x8*)(L + (bo) + r32 * 528 + (16 * d0 + 8 * hi) * 2), k1_ = *(const LAS bf16x8*)(L + (bo) + (32 + r32) * 528 + (16 * d0 + 8 * hi) * 2); \
        a0 = MFMA32(k0_, qf[d0], a0); a1 = MFMA32(k1_, qf[d0], a1); } __builtin_amdgcn_s_setprio(0); } while (0)
    XA_LOAD(0); XA_STORE(0);
    LBAR();
    float mt[4], lt[4];
    v4u pw[4][4];
#pragma unroll
    for (int j = 0; j < 4; ++j) {
        XA_LOAD(j + 1);
        f32x16 a0, a1; XA_QK(a0, a1, (j & 1) * BUFB);
        float mx = fmaxf(a0[0], a1[0]);
#pragma unroll
        for (int r = 1; r < 16; ++r) mx = fmaxf(mx, fmaxf(a0[r], a1[r]));
        mx = fmaxf(mx, __shfl_xor(mx, 32));
        float p[16], q[16], l = 0.f;
#pragma unroll
        for (int r = 0; r < 16; ++r) { p[r] = __builtin_amdgcn_exp2f(a0[r] - mx); q[r] = __builtin_amdgcn_exp2f(a1[r] - mx); l += p[r] + q[r]; }
        mt[j] = mx; lt[j] = l;
        pw[j][0] = (v4u){pk2(p[0], p[1]), pk2(p[2], p[3]), pk2(p[4], p[5]), pk2(p[6], p[7])};
        pw[j][1] = (v4u){pk2(p[8], p[9]), pk2(p[10], p[11]), pk2(p[12], p[13]), pk2(p[14], p[15])};
        pw[j][2] = (v4u){pk2(q[0], q[1]), pk2(q[2], q[3]), pk2(q[4], q[5]), pk2(q[6], q[7])};
        pw[j][3] = (v4u){pk2(q[8], q[9]), pk2(q[10], q[11]), pk2(q[12], q[13]), pk2(q[14], q[15])};
        XA_STORE(j + 1);
        LBAR();
    }
    const float mg = fmaxf(fmaxf(mt[0], mt[1]), fmaxf(mt[2], mt[3]));
    float l = 0.f;
#pragma unroll
    for (int j = 0; j < 4; ++j) { const float f = __builtin_amdgcn_exp2f(mt[j] - mg); l += f * lt[j];
#pragma unroll
        for (int k = 0; k < 4; ++k) { unsigned w4[4] = {pw[j][k].x, pw[j][k].y, pw[j][k].z, pw[j][k].w};
#pragma unroll
            for (int e = 0; e < 4; ++e) w4[e] = pk2(bf_lo(w4[e]) * f, bf_hi(w4[e]) * f);
            pw[j][k] = (v4u){w4[0], w4[1], w4[2], w4[3]}; } }
    l += __shfl_xor(l, 32);
    const float rl = 1.0f / l;
    bf16* obase = QO + ((size_t)pt * 256 + w * 32) * 1024 + hx * 256;
#pragma unroll
    for (int hd = 0; hd < 2; ++hd) {
        f32x16 o[4];
#pragma unroll
        for (int i = 0; i < 4; ++i) o[i] = (f32x16){};
#pragma unroll
        for (int vt = 0; vt < 4; ++vt) {
            const int j = 4 + 4 * hd + vt;
            if (j < 11) XA_LOAD(j + 1);
            const int bo = (j & 1) * BUFB;
            __builtin_amdgcn_s_setprio(1);
#pragma unroll
            for (int db = 0; db < 4; ++db)
#pragma unroll
                for (int j4 = 0; j4 < 4; ++j4) { const v2u lo = *(const LAS v2u*)(L + bo + (32 * db + r32) * 144 + (16 * j4 + 4 * hi) * 2), hh = *(const LAS v2u*)(L + bo + (32 * db + r32) * 144 + (16 * j4 + 8 + 4 * hi) * 2);
                    const v4u vv = {lo.x, lo.y, hh.x, hh.y}; o[db] = MFMA32(__builtin_bit_cast(bf16x8, pw[vt][j4]), __builtin_bit_cast(bf16x8, vv), o[db]); }
            __builtin_amdgcn_s_setprio(0);
            if (j < 11) { XA_STORE(j + 1); }
            LBAR();
        }
#pragma unroll
        for (int r = 0; r < 16; ++r) { const int q = (r & 3) + 8 * (r >> 2) + 4 * hi; const float rq = __shfl(rl, q);
#pragma unroll
            for (int db = 0; db < 4; ++db) obase[(size_t)q * 1024 + 128 * hd + 32 * db + r32] = (bf16)f2bf(o[db][r] * rq); }
    }
#undef XA_QK
#undef XA_LOAD
#undef XA_STORE
}
}
#define XB_TMO      128
#define XB_XCNT(j)  (256  + 64 * (j))
#define XB_XSUB(j)  (1280 + 64 * (j))
#define XB_XGEN(j)  (2304 + 64 * (j))
#define XB_TOP      3328
#define XB_TOPGEN   3392
#define XCD_BAR_WORDS 3456
#define XB_SPIN_CAP (1u << 18)

__device__ __forceinline__ unsigned xb_ld(unsigned* p)              { return __hip_atomic_load(p, __ATOMIC_RELAXED, __HIP_MEMORY_SCOPE_AGENT); }
__device__ __forceinline__ unsigned xb_add(unsigned* p, unsigned v) { return __hip_atomic_fetch_add(p, v, __ATOMIC_RELAXED, __HIP_MEMORY_SCOPE_AGENT); }
__device__ __forceinline__ unsigned xb_xcc_id() { return (unsigned)__builtin_amdgcn_s_getreg((3 << 11) | 20) & 0xFu; }
#define XB_SPIN(cond, bar) do { unsigned _sp = 0; while (cond) { __builtin_amdgcn_s_sleep(1); \
    if ((++_sp & 255u) == 0u) { if (xb_ld(&(bar)[XB_TMO])) break; if (_sp > XB_SPIN_CAP) { atomicAdd(&(bar)[XB_TMO], 1u); break; } } } } while (0)

struct XcdBarrier {
    unsigned* bar; unsigned x;
    volatile LAS unsigned* st;
};

__device__ __forceinline__ XcdBarrier xcd_barrier_post(unsigned* bar, volatile LAS unsigned* st) {
    XcdBarrier b; b.bar = bar; b.x = xb_xcc_id(); b.st = st;
    if (threadIdx.x == 0) (void)xb_add(&bar[XB_XCNT(b.x)], 1u);
    return b;
}
__device__ __forceinline__ void xcd_barrier_complete(unsigned* bar, unsigned x, unsigned& nloc, unsigned& nx) {
    const unsigned G = gridDim.x * gridDim.y * gridDim.z;
    unsigned sum, cnt, mine, sp = 0u;
    for (;;) {
        sum = 0u; cnt = 0u; mine = 0u;
#pragma unroll
        for (unsigned j = 0; j < 16; ++j) { const unsigned c = xb_ld(&bar[XB_XCNT(j)]); sum += c; cnt += (c > 0u) ? 1u : 0u; mine = (j == x) ? c : mine; }
        if (sum == G) break;
        __builtin_amdgcn_s_sleep(1);
        if ((++sp & 255u) == 0u) { if (xb_ld(&bar[XB_TMO])) break; if (sp > XB_SPIN_CAP) { atomicAdd(&bar[XB_TMO], 1u); break; } }
    }
    nloc = mine > 0u ? mine : 1u; nx = cnt > 0u ? cnt : 1u;
}

__device__ __forceinline__ void xcd_barrier(const XcdBarrier& b) {
    asm volatile("s_waitcnt vmcnt(0)" ::: "memory");
    __syncthreads();
    if (threadIdx.x == 0) {
        unsigned* bar = b.bar;
        __builtin_amdgcn_s_waitcnt(0);
        unsigned nloc = b.st[0], nx = b.st[1];
        if (nloc == 0u) { xcd_barrier_complete(bar, b.x, nloc, nx); b.st[0] = nloc; b.st[1] = nx; }
        const unsigned old = xb_add(&bar[XB_XSUB(b.x)], 1u);
        const unsigned gen = old / nloc;
        if (old + 1u == (gen + 1u) * nloc) {
            __builtin_amdgcn_fence(__ATOMIC_RELEASE, "agent");
            asm volatile("s_waitcnt vmcnt(0)" ::: "memory");
            const unsigned og = xb_add(&bar[XB_TOP], 1u);
            const unsigned tg = og / nx;
            if (og + 1u == (tg + 1u) * nx) xb_add(&bar[XB_TOPGEN], 1u);
            else XB_SPIN(xb_ld(&bar[XB_TOPGEN]) == tg, bar);
            __builtin_amdgcn_fence(__ATOMIC_ACQUIRE, "agent");
            xb_add(&bar[XB_XGEN(b.x)], 1u);
            asm volatile("s_waitcnt vmcnt(0)" ::: "memory");
        } else {
            XB_SPIN(xb_ld(&bar[XB_XGEN(b.x)]) == gen, bar);
            __builtin_amdgcn_fence(__ATOMIC_ACQUIRE, "agent");
            asm volatile("s_waitcnt vmcnt(0)" ::: "memory");
        }
    }
    __syncthreads();
}

struct Args { const float* in[20]; float* out; unsigned char* ws; int ph_lo, ph_hi, coop, pad; };
constexpr int N_PHASES = 10;
__global__ void __launch_bounds__(NWAVES * 64, 2) mk_fwd(Args args) {
    __builtin_assume(__builtin_amdgcn_workitem_id_y() == 0); __builtin_assume(__builtin_amdgcn_workitem_id_z() == 0);
    extern __shared__ __attribute__((aligned(16))) unsigned char lds[];
    const ldsp L = (ldsp)lds;
    volatile LAS unsigned* MISC = (volatile LAS unsigned*)(L + MISC_OFF);
    const int tid = threadIdx.x, lane = tid & 63, wave = __builtin_amdgcn_readfirstlane(tid >> 6);
    const int G = gridDim.x, bid = blockIdx.x;
#define x (args.in[0])
#define mem (args.in[1])
#define ln1 (args.in[2])
#define w_in (args.in[3])
#define conv_w (args.in[4])
#define conv_b (args.in[5])
#define ml_b_i (args.in[6])
#define ml_b_f (args.in[7])
#define ml_norm (args.in[8])
#define fx_b_f (args.in[9])
#define w_out (args.in[10])
#define ln_x (args.in[11])
#define ln_mem (args.in[12])
#define w_xq (args.in[13])
#define w_xkv (args.in[14])
#define w_xo (args.in[15])
#define ln2 (args.in[16])
#define w_ff1 (args.in[17])
#define w_ff2 (args.in[18])
#define ln_f (args.in[19])
    float* const out = args.out;
#define ctl ((unsigned*)(args.ws + WS_CTL))
#define Win_t ((bf16*)(args.ws + WS_WIN))
#define Wout_t ((bf16*)(args.ws + WS_WOUT))
#define Wxq_t ((bf16*)(args.ws + WS_WXQ))
#define Wxkv_t ((bf16*)(args.ws + WS_WXKV))
#define Wxo_t ((bf16*)(args.ws + WS_WXO))
#define W1_t ((bf16*)(args.ws + WS_W1))
#define W2_t ((bf16*)(args.ws + WS_W2))
#define MEMN ((bf16*)(args.ws + WS_MEMN))
#define KX ((bf16*)(args.ws + WS_KX))
#define VXT ((bf16*)(args.ws + WS_VXT))
#define GT ((float*)(args.ws + WS_G))
#define CNEG ((float*)(args.ws + WS_CNEG))
#define SS1 ((float*)(args.ws + WS_SS1))
#define SS2 ((float*)(args.ws + WS_SS2))
#define SS3 ((float*)(args.ws + WS_SS3))
#define XN ((bf16*)(args.ws + WS_XN))
#define MIX ((bf16*)(args.ws + WS_MIX))
#define Zb ((bf16*)(args.ws + WS_Z))
#define Ub ((bf16*)(args.ws + WS_U))
    const int lo = args.ph_lo, hi = args.ph_hi;
    if (tid < 16) MISC[tid] = 0u;
    __syncthreads();
    const XcdBarrier xbar = xcd_barrier_post((unsigned*)(ctl + 24576), MISC + 8);
#ifndef PH_MASK
#define PH_MASK 0x7ff
#endif
#define IN(k) ((((PH_MASK) >> (k)) & 1) && lo <= (k) && (k) < hi)
#ifndef DIL_MASK
#define DIL_MASK 0
#endif
#ifndef DIL_MUL
#define DIL_MUL 3
#endif
    unsigned long long tprev = (DIL_MASK) ? __builtin_amdgcn_s_memrealtime() : 0ull;
#define SEAM(k) do { if (IN(k) && IN((k) + 1)) { if (args.coop == 0x7fff0001) cg::this_grid().sync(); xcd_barrier(xbar); } \
    if (DIL_MASK) { unsigned long long t1_ = __builtin_amdgcn_s_memrealtime(); if (((DIL_MASK) >> (k)) & 1) { const unsigned long long w_ = (t1_ - tprev) * (DIL_MUL); while (__builtin_amdgcn_s_memrealtime() - t1_ < w_) __builtin_amdgcn_s_sleep(8); t1_ = __builtin_amdgcn_s_memrealtime(); } tprev = t1_; } } while (0)

    if (IN(0)) {
        LAS float* scr = (LAS float*)(L + wave * 16384);
        const int gw = bid * NWAVES + wave, NGW = G * NWAVES;
        constexpr int I_IN = 16 * (NIN / 32), I_SQ = 16 * 32, I_KV = 16 * 64, I_1 = 16 * 128, I_2 = 64 * 32;
        constexpr int NITEMS = I_IN + 3 * I_SQ + I_KV + I_1 + I_2;
        auto ident = [](int n) { return n; };
        auto inmap = [](int n) { return n < 2048 ? n : (n < 3584 ? n + 8 : (n < 3592 ? n - 1536 : (n < 3600 ? n : -1))); };
        for (int it = gw; it < NITEMS; it += NGW) {
            int r = it;
            if (r < I_IN) { p0_transpose_item(w_in, 1024, 3600, NIN, Win_t, scr, r, lane, inmap); continue; } r -= I_IN;
            if (r < I_SQ) { p0_transpose_item(w_out, 1024, 1024, 1024, Wout_t, scr, r, lane, ident); continue; } r -= I_SQ;
            if (r < I_SQ) { p0_transpose_item(w_xq, 1024, 1024, 1024, Wxq_t, scr, r, lane, ident); continue; } r -= I_SQ;
            if (r < I_KV) { p0_transpose_item(w_xkv, 1024, 2048, 2048, Wxkv_t, scr, r, lane, ident); continue; } r -= I_KV;
            if (r < I_SQ) { p0_transpose_item(w_xo, 1024, 1024, 1024, Wxo_t, scr, r, lane, ident); continue; } r -= I_SQ;
            if (r < I_1) { p0_transpose_item(w_ff1, 1024, 4096, 4096, W1_t, scr, r, lane, ident); continue; } r -= I_1;
            p0_transpose_item(w_ff2, 4096, 1024, 1024, W2_t, scr, r, lane, ident);
        }
        { int m = gw; for (; m + 3 * NGW < M; m += 4 * NGW) rms_rows_to_bf16<4>(x + (size_t)m * D, (size_t)NGW * D, ln1, XN + (size_t)m * D, lane);
          for (; m < M; m += NGW) rms_row_to_bf16(x + (size_t)m * D, ln1, XN + (size_t)m * D, lane); }
        for (int m = gw; m < MM; m += NGW) rms_row_to_bf16(mem + (size_t)m * D, ln_mem, MEMN + (size_t)m * D, lane);
        __syncthreads();
    }
    SEAM(0);
    if (IN(1)) {
        pg8::Gemm g{XN, Win_t, M, NIN, D}; pg8::StaticOrder S; S.init(M, NIN, G, bid);
        pg8::EpiZ E{Zb, GT, C2_FOX};
        pg8::gemm_phase<pg8::EpiZ, pg8::StaticOrder, true, true>(L, g, S, E, tid);
    }
    SEAM(1);
    if (IN(2)) {
        if (bid < 64) {
            const int b = bid >> 3, h = bid & 7; const float bfv = fx_b_f[h];
            float v[16]; float run = 0.f;
#pragma unroll
            for (int j = 0; j < 16; ++j) { const int s = 16 * tid + j; run += logsig(GT[((size_t)b * SEQ + s) * 16 + 8 + h] + bfv); v[j] = run; }
            const float inc = ml::scan_add(run, lane);
            LAS float* wt = (LAS float*)(L);
            if (lane == 63) wt[wave] = inc;
            __syncthreads();
            float off = inc - run;
            for (int ww = 0; ww < wave; ++ww) off += wt[ww];
#pragma unroll
            for (int j4 = 0; j4 < 4; ++j4) { f32x4 o;
#pragma unroll
                for (int i = 0; i < 4; ++i) o[i] = -(off + v[4 * j4 + i]) * LOG2E;
                *(f32x4*)(CNEG + (size_t)bid * SEQ + 16 * tid + 4 * j4) = o; }
            __syncthreads();
        } else if (bid < 96) {
            pg8::Gemm g{MEMN, Wxkv_t, MM, 1024, D}; pg8::StaticOrder S; S.init(MM, 1024, 32, bid - 64);
            pg8::EpiPlain E{KX, 1024};
            pg8::gemm_phase<pg8::EpiPlain, pg8::StaticOrder, true, true>(L, g, S, E, tid);
        } else if (bid < 128) {
            pg8::Gemm g{Wxkv_t + (size_t)1024 * 1024, MEMN, 1024, MM, D}; pg8::StaticOrder S; S.init(1024, MM, 32, bid - 96);
            pg8::EpiPlain E{VXT, 2048};
            pg8::gemm_phase<pg8::EpiPlain, pg8::StaticOrder, true, true>(L, g, S, E, tid);
        }
        {
            const ml::PreOut PO{XN, XN + (size_t)32 * 1024 * 1024, (bf16*)(args.ws + WS_VTG), out, SS2, SS3};
            int cw_head = -1;
            const int u0 = bid < 128 ? 14 * bid : 1792 + 18 * (bid - 128), nu = (G == 256) ? (bid < 128 ? 14 : 18) : 0;
            ml::PreRegs PR;
            if (nu > 0) ml::pre_load(u0, Zb, GT, PR, tid);
            for (int i = 0; i < nu; ++i) ml::pre_unit(u0 + i, Zb, GT, PO, conv_w, conv_b, ml_b_i, ml_b_f, L, tid, cw_head, PR, i + 1 < nu ? u0 + i + 1 : -1);
            if (G != 256) { for (int u = bid; u < 4096; u += G) { ml::pre_load(u, Zb, GT, PR, tid); ml::pre_unit(u, Zb, GT, PO, conv_w, conv_b, ml_b_i, ml_b_f, L, tid, cw_head, PR, -1); } }
        }
    }
    SEAM(2);
    if (IN(3)) {
#ifndef NO_ML
        if (bid < 64) { const ml::PreOut PO{XN, XN + (size_t)32 * 1024 * 1024, (bf16*)(args.ws + WS_VTG), out, SS2, SS3}; const int sg = 1 - (bid >> 5), sbh = bid & 31; ml::stream(sbh >> 2, sbh & 3, Zb, PO, MIX, ml_norm, L, tid, 64 * sg, 64 * sg + 64); }
#endif
#if defined(ML_SEP)
        cg::this_grid().sync();
        if (DIL_MASK) { unsigned long long t1_ = __builtin_amdgcn_s_memrealtime(); if (((DIL_MASK) >> 11) & 1) { const unsigned long long w_ = (t1_ - tprev) * (DIL_MUL); while (__builtin_amdgcn_s_memrealtime() - t1_ < w_) __builtin_amdgcn_s_sleep(8); t1_ = __builtin_amdgcn_s_memrealtime(); } tprev = t1_; }
#endif
        {
            if (tid == 0) { MISC[2] = (unsigned)__builtin_amdgcn_s_getreg((3 << 11) | 20) & 7u; MISC[3] = 0u; }
            for (;;) {
                if (tid == 0) { unsigned qi = MISC[3], u = 0xffffffffu;
                    while (qi < 8u) { const unsigned qx = (MISC[2] + qi) & 7u; const unsigned v = atomicAdd(ctl + 64 + 16 * qx, 1u); if (v < 256u) { u = qx * 256u + v; break; } ++qi; }
                    MISC[3] = qi; MISC[0] = u; }
                LBAR();
                const unsigned u = MISC[0];
                LBAR();
                if (u == 0xffffffffu) break;
                const int bh = (int)(u >> 5), qb = 31 - (int)(u & 31); int tq = tid; asm volatile("" : "+v"(tq));
#ifndef NO_FOX
                attn_body::attn_unit<100>(bh >> 3, bh & 7, qb, (const attn_body::bf16*)(Zb + ZC_FXQ), (const attn_body::bf16*)(Zb + ZC_FXK), (const attn_body::bf16*)(Zb + ZC_FXV),
                                        (attn_body::bf16*)(MIX + 512), CNEG + (size_t)bh * SEQ, (char*)lds, tq);
#endif
            }
        }
    }
    SEAM(3);
    if (IN(4)) {
        pg8::Gemm g{MIX, Wout_t, M, D, D}; pg8::StaticOrder S; S.init(M, D, G, bid);
        pg8::EpiRes E{x, out, XN, ln_x, SS1};
        pg8::gemm_phase<pg8::EpiRes, pg8::StaticOrder, true, true>(L, g, S, E, tid);
    }
    SEAM(4);
    if (IN(5)) {
        pg8::Gemm g{XN, Wxq_t, M, D, D}; pg8::StaticOrder S; S.init(M, D, G, bid);
        pg8::EpiRowScale<0> E{MIX, 1024, SS1, C2_X};
        pg8::gemm_phase<pg8::EpiRowScale<0>, pg8::StaticOrder, true, true>(L, g, S, E, tid);
    }
    if (IN(6)) {
#ifndef NO_XA
        { pg8::StaticOrder S; S.init(M, D, G, bid); pg8::Unit uu; for (int i = 0; S.next(i, uu); ++i) xa::xattn_unit(uu.pm, uu.pn, MIX, KX, VXT, L, tid); }
#endif
    }
    SEAM(6);
    if (IN(7)) {
        pg8::Gemm g{MIX, Wxo_t, M, D, D}; pg8::StaticOrder S; S.init(M, D, G, bid);
        pg8::EpiRes E{out, out, XN, ln2, SS2};
        pg8::gemm_phase<pg8::EpiRes, pg8::StaticOrder, true, true>(L, g, S, E, tid);
    }
    SEAM(7);
    if (IN(8)) {
        pg8::Gemm g{XN, W1_t, M, FF, D}; pg8::StaticOrder S; S.init(M, FF, G, bid);
        pg8::EpiRowScale<1> E{Ub, FF, SS2, 1.0f};
        pg8::gemm_phase<pg8::EpiRowScale<1>, pg8::StaticOrder, true, true>(L, g, S, E, tid);
    }
    SEAM(8);
    if (IN(9)) {
        pg8::Gemm g{Ub, W2_t, M, D, FF}; pg8::StaticOrder S; S.init(M, D, G, bid);
        if (G == 256) {
            pg8::EpiResNorm E{out, out, ln_f, SS3, ctl + 4096};
            pg8::gemm_phase<pg8::EpiResNorm, pg8::StaticOrder, true, true>(L, g, S, E, tid);
        } else {
            pg8::EpiRes E{out, out, nullptr, nullptr, SS3};
            pg8::gemm_phase<pg8::EpiRes, pg8::StaticOrder, true, true>(L, g, S, E, tid);
            xcd_barrier(xbar);
            const int gw = bid * NWAVES + wave, NGW = G * NWAVES;
            for (int m = gw; m < M; m += NGW) { const float r = pg8::row_rs(SS3, m); f32x4* p = (f32x4*)(out + (size_t)m * D) + lane;
#pragma unroll
                for (int j = 0; j < 4; ++j) p[64 * j] = p[64 * j] * ((const f32x4*)ln_f)[lane + 64 * j] * r; }
        }
    }
    SEAM(9);
#undef IN
#undef SEAM
}
#undef x
#undef mem
#undef ln1
#undef w_in
#undef conv_w
#undef conv_b
#undef ml_b_i
#undef ml_b_f
#undef ml_norm
#undef fx_b_f
#undef w_out
#undef ln_x
#undef ln_mem
#undef w_xq
#undef w_xkv
#undef w_xo
#undef ln2
#undef w_ff1
#undef w_ff2
#undef ln_f
#undef ctl
#undef Win_t
#undef Wout_t
#undef Wxq_t
#undef Wxkv_t
#undef Wxo_t
#undef W1_t
#undef W2_t
#undef MEMN
#undef KX
#undef VXT
#undef GT
#undef CNEG
#undef SS1
#undef SS2
#undef SS3
#undef XN
#undef MIX
#undef Zb
#undef Ub

#ifndef MK_SPLIT
#define MK_SPLIT 0
#endif
extern "C" void kernel_launch(void* const* d_in, const int* in_sizes, int n_in, void* d_out, int out_size, void* d_ws, size_t ws_size, hipStream_t stream) {
    static int grid = 0;
    if (grid == 0) {
        if (n_in != 20 || out_size != M * D || ws_size < WS_END) { fprintf(stderr, "kernel_launch: unexpected problem (n_in %d out %d ws %zu)\n", n_in, out_size, ws_size); grid = -1; return; }
        int dev = 0, cus = 0, per_cu = 0;
        hipGetDevice(&dev); hipDeviceGetAttribute(&cus, hipDeviceAttributeMultiprocessorCount, dev);
        if (hipFuncSetAttribute((const void*)mk_fwd, hipFuncAttributeMaxDynamicSharedMemorySize, LDS_BYTES) != hipSuccess) { fprintf(stderr, "kernel_launch: hipFuncSetAttribute failed\n"); grid = -1; return; }
        if (hipOccupancyMaxActiveBlocksPerMultiprocessor(&per_cu, (const void*)mk_fwd, NWAVES * 64, LDS_BYTES) != hipSuccess || per_cu < 1) { fprintf(stderr, "kernel_launch: occupancy query says %d\n", per_cu); per_cu = 1; }
        (void)hipGetLastError();
        grid = cus;
        if (grid > 256) grid = 256;
    }
    if (grid < 0) return;
    hipMemsetAsync((char*)d_ws + WS_CTL, 0, CTL_ZERO_BYTES, stream);
    Args a{};
    for (int i = 0; i < 20; ++i) a.in[i] = (const float*)d_in[i];
    a.out = (float*)d_out; a.ws = (unsigned char*)d_ws;
#if MK_SPLIT
    for (int p = 0; p < N_PHASES; ++p) { a.ph_lo = p; a.ph_hi = p + 1; a.coop = 0; hipLaunchKernelGGL(mk_fwd, dim3(grid), dim3(NWAVES * 64), LDS_BYTES, stream, a); }
#else
    a.ph_lo = 0; a.ph_hi = N_PHASES; a.coop = 1;
    void* kargs[] = {&a};
    hipError_t e = hipLaunchCooperativeKernel((const void*)mk_fwd, dim3(grid), dim3(NWAVES * 64), kargs, LDS_BYTES, stream);
    if (e != hipSuccess) fprintf(stderr, "cooperative launch failed: %s (grid %d)\n", hipGetErrorString(e), grid);
#endif
}
```

```cpp
#include <hip/hip_runtime.h>
#include <hip/hip_cooperative_groups.h>
#include <hip/hip_bf16.h>
#include <cstdio>
#include <cstdint>
#include <cmath>
namespace cg = cooperative_groups;
namespace pg8 {
#define PG8_LAS __attribute__((address_space(3)))
typedef unsigned short bf16_t;
typedef short bf16x8 __attribute__((ext_vector_type(8)));
typedef float f32x4 __attribute__((ext_vector_type(4)));
typedef unsigned u32x4 __attribute__((ext_vector_type(4)));
constexpr int BM = 256, BK = 64, HALF = 128, HTB = HALF * BK * 2  , STAGE_BYTES = 8 * HTB, NXCD = 8, WGM = 8;

__host__ __device__ __forceinline__ int lds_byte(int r, int c) { const int st = (r >> 4) * 2 + (c >> 5), rr = r & 15, cc = c & 31, ob = rr * 64 + cc * 2; return st * 1024 + (ob ^ (((ob >> 9) & 1) << 5)); }
__host__ __device__ __forceinline__ void stage_rc(int b, int& R, int& C) { const int st = b / 1024, sb = b % 1024, swz = sb ^ (((sb >> 9) & 1) << 5); R = (st >> 1) * 16 + swz / 64; C = (st & 1) * 32 + (swz % 64) / 2; }
__host__ __device__ __forceinline__ int perm32(int rho) { const int n = rho >> 4, i = rho & 15; return 8 * (i >> 2) + 4 * n + (i & 3); }

struct Unit { int pm, pn; };
struct Gemm { const bf16_t* A; const bf16_t* Bt; int M, N, K; };

struct StaticOrder {
    int nM, nN, nwg, G, c;
    __host__ __device__ void init(int M, int N, int G_, int c_) { nM = M / BM; nN = N / BM; nwg = nM * nN; G = G_; c = c_; }
    __host__ __device__ bool next(int i, Unit& u) const {
        const long L = (long)i * G + c; if (L >= nwg) return false;
        int wgid = (int)L; { const int q = nwg / NXCD, r = nwg % NXCD, xcd = wgid % NXCD, off = wgid / NXCD; wgid = (xcd < r ? xcd * (q + 1) : r * (q + 1) + (xcd - r) * q) + off; }
        const int nig = WGM * nN, gid = wgid / nig, fm = gid * WGM, gsz = (nM - fm) < WGM ? (nM - fm) : WGM;
        u.pm = fm + ((wgid % nig) % gsz); u.pn = (wgid % nig) / gsz; return true;
    }
    __device__ __forceinline__ void a_ready(const Unit&) const {}
    __device__ __forceinline__ void done(const Unit&) const {}
};

__device__ __forceinline__ unsigned cvt_pk_bf16(float lo, float hi) { unsigned r; asm volatile("v_cvt_pk_bf16_f32 %0, %1, %2" : "=v"(r) : "v"(lo), "v"(hi)); return r; }
typedef float f32x2 __attribute__((ext_vector_type(2)));
typedef unsigned u32x2 __attribute__((ext_vector_type(2)));
constexpr float RMS_EPS = 1e-6f;
__device__ __forceinline__ float row_rs(const float* ss, int row) {
    const f32x4* p = (const f32x4*)(ss + (size_t)row * 16);
    const f32x4 a = p[0], b = p[1], c = p[2], d = p[3];
    const float s = ((a[0] + a[1]) + (a[2] + a[3])) + ((b[0] + b[1]) + (b[2] + b[3])) + ((c[0] + c[1]) + (c[2] + c[3])) + ((d[0] + d[1]) + (d[2] + d[3]));
    return 1.0f / sqrtf(s * (1.0f / 1024.0f) + RMS_EPS);
}
struct EpiZ {
    static constexpr bool PERM = true, AFTER_DRAIN = false;
    bf16_t* Z; float* G; float c2;
    __device__ __forceinline__ void operator()(const f32x4 (&acc)[2][2][4][2], const Unit& u, int wr, int wc, int fr, int fq) const {
        const int row0 = u.pm * BM + wr * 64 + fr;
        if (u.pn < 14) {
            const float sc = (u.pn == 8 || u.pn == 9) ? c2 : 1.0f;
            const int col0 = u.pn * BM + wc * 32 + 8 * fq;
#pragma unroll
            for (int ai = 0; ai < 2; ++ai)
#pragma unroll
                for (int m = 0; m < 4; ++m) { bf16_t* rowp = Z + (size_t)(row0 + ai * HALF + m * 16) * 3584 + col0;
#pragma unroll
                    for (int bj = 0; bj < 2; ++bj) { const f32x4 v0 = acc[ai][bj][m][0] * sc, v1 = acc[ai][bj][m][1] * sc;
                        u32x4 w; w.x = cvt_pk_bf16(v0[0], v0[1]); w.y = cvt_pk_bf16(v0[2], v0[3]); w.z = cvt_pk_bf16(v1[0], v1[1]); w.w = cvt_pk_bf16(v1[2], v1[3]);
                        *(u32x4*)(rowp + bj * HALF) = w; } }
        } else if (wc == 0 && fq < 2) {
#pragma unroll
            for (int ai = 0; ai < 2; ++ai)
#pragma unroll
                for (int m = 0; m < 4; ++m) { float* gp = G + (size_t)(row0 + ai * HALF + m * 16) * 16 + 8 * fq;
                    *(f32x4*)(gp) = acc[ai][0][m][0]; *(f32x4*)(gp + 4) = acc[ai][0][m][1]; }
        }
    }
};
struct EpiPlain {
    static constexpr bool PERM = true, AFTER_DRAIN = false;
    bf16_t* O; int ldc;
    __device__ __forceinline__ void operator()(const f32x4 (&acc)[2][2][4][2], const Unit& u, int wr, int wc, int fr, int fq) const {
        const int row0 = u.pm * BM + wr * 64 + fr; const int col0 = u.pn * BM + wc * 32 + 8 * fq;
#pragma unroll
        for (int ai = 0; ai < 2; ++ai)
#pragma unroll
            for (int m = 0; m < 4; ++m) { bf16_t* rowp = O + (size_t)(row0 + ai * HALF + m * 16) * ldc + col0;
#pragma unroll
                for (int bj = 0; bj < 2; ++bj) { const f32x4 v0 = acc[ai][bj][m][0], v1 = acc[ai][bj][m][1];
                    u32x4 w; w.x = cvt_pk_bf16(v0[0], v0[1]); w.y = cvt_pk_bf16(v0[2], v0[3]); w.z = cvt_pk_bf16(v1[0], v1[1]); w.w = cvt_pk_bf16(v1[2], v1[3]);
                    *(u32x4*)(rowp + bj * HALF) = w; } }
    }
};
template <int ACT> struct EpiRowScale {
    static constexpr bool PERM = true, AFTER_DRAIN = false;
    bf16_t* O; int ldc; const float* ss; float sc;
    __device__ __forceinline__ void operator()(const f32x4 (&acc)[2][2][4][2], const Unit& u, int wr, int wc, int fr, int fq) const {
        const int row0 = u.pm * BM + wr * 64 + fr; const int col0 = u.pn * BM + wc * 32 + 8 * fq;
#pragma unroll
        for (int ai = 0; ai < 2; ++ai)
#pragma unroll
            for (int m = 0; m < 4; ++m) { const int row = row0 + ai * HALF + m * 16; const float r = row_rs(ss, row) ; bf16_t* rowp = O + (size_t)row * ldc + col0;
#pragma unroll
                for (int bj = 0; bj < 2; ++bj) { f32x4 v0 = acc[ai][bj][m][0] * r, v1 = acc[ai][bj][m][1] * r;
                    if (ACT == 1) {
#pragma unroll
                        for (int e = 0; e < 4; ++e) { const float a = fmaxf(v0[e], 0.f), b = fmaxf(v1[e], 0.f); v0[e] = a * a; v1[e] = b * b; }
                    } else { v0 = v0 * sc; v1 = v1 * sc; }
                    u32x4 w; w.x = cvt_pk_bf16(v0[0], v0[1]); w.y = cvt_pk_bf16(v0[2], v0[3]); w.z = cvt_pk_bf16(v1[0], v1[1]); w.w = cvt_pk_bf16(v1[2], v1[3]);
                    *(u32x4*)(rowp + bj * HALF) = w; } }
    }
};
struct EpiRes {
    static constexpr bool PERM = true, AFTER_DRAIN = false;
    const float* base; float* out; bf16_t* xn; const float* gain; float* ssout;
    __device__ __forceinline__ void operator()(const f32x4 (&acc)[2][2][4][2], const Unit& u, int wr, int wc, int fr, int fq) const {
        const int row0 = u.pm * BM + wr * 64 + fr; const int col0 = u.pn * BM + wc * 32 + 8 * fq;
        f32x4 gv[2][2];
#pragma unroll
        for (int bj = 0; bj < 2; ++bj)
#pragma unroll
            for (int n = 0; n < 2; ++n) { if (xn) gv[bj][n] = *(const f32x4*)(gain + col0 + bj * HALF + n * 4); else gv[bj][n] = (f32x4){1.f, 1.f, 1.f, 1.f}; }
#pragma unroll
        for (int ai = 0; ai < 2; ++ai) {
            f32x4 bs[4][2][2];
#pragma unroll
            for (int m = 0; m < 4; ++m) { const size_t off = (size_t)(row0 + ai * HALF + m * 16) * 1024 + col0;
#pragma unroll
                for (int bj = 0; bj < 2; ++bj) { bs[m][bj][0] = *(const f32x4*)(base + off + bj * HALF); bs[m][bj][1] = *(const f32x4*)(base + off + bj * HALF + 4); } }
#pragma unroll
            for (int m = 0; m < 4; ++m) { const int row = row0 + ai * HALF + m * 16; const size_t off = (size_t)row * 1024 + col0; float sq = 0.f;
#pragma unroll
                for (int bj = 0; bj < 2; ++bj) {
                    const f32x4 o0 = bs[m][bj][0] + acc[ai][bj][m][0], o1 = bs[m][bj][1] + acc[ai][bj][m][1];
                    *(f32x4*)(out + off + bj * HALF) = o0; *(f32x4*)(out + off + bj * HALF + 4) = o1;
                    sq += ((o0[0] * o0[0] + o0[1] * o0[1]) + (o0[2] * o0[2] + o0[3] * o0[3])) + ((o1[0] * o1[0] + o1[1] * o1[1]) + (o1[2] * o1[2] + o1[3] * o1[3]));
                    if (xn) { const f32x4 g0 = o0 * gv[bj][0], g1 = o1 * gv[bj][1]; u32x4 w; w.x = cvt_pk_bf16(g0[0], g0[1]); w.y = cvt_pk_bf16(g0[2], g0[3]); w.z = cvt_pk_bf16(g1[0], g1[1]); w.w = cvt_pk_bf16(g1[2], g1[3]);
                        *(u32x4*)(xn + off + bj * HALF) = w; } }
                sq += __shfl_xor(sq, 16); sq += __shfl_xor(sq, 32);
                if (fq == 0) ssout[(size_t)row * 16 + u.pn * 4 + wc] = sq; }
            asm volatile("" ::: "memory"); }
    }
};
struct EpiResNorm {
    static constexpr bool PERM = true, AFTER_DRAIN = false;
    const float* base; float* out; const float* gain; float* ss; unsigned* cnt;
    __device__ __forceinline__ void operator()(const f32x4 (&acc_c)[2][2][4][2], const Unit& u, int wr, int wc, int fr, int fq) const {
        f32x4 (&acc)[2][2][4][2] = const_cast<f32x4 (&)[2][2][4][2]>(acc_c);
        const int row0 = u.pm * BM + wr * 64 + fr; const int col0 = u.pn * BM + wc * 32 + 8 * fq;
#pragma unroll
        for (int ai = 0; ai < 2; ++ai)
#pragma unroll
            for (int m = 0; m < 4; ++m) { const int row = row0 + ai * HALF + m * 16; const size_t off = (size_t)row * 1024 + col0; float sq = 0.f;
#pragma unroll
                for (int bj = 0; bj < 2; ++bj) {
                    const f32x4 b0 = *(const f32x4*)(base + off + bj * HALF), b1 = *(const f32x4*)(base + off + bj * HALF + 4);
                    const f32x4 o0 = b0 + acc[ai][bj][m][0], o1 = b1 + acc[ai][bj][m][1];
                    acc[ai][bj][m][0] = o0; acc[ai][bj][m][1] = o1;
                    sq += ((o0[0] * o0[0] + o0[1] * o0[1]) + (o0[2] * o0[2] + o0[3] * o0[3])) + ((o1[0] * o1[0] + o1[1] * o1[1]) + (o1[2] * o1[2] + o1[3] * o1[3])); }
                sq += __shfl_xor(sq, 16); sq += __shfl_xor(sq, 32);
                if (fq == 0) __hip_atomic_store(ss + (size_t)row * 16 + u.pn * 4 + wc, sq, __ATOMIC_RELAXED, __HIP_MEMORY_SCOPE_AGENT);
                if (m == 3) asm volatile("" ::: "memory"); }
        asm volatile("s_waitcnt vmcnt(0)" ::: "memory");
        unsigned* c = cnt + 64 * u.pm;
        if ((fr | fq) == 0) __hip_atomic_fetch_add(c, 1u, __ATOMIC_RELAXED, __HIP_MEMORY_SCOPE_AGENT);
        { unsigned spins = 0;
          while ((unsigned)__builtin_amdgcn_readfirstlane(__hip_atomic_load(c, __ATOMIC_RELAXED, __HIP_MEMORY_SCOPE_AGENT)) < 32u) { __builtin_amdgcn_s_sleep(2); if (++spins > (1u << 22)) break; } }
        asm volatile("" ::: "memory");
        f32x4 gv[2][2];
#pragma unroll
        for (int bj = 0; bj < 2; ++bj)
#pragma unroll
            for (int n = 0; n < 2; ++n) gv[bj][n] = *(const f32x4*)(gain + col0 + bj * HALF + n * 4);
#pragma unroll
        for (int ai = 0; ai < 2; ++ai)
#pragma unroll
            for (int m = 0; m < 4; ++m) { const int row = row0 + ai * HALF + m * 16; const size_t off = (size_t)row * 1024 + col0;
                const unsigned long long* sp = (const unsigned long long*)(ss + (size_t)row * 16); float tot = 0.f;
#pragma unroll
                for (int k = 0; k < 8; ++k) { const unsigned long long v = __hip_atomic_load(sp + k, __ATOMIC_RELAXED, __HIP_MEMORY_SCOPE_AGENT); tot += __uint_as_float((unsigned)v) + __uint_as_float((unsigned)(v >> 32)); }
                const float r = 1.0f / sqrtf(tot * (1.0f / 1024.0f) + RMS_EPS);
#pragma unroll
                for (int bj = 0; bj < 2; ++bj) { *(f32x4*)(out + off + bj * HALF) = acc[ai][bj][m][0] * gv[bj][0] * r; *(f32x4*)(out + off + bj * HALF + 4) = acc[ai][bj][m][1] * gv[bj][1] * r; }
                asm volatile("" ::: "memory"); }
    }
};
template <class Epi, class Sched, bool ALIGN_EPI = false, bool SP2 = false>
__device__ __forceinline__ void gemm_phase(PG8_LAS unsigned char* lds, const Gemm g, const Sched& S, const Epi& E, const int tid_in) {
    const int tid = tid_in, wid = __builtin_amdgcn_readfirstlane(tid >> 6), lane = tid & 63, wr = wid >> 2, wc = wid & 3, fr = lane & 15, fq = lane >> 4;
    const int K = g.K, nt = K / BK;
    unsigned voffA[2], voffB[2];
#pragma unroll
    for (int i = 0; i < 2; ++i) { int R, C; stage_rc(tid * 16 + i * 8192, R, C); const int Rb = Epi::PERM ? ((R & ~31) + perm32(R & 31)) : R;
        voffA[i] = (unsigned)(R * K + C) * 2u; voffB[i] = (unsigned)(Rb * K + C) * 2u; }
    const size_t kstep = (size_t)(BK * 2);
    const size_t hstep = (size_t)HALF * K * 2;
    const size_t tstep = 2 * hstep;
    const unsigned ldsw = (unsigned)wid * 1024u;
    const int aoff = lds_byte(wr * 64 + fr, fq * 8), boff = lds_byte(wc * 32 + fr, fq * 8);
#define PG8_SA(b, h) (((b) * 2 + (h)) * HTB)
#define PG8_SB(b, h) ((4 + (b) * 2 + (h)) * HTB)
#define PG8_STAGE(bufoff, gbase, voff) do { _Pragma("unroll") for (int _i = 0; _i < 2; ++_i) \
        __builtin_amdgcn_global_load_lds((const unsigned*)((const char*)(gbase) + (voff)[_i]), (PG8_LAS unsigned*)(lds + (bufoff) + ldsw + _i * 8192), 16, 0, 0); } while (0)
#define PG8_LDA(dst, b, h) do { _Pragma("unroll") for (int m = 0; m < 4; ++m) _Pragma("unroll") for (int k = 0; k < 2; ++k) dst[m][k] = *(const PG8_LAS bf16x8*)(lds + PG8_SA(b, h) + aoff + m * 2048 + k * 1024); } while (0)
#define PG8_LDB(dst, b, h) do { _Pragma("unroll") for (int n = 0; n < 2; ++n) _Pragma("unroll") for (int k = 0; k < 2; ++k) dst[n][k] = *(const PG8_LAS bf16x8*)(lds + PG8_SB(b, h) + boff + n * 2048 + k * 1024); } while (0)
#define PG8_MMA(ai, bj, At, Bt) do { __builtin_amdgcn_s_setprio(1); _Pragma("unroll") for (int m = 0; m < 4; ++m) _Pragma("unroll") for (int n = 0; n < 2; ++n) _Pragma("unroll") for (int k = 0; k < 2; ++k) \
        acc[ai][bj][m][n] = __builtin_amdgcn_mfma_f32_16x16x32_bf16(Bt[n][k], At[m][k], acc[ai][bj][m][n], 0, 0, 0); __builtin_amdgcn_s_setprio(0); } while (0)
#define PG8_WAIT_V(n) asm volatile("s_waitcnt vmcnt(" #n ")" ::: "memory")
#define PG8_WAIT_L(n) asm volatile("s_waitcnt lgkmcnt(" #n ")" ::: "memory")
#define PG8_BAR __builtin_amdgcn_s_barrier()
#define PG8_SCHED __builtin_amdgcn_sched_barrier(0)
    Unit cur, nxt; int ui = 0;
    if (!S.next(0, cur)) return;
    f32x4 acc[2][2][4][2];
#pragma unroll
    for (int a = 0; a < 2; ++a)
#pragma unroll
        for (int b = 0; b < 2; ++b)
#pragma unroll
            for (int m = 0; m < 4; ++m)
#pragma unroll
                for (int n = 0; n < 2; ++n) acc[a][b][m][n] = (f32x4){0.f, 0.f, 0.f, 0.f};
    bf16x8 At[4][2], B0[2][2], B1[2][2];
    const char* cA = (const char*)g.A + (size_t)cur.pm * tstep; const char* cB = (const char*)g.Bt + (size_t)cur.pn * tstep;
    S.a_ready(cur);
    if constexpr (SP2) {
        PG8_STAGE(PG8_SB(0, 0), cB, voffB); PG8_STAGE(PG8_SB(0, 1), cB + hstep, voffB); PG8_STAGE(PG8_SA(0, 0), cA, voffA); PG8_STAGE(PG8_SA(0, 1), cA + hstep, voffA);
        if (wr == 1) PG8_BAR;
        PG8_WAIT_V(2); PG8_BAR;
        PG8_STAGE(PG8_SB(1, 0), cB + kstep, voffB); PG8_STAGE(PG8_SA(1, 0), cA + kstep, voffA); PG8_STAGE(PG8_SB(1, 1), cB + hstep + kstep, voffB);
        PG8_WAIT_V(6); PG8_BAR;
    } else {
        PG8_STAGE(PG8_SB(0, 0), cB, voffB); PG8_STAGE(PG8_SA(0, 0), cA, voffA); PG8_STAGE(PG8_SB(0, 1), cB + hstep, voffB); PG8_STAGE(PG8_SA(0, 1), cA + hstep, voffA);
        if (wr == 1) PG8_BAR;
        PG8_WAIT_V(4); PG8_BAR;
        PG8_STAGE(PG8_SB(1, 0), cB + kstep, voffB); PG8_STAGE(PG8_SA(1, 0), cA + kstep, voffA); PG8_STAGE(PG8_SB(1, 1), cB + hstep + kstep, voffB);
        PG8_WAIT_V(6); PG8_BAR;
    }
    for (;;) {
        const bool has_next = S.next(ui + 1, nxt);
        const char* nA = has_next ? (const char*)g.A + (size_t)nxt.pm * tstep : cA; const char* nB = has_next ? (const char*)g.Bt + (size_t)nxt.pn * tstep : cB;
        for (int t = 0; t < nt; t += 2) {
            const bool last = (t == nt - 2);
            const char* a1 = cA + (size_t)(t + 1) * kstep;
            const char* a2 = last ? nA : cA + (size_t)(t + 2) * kstep; const char* b2 = last ? nB : cB + (size_t)(t + 2) * kstep;
            const char* a3 = a2 + kstep; const char* b3 = b2 + kstep;
            if (last && has_next) S.a_ready(nxt);
            if constexpr (SP2) {
            PG8_LDB(B0, 0, 0); PG8_LDB(B1, 0, 1); PG8_SCHED; PG8_LDA(At, 0, 0); PG8_STAGE(PG8_SA(1, 1), a1 + hstep, voffA);
            PG8_WAIT_V(8); PG8_WAIT_L(0); PG8_BAR; PG8_MMA(0, 0, At, B0); PG8_MMA(0, 1, At, B1); PG8_BAR; PG8_SCHED;
            PG8_LDA(At, 0, 1); PG8_STAGE(PG8_SB(0, 0), b2, voffB); PG8_STAGE(PG8_SB(0, 1), b2 + hstep, voffB); PG8_STAGE(PG8_SA(0, 0), a2, voffA);
            PG8_WAIT_V(8); PG8_WAIT_L(0); PG8_BAR; PG8_MMA(1, 0, At, B0); PG8_MMA(1, 1, At, B1); PG8_BAR; PG8_SCHED;
            PG8_LDB(B0, 1, 0); PG8_LDB(B1, 1, 1); PG8_SCHED; PG8_LDA(At, 1, 0); PG8_STAGE(PG8_SA(0, 1), a2 + hstep, voffA);
            PG8_WAIT_V(8); PG8_WAIT_L(0); PG8_BAR; PG8_MMA(0, 0, At, B0); PG8_MMA(0, 1, At, B1); PG8_BAR; PG8_SCHED;
            PG8_LDA(At, 1, 1); PG8_STAGE(PG8_SB(1, 0), b3, voffB); PG8_STAGE(PG8_SB(1, 1), b3 + hstep, voffB); PG8_STAGE(PG8_SA(1, 0), a3, voffA);
            PG8_WAIT_V(8); PG8_WAIT_L(0); PG8_BAR; PG8_MMA(1, 0, At, B0); PG8_MMA(1, 1, At, B1); PG8_BAR; PG8_SCHED;
            } else {
            PG8_LDB(B0, 0, 0); PG8_SCHED; PG8_LDA(At, 0, 0); PG8_STAGE(PG8_SA(1, 1), a1 + hstep, voffA);
            PG8_WAIT_L(8); PG8_BAR; PG8_WAIT_L(0); PG8_MMA(0, 0, At, B0); PG8_BAR; PG8_SCHED;
            PG8_LDB(B1, 0, 1); PG8_STAGE(PG8_SB(0, 0), b2, voffB);
            PG8_BAR; PG8_WAIT_L(0); PG8_MMA(0, 1, At, B1); PG8_BAR;
            PG8_LDA(At, 0, 1); PG8_STAGE(PG8_SA(0, 0), a2, voffA);
            PG8_BAR; PG8_WAIT_L(0); PG8_MMA(1, 0, At, B0); PG8_BAR; PG8_SCHED;
            PG8_STAGE(PG8_SB(0, 1), b2 + hstep, voffB);
            PG8_WAIT_V(6); PG8_BAR; PG8_MMA(1, 1, At, B1); PG8_BAR;
            PG8_LDB(B0, 1, 0); PG8_SCHED; PG8_LDA(At, 1, 0); PG8_STAGE(PG8_SA(0, 1), a2 + hstep, voffA);
            PG8_WAIT_L(8); PG8_BAR; PG8_WAIT_L(0); PG8_MMA(0, 0, At, B0); PG8_BAR; PG8_SCHED;
            PG8_LDB(B1, 1, 1); PG8_STAGE(PG8_SB(1, 0), b3, voffB);
            PG8_BAR; PG8_WAIT_L(0); PG8_MMA(0, 1, At, B1); PG8_BAR;
            PG8_LDA(At, 1, 1); PG8_STAGE(PG8_SA(1, 0), a3, voffA);
            PG8_BAR; PG8_WAIT_L(0); PG8_MMA(1, 0, At, B0); PG8_BAR; PG8_SCHED;
            PG8_STAGE(PG8_SB(1, 1), b3 + hstep, voffB);
            PG8_WAIT_V(6); PG8_BAR; PG8_MMA(1, 1, At, B1); PG8_BAR;
            }
        }
        if constexpr (ALIGN_EPI) { if (wr == 0) PG8_BAR; }
        if constexpr (!Epi::AFTER_DRAIN) { E(acc, cur, wr, wc, fr, fq); S.done(cur); }
        if (!has_next) break;
#pragma unroll
        for (int a = 0; a < 2; ++a)
#pragma unroll
            for (int b = 0; b < 2; ++b)
#pragma unroll
                for (int m = 0; m < 4; ++m)
#pragma unroll
                    for (int n = 0; n < 2; ++n) acc[a][b][m][n] = (f32x4){0.f, 0.f, 0.f, 0.f};
        cur = nxt; cA = nA; cB = nB; ++ui;
        if constexpr (ALIGN_EPI) { if (wr == 1) PG8_BAR; }
    }
    PG8_WAIT_V(0);
    if constexpr (!ALIGN_EPI) { if (wr == 0) PG8_BAR; }
    PG8_BAR;
    if constexpr (Epi::AFTER_DRAIN) { E.fused(acc, cur, wr, wc, fr, fq, lds, wid, lane); S.done(cur); }
#undef PG8_SA
#undef PG8_SB
#undef PG8_STAGE
#undef PG8_LDA
#undef PG8_LDB
#undef PG8_MMA
#undef PG8_WAIT_V
#undef PG8_WAIT_L
#undef PG8_BAR
#undef PG8_SCHED
}
}
#include <hip/hip_bf16.h>
#include <cmath>
namespace attn_body {
using bf16=__hip_bfloat16;
using bf16x8=__attribute__((ext_vector_type(8)))short;
using s16x4=__attribute__((ext_vector_type(4)))short;
using f32x16=__attribute__((ext_vector_type(16)))float;
using u32x4=__attribute__((ext_vector_type(4)))unsigned;
using f32x4_t=__attribute__((ext_vector_type(4)))float;
constexpr int BATCH=8,NHEAD=8,SEQ=8192,D=64,DM=3584,DMO=1024;
constexpr int NW=8,QBLK=32,QB=QBLK*NW,KVBLK=64,NQB=SEQ/QB;
constexpr int ATTN_PITCH=DM, ATTN_UNIT_ROWS=QB;
__device__ __forceinline__ int crow(int r,int hi){return (r&3)+8*(r>>2)+4*hi;}
#define SBAR() __builtin_amdgcn_sched_barrier(0)
__device__ __forceinline__ void cmask(f32x16&p0,f32x16&p1,int jb,int qrel,int hi){
  const float NEG=-INFINITY; int dq=qrel-64*jb-4*hi; asm volatile("":"+v"(dq));
  #pragma unroll
  for(int r=0;r<16;++r){const int c=(r&3)+8*(r>>2); if(c>dq)p0[r]=NEG; if(c+32>dq)p1[r]=NEG;}
}

constexpr int NSLOT=3, SLOTB=8192;
constexpr int LDS_K=0, LDS_V=NSLOT*SLOTB, LDS_WS=2*NSLOT*SLOTB, LDS_OST=LDS_WS+NW*64*4, LDS_CN=LDS_OST+NW*4096, LDS_BYTES=LDS_CN+SEQ*4;
constexpr float C2=0.125f*1.4426950408889634f;
__device__ __forceinline__ void glds16(const void*gsrc,unsigned lds_dst){unsigned keep;
  asm volatile("s_mov_b32 %0, m0\n\ts_mov_b32 m0, %2\n\ts_nop 0\n\tglobal_load_lds_dwordx4 %1, off\n\ts_mov_b32 m0, %0":"=&s"(keep):"v"(gsrc),"s"(lds_dst):"memory");}
__device__ __forceinline__ float max3f(float a,float b,float c){float r;asm("v_max3_f32 %0, %1, %2, %3":"=v"(r):"v"(a),"v"(b),"v"(c));return r;}
__device__ __forceinline__ float max2f(float a,float b){float r;asm("v_max_f32_e32 %0, %1, %2":"=v"(r):"v"(a),"v"(b));return r;}
__device__ __forceinline__ float fadd_s(float a,float b){float r;asm("v_add_f32_e32 %0, %1, %2":"=v"(r):"v"(a),"v"(b));return r;}
__device__ __forceinline__ float fsub_s(float a,float b){float r;asm("v_sub_f32_e32 %0, %1, %2":"=v"(r):"v"(a),"v"(b));return r;}
typedef float f32x2_t __attribute__((ext_vector_type(2))); typedef __bf16 bf16x2_t __attribute__((ext_vector_type(2)));
__device__ __forceinline__ unsigned cvtpk_s(float lo,float hi){f32x2_t v={lo,hi};bf16x2_t b=__builtin_convertvector(v,bf16x2_t);return __builtin_bit_cast(unsigned,b);}
#define WAIT_BAR(N) asm volatile("s_waitcnt vmcnt(" #N ") lgkmcnt(0)\n\ts_barrier":::"memory")

__device__ __forceinline__ void qkt(f32x16&p0,f32x16&p1,const char*Kslot,const bf16x8*qr,int r32,int hi){
  const char*kb=Kslot+hi*1024+r32*16;
  #pragma unroll
  for(int d0=0;d0<4;++d0){
    const bf16x8 b0=*reinterpret_cast<const bf16x8*>(kb+d0*2048);
    const bf16x8 b1=*reinterpret_cast<const bf16x8*>(kb+d0*2048+512);
    {p0=__builtin_amdgcn_mfma_f32_32x32x16_bf16(b0,qr[d0],p0,0,0,0);p1=__builtin_amdgcn_mfma_f32_32x32x16_bf16(b1,qr[d0],p1,0,0,0);}}
}
typedef __attribute__((address_space(3))) const char* lds_cptr;
typedef short v4i16_t __attribute__((ext_vector_type(4)));
__device__ __forceinline__ void kload8(bf16x8*kf,lds_cptr kp){
  kf[0]=*(const __attribute__((address_space(3))) bf16x8*)(kp);      kf[1]=*(const __attribute__((address_space(3))) bf16x8*)(kp+512);
  kf[2]=*(const __attribute__((address_space(3))) bf16x8*)(kp+2048); kf[3]=*(const __attribute__((address_space(3))) bf16x8*)(kp+2560);
  kf[4]=*(const __attribute__((address_space(3))) bf16x8*)(kp+4096); kf[5]=*(const __attribute__((address_space(3))) bf16x8*)(kp+4608);
  kf[6]=*(const __attribute__((address_space(3))) bf16x8*)(kp+6144); kf[7]=*(const __attribute__((address_space(3))) bf16x8*)(kp+6656);
}
__device__ __forceinline__ void kload2(bf16x8*kf,lds_cptr kp,int j){ kf[2*j]=*(const __attribute__((address_space(3))) bf16x8*)(kp+j*2048); kf[2*j+1]=*(const __attribute__((address_space(3))) bf16x8*)(kp+j*2048+512); }
__device__ __forceinline__ s16x4 vtr(lds_cptr p){ return __builtin_bit_cast(s16x4,__builtin_amdgcn_ds_read_tr16_b64_v4i16((__attribute__((address_space(3))) v4i16_t*)p)); }
__device__ __forceinline__ float rowmax(const f32x16&p0,const f32x16&p1){
  float a=max3f(p0[0],p0[1],p1[0]),b=max3f(p0[2],p0[3],p1[1]);a=max3f(a,p1[2],p1[3]);
  #pragma unroll
  for(int r=4;r<16;r+=4){a=max3f(a,p0[r],p0[r+1]);b=max3f(b,p0[r+2],p0[r+3]);a=max3f(a,p1[r],p1[r+1]);b=max3f(b,p1[r+2],p1[r+3]);}
  const float m=max2f(a,b);
  auto rr=__builtin_amdgcn_permlane32_swap(__float_as_uint(m),__float_as_uint(m),false,false);
  return max2f(__uint_as_float(rr[0]),__uint_as_float(rr[1]));
}
__device__ __forceinline__ void pv(f32x16*o,int vb,bf16x8 pa0,bf16x8 pa1,bf16x8 pa2,bf16x8 pa3){
  #pragma unroll
  for(int d0=0;d0<2;++d0){s16x4 lo[4],hi[4];
    #pragma unroll
    for(int ks=0;ks<4;++ks){
      asm volatile("ds_read_b64_tr_b16 %0,%1 offset:%c2":"=&v"(lo[ks]):"v"(vb),"i"(d0*4096+ks*1024):"memory");
      asm volatile("ds_read_b64_tr_b16 %0,%1 offset:%c2":"=&v"(hi[ks]):"v"(vb),"i"(d0*4096+ks*1024+512):"memory");}
    asm volatile("s_waitcnt lgkmcnt(0)":::"memory");SBAR();
    #define PK(k) (bf16x8){lo[k][0],lo[k][1],lo[k][2],lo[k][3],hi[k][0],hi[k][1],hi[k][2],hi[k][3]}
    o[d0]=__builtin_amdgcn_mfma_f32_32x32x16_bf16(pa0,PK(0),o[d0],0,0,0);
    o[d0]=__builtin_amdgcn_mfma_f32_32x32x16_bf16(pa1,PK(1),o[d0],0,0,0);
    o[d0]=__builtin_amdgcn_mfma_f32_32x32x16_bf16(pa2,PK(2),o[d0],0,0,0);
    o[d0]=__builtin_amdgcn_mfma_f32_32x32x16_bf16(pa3,PK(3),o[d0],0,0,0);
    #undef PK
  }
}

#ifndef ATTN_STORE16
#define ATTN_STORE16(p,v) (*(u32x4*)(p)=(v))
#endif
template<int THRL> __device__ __forceinline__ void attn_unit(int b,int h,int qb,const bf16*Q,const bf16*__restrict__ K,const bf16*__restrict__ V,bf16*O,const float*__restrict__ cng,char*shm,const int tid_in){
  const int tid=tid_in,lane=tid&63,r32=lane&31,hi=lane>>5; const int wid=__builtin_amdgcn_readfirstlane(tid>>6);
  const long rowbase=(long)b*SEQ; const int q0=qb*QB;
  typedef __attribute__((address_space(3))) float lds_f32; typedef __attribute__((address_space(3))) const f32x4_t lds_cf4;
  { lds_f32* cl=(lds_f32*)((__attribute__((address_space(3))) char*)shm+LDS_CN); const int ncn=q0+QB;
    for(int i=tid*4;i<ncn;i+=NW*64*4){ const f32x4_t v=*reinterpret_cast<const f32x4_t*>(cng+i); *(__attribute__((address_space(3))) f32x4_t*)(cl+i)=v; } }
  const __attribute__((address_space(3))) char* cnr=(const __attribute__((address_space(3))) char*)shm+LDS_CN+r32*4;
  #define BFRAG(F,x_) do{ const unsigned xb_=__float_as_uint(x_), xh_=xb_&0xffff0000u; const float r1_=(x_)-__uint_as_float(xh_); const unsigned mb_=__float_as_uint(r1_)&0xffff0000u; \
      const float r2_=r1_-__uint_as_float(mb_); u32x4 w_; w_.x=hi?0u:((xh_>>16)|mb_); w_.y=hi?0u:((__float_as_uint(r2_)>>16)|0x3f800000u); w_.z=hi?0u:0x3f803f80u; w_.w=0u; F=__builtin_bit_cast(bf16x8,w_); }while(0)
  #define BFR(t) do{ const float c0_=*(const __attribute__((address_space(3))) float*)(cnr+(t)*256), c1_=*(const __attribute__((address_space(3))) float*)(cnr+(t)*256+128); BFRAG(bfa,c0_); BFRAG(bfb,c1_); }while(0)
  #define MFRAG_SET() do{ const float x_=-mhat; const unsigned xb_=__float_as_uint(x_), xh_=xb_&0xffff0000u; const float r1_=x_-__uint_as_float(xh_); const unsigned mb_=__float_as_uint(r1_)&0xffff0000u; \
      const float r2_=r1_-__uint_as_float(mb_); u32x4 w_; w_.x=0x3f803f80u; w_.y=0x3f80u|xh_; w_.z=(mb_>>16)|(__float_as_uint(r2_)&0xffff0000u); w_.w=0u; mfrag=__builtin_bit_cast(bf16x8,w_); asm volatile("":"+v"(mfrag)); }while(0)
  const bf16*Qw=Q+(rowbase+q0+wid*QBLK)*DM+h*D;
  const bf16*Kh=K+rowbase*DM+h*D,*Vh=V+rowbase*DM+h*D;
  const unsigned lds0=(unsigned)(uintptr_t)shm;
  float*wsf=(float*)(shm+LDS_WS)+wid*64;
  const bf16*ksrc=Kh+(long)lane*DM+wid*8;
  const bf16*vsrc=Vh+(long)(16*(wid&3)+(lane>>2))*DM+(wid>>2)*32+(lane&3)*8;
  const unsigned kdst=lds0+LDS_K+wid*1024, vdst=lds0+LDS_V+wid*1024;
  #define DMA_K(t,slot) glds16(ksrc+(long)(t)*KVBLK*DM,(unsigned)__builtin_amdgcn_readfirstlane(kdst+(slot)))
  #define DMA_V(t,slot) glds16(vsrc+(long)(t)*KVBLK*DM,(unsigned)__builtin_amdgcn_readfirstlane(vdst+(slot)))
  const int vb0=(int)(lds0+LDS_V)+((lane>>4)&1)*32+(lane&3)*8+(4*hi+((lane&15)>>2))*64;
  const char*Kbase=shm+LDS_K; bf16x8 kf[8];
  const lds_cptr shm3=(lds_cptr)shm; const lds_cptr kp0=shm3+LDS_K+hi*1024+r32*16; const lds_cptr vp0=shm3+LDS_V+((lane>>4)&1)*32+(lane&3)*8+(4*hi+((lane&15)>>2))*64;
  const int NT=(q0+QB)/KVBLK;
  DMA_K(0,0);DMA_V(0,0);DMA_K(1,SLOTB);
  bf16x8 qr[4];
  #pragma unroll
  for(int d0=0;d0<4;++d0)qr[d0]=*reinterpret_cast<const bf16x8*>(&Qw[(long)r32*DM+d0*16+hi*8]);
  const __attribute__((address_space(3))) char* qlp=(const __attribute__((address_space(3))) char*)shm+LDS_OST+wid*4096+lane*16;
  #pragma unroll
  for(int d0=0;d0<4;++d0)*(__attribute__((address_space(3))) bf16x8*)(qlp+d0*1024)=qr[d0];
  #define QLD() do{ _Pragma("unroll") for(int d_=0;d_<4;++d_)qr[d_]=*(const __attribute__((address_space(3))) bf16x8*)(qlp+d_*1024); }while(0)
  float mhat=0.f,l_reg=0.f;f32x16 o[2];o[0]=f32x16{};o[1]=f32x16{};bf16x8 mfrag,bfa,bfb; const f32x16 zero16=f32x16{}; MFRAG_SET();
  const int qrel=wid*QBLK+r32;
  #define CMASK(P0,P1,t) do{int jb_=(t)-(NT-4); if(jb_>=0)cmask(P0,P1,jb_,qrel,hi);}while(0)
  bool resc=false;
  #define START(P0,P1) do{ const float rm=rowmax(P0,P1); resc=false; \
    { const float dl=rm; mhat=fadd_s(mhat,dl); \
      _Pragma("unroll") for(int r=0;r<16;++r){P0[r]=fsub_s(P0[r],dl);P1[r]=fsub_s(P1[r],dl);} \
      MFRAG_SET(); } \
    _Pragma("unroll") for(int r=0;r<16;++r)P0[r]=__builtin_amdgcn_exp2f(P0[r]); }while(0)
  #define RESC() do{ if(resc){ asm volatile("s_waitcnt lgkmcnt(0)":::"memory"); \
      _Pragma("unroll") for(int d_=0;d_<2;++d_) _Pragma("unroll") for(int r=0;r<16;++r)o[d_][r]*=wsf[crow(r,hi)]; } }while(0)
  f32x16 pA0,pA1,pB0,pB1;
  int sl_prev=0,sl_cur=0,sl_next=SLOTB;
  #define ROT() do{sl_prev=sl_cur;sl_cur=sl_next;sl_next=(sl_next==(NSLOT-1)*SLOTB)?0:sl_next+SLOTB;}while(0)
  DMA_K(2,2*SLOTB);
  WAIT_BAR(3);
  BFR(0); pA0=__builtin_amdgcn_mfma_f32_32x32x16_bf16(bfa,mfrag,zero16,0,0,0); pA1=__builtin_amdgcn_mfma_f32_32x32x16_bf16(bfb,mfrag,zero16,0,0,0);
  qkt(pA0,pA1,Kbase,qr,r32,hi);asm volatile("s_nop 15\n\ts_nop 7":"+v"(pA0),"+v"(pA1));CMASK(pA0,pA1,0);
  START(pA0,pA1);
  _Pragma("unroll") for(int r=0;r<16;++r)pA1[r]=__builtin_amdgcn_exp2f(pA1[r]);
  WAIT_BAR(0);
  DMA_K(3,0);DMA_V(1,SLOTB);
  ROT();
  kload8(kf,kp0+sl_cur);
  BFR(1);
  WAIT_BAR(2);
  s16x4 vlo[8],vhi[8]; u32x4 pw0,pw1,pw2,pw3;
  #define PKW(P,B) cvtpk_s(P[B],P[B+1])
  #define PAF(k) __builtin_bit_cast(bf16x8,pw##k)
  #define VFR(i) (bf16x8){vlo[i][0],vlo[i][1],vlo[i][2],vlo[i][3],vhi[i][0],vhi[i][1],vhi[i][2],vhi[i][3]}
  #define PIN(x) asm volatile("":"+v"(x))
  #define MX3(a,b,c) __builtin_fmaxf(__builtin_fmaxf((a),(b)),(c))
  #define GAPA(MF,A0,A1,A2,A3,W0,W1,PW) do{ MF; sacc+=A0; sacc+=A1; sacc+=A2; sacc+=A3; PIN(sacc); W0; W1; PIN(PW); SBAR(); }while(0)
  #define EX(v) __builtin_amdgcn_exp2f(v)
  #define GAPB(MF,X,B) do{ MF; X[B]=EX(X[B]); X[B+1]=EX(X[B+1]); X[B+2]=EX(X[B+2]); X[B+3]=EX(X[B+3]); PIN(X); SBAR(); }while(0)
  #define VRD(i) do{ vlo[i]=vtr(vp_+(((i)>>2)*4096+((i)&3)*1024)); vhi[i]=vtr(vp_+(((i)>>2)*4096+((i)&3)*1024+512)); }while(0)
  #define KRD(G,j) do{ if(G){ kload2(kf,kp0+sl_next,j); SBAR(); } }while(0)
  #define STEP(C0,C1,P0,P1,t,GK,GV,GL) do{ SBAR(); \
    const lds_cptr vp_=vp0+sl_prev; \
    VRD(0); SBAR(); float sacc=(P0[0]+P0[1]); \
    C0=__builtin_amdgcn_mfma_f32_32x32x16_bf16(bfa,mfrag,zero16,0,0,0); C1=__builtin_amdgcn_mfma_f32_32x32x16_bf16(bfb,mfrag,zero16,0,0,0); SBAR(); \
    GAPA(C0=__builtin_amdgcn_mfma_f32_32x32x16_bf16(kf[0],qr[0],C0,0,0,0), P0[2],P0[3],P0[4],P0[5],     pw0[0]=PKW(P0,0), pw0[1]=PKW(P0,2), pw0); \
    VRD(4); SBAR(); GAPA(C1=__builtin_amdgcn_mfma_f32_32x32x16_bf16(kf[1],qr[0],C1,0,0,0), P0[6],P0[7],P0[8],P0[9],     pw0[2]=PKW(P0,4), pw0[3]=PKW(P0,6), pw0); \
    VRD(1); SBAR(); GAPA(C0=__builtin_amdgcn_mfma_f32_32x32x16_bf16(kf[2],qr[1],C0,0,0,0),   P0[10],P0[11],P0[12],P0[13], pw1[0]=PKW(P0,8), pw1[1]=PKW(P0,10), pw1); \
    VRD(5); SBAR(); GAPA(C1=__builtin_amdgcn_mfma_f32_32x32x16_bf16(kf[3],qr[1],C1,0,0,0),   P0[14],P0[15],P1[0],P1[1],   pw1[2]=PKW(P0,12),pw1[3]=PKW(P0,14), pw1); \
    VRD(2); SBAR(); GAPA(C0=__builtin_amdgcn_mfma_f32_32x32x16_bf16(kf[4],qr[2],C0,0,0,0),   P1[2],P1[3],P1[4],P1[5],     pw2[0]=PKW(P1,0), pw2[1]=PKW(P1,2), pw2); \
    VRD(6); SBAR(); GAPA(C1=__builtin_amdgcn_mfma_f32_32x32x16_bf16(kf[5],qr[2],C1,0,0,0),   P1[6],P1[7],P1[8],P1[9],     pw2[2]=PKW(P1,4), pw2[3]=PKW(P1,6), pw2); \
    VRD(3); SBAR(); GAPA(C0=__builtin_amdgcn_mfma_f32_32x32x16_bf16(kf[6],qr[3],C0,0,0,0),   P1[10],P1[11],P1[12],P1[13], pw3[0]=PKW(P1,8), pw3[1]=PKW(P1,10), pw3); \
    VRD(7); SBAR(); GAPA(C1=__builtin_amdgcn_mfma_f32_32x32x16_bf16(kf[7],qr[3],C1,0,0,0),   P1[14],P1[15],0.f,0.f,       pw3[2]=PKW(P1,12),pw3[3]=PKW(P1,14), pw3); \
    l_reg+=sacc; \
    if(GK){DMA_K((t)+3,sl_cur);} if(GV){DMA_V((t)+1,sl_next);} \
    CMASK(C0,C1,t); \
    { float a=MX3(C0[0],C0[1],C1[0]),b=MX3(C0[2],C0[3],C1[1]); a=MX3(a,C1[2],C1[3]); \
      _Pragma("unroll") for(int r=4;r<16;r+=4){a=MX3(a,C0[r],C0[r+1]);b=MX3(b,C0[r+2],C0[r+3]);a=MX3(a,C1[r],C1[r+1]);b=MX3(b,C1[r+2],C1[r+3]);} \
      float rm=__builtin_fmaxf(a,b); { auto rr=__builtin_amdgcn_permlane32_swap(__float_as_uint(rm),__float_as_uint(rm),false,false); rm=__builtin_fmaxf(__uint_as_float(rr[0]),__uint_as_float(rr[1])); } \
      resc=false; \
      if(__builtin_expect(__any(rm>(float)THRL),0)){ const float dl=__builtin_fmaxf(rm,0.f); mhat+=dl; \
        _Pragma("unroll") for(int r=0;r<16;++r){C0[r]-=dl;C1[r]-=dl;} \
        MFRAG_SET(); \
        const float f=__builtin_amdgcn_exp2f(-dl); l_reg*=f; if(hi==0)wsf[r32]=f; resc=true; } } \
    SBAR(); \
    GAPB(o[0]=__builtin_amdgcn_mfma_f32_32x32x16_bf16(PAF(0),VFR(0),o[0],0,0,0), C0,0); \
    GAPB(o[1]=__builtin_amdgcn_mfma_f32_32x32x16_bf16(PAF(0),VFR(4),o[1],0,0,0), C0,4); \
    KRD(GL,0); GAPB(o[0]=__builtin_amdgcn_mfma_f32_32x32x16_bf16(PAF(1),VFR(1),o[0],0,0,0), C0,8); \
    KRD(GL,1); GAPB(o[1]=__builtin_amdgcn_mfma_f32_32x32x16_bf16(PAF(1),VFR(5),o[1],0,0,0), C0,12); \
    KRD(GL,2); GAPB(o[0]=__builtin_amdgcn_mfma_f32_32x32x16_bf16(PAF(2),VFR(2),o[0],0,0,0), C1,0); \
    KRD(GL,3); GAPB(o[1]=__builtin_amdgcn_mfma_f32_32x32x16_bf16(PAF(2),VFR(6),o[1],0,0,0), C1,4); \
    GAPB(o[0]=__builtin_amdgcn_mfma_f32_32x32x16_bf16(PAF(3),VFR(3),o[0],0,0,0), C1,8); \
    GAPB(o[1]=__builtin_amdgcn_mfma_f32_32x32x16_bf16(PAF(3),VFR(7),o[1],0,0,0), C1,12); \
    BFR((t)+1); \
    }while(0)
  int t=1;
  #undef CMASK
  #define CMASK(P0,P1,t) do{}while(0)
  for(;t+5<NT;t+=2){
    STEP(pB0,pB1,pA0,pA1,t,true,true,true);     WAIT_BAR(2); RESC(); ROT();
    STEP(pA0,pA1,pB0,pB1,t+1,true,true,true);   WAIT_BAR(2); RESC(); ROT();
  }
  #undef CMASK
  #define CMASK(P0,P1,t) do{int jb_=(t)-(NT-4); if(jb_>=0)cmask(P0,P1,jb_,qrel,hi);}while(0)
  #define ENDW(tt) do{ if((tt)+3<NT){WAIT_BAR(2);} else if((tt)+2<NT){WAIT_BAR(1);} else {WAIT_BAR(0);} }while(0)
  for(;t+1<NT;t+=2){
    STEP(pB0,pB1,pA0,pA1,t,(t+3<NT),(t+1<NT),(t+1<NT));       ENDW(t);   RESC(); ROT();
    STEP(pA0,pA1,pB0,pB1,t+1,(t+4<NT),(t+2<NT),(t+2<NT));     ENDW(t+1); RESC(); ROT();
  }
  STEP(pB0,pB1,pA0,pA1,NT-1,false,false,false); RESC();
  { float sacc=pB0[0]+pB0[1]; _Pragma("unroll") for(int r=2;r<16;++r)sacc+=pB0[r]; _Pragma("unroll") for(int r=0;r<16;++r)sacc+=pB1[r]; l_reg+=sacc;
    pw0=(u32x4){PKW(pB0,0),PKW(pB0,2),PKW(pB0,4),PKW(pB0,6)};pw1=(u32x4){PKW(pB0,8),PKW(pB0,10),PKW(pB0,12),PKW(pB0,14)};pw2=(u32x4){PKW(pB1,0),PKW(pB1,2),PKW(pB1,4),PKW(pB1,6)};pw3=(u32x4){PKW(pB1,8),PKW(pB1,10),PKW(pB1,12),PKW(pB1,14)};
    SBAR(); pv(o,vb0+sl_cur,PAF(0),PAF(1),PAF(2),PAF(3)); }
  #undef PKW
  #undef PAF
  #undef VFR
  #undef PIN
  #undef MX3
  #undef GAPA
  #undef GAPB
  #undef EX
  #undef VRD
  #undef KRD
  #undef STEP
  #undef ENDW
  {auto rr=__builtin_amdgcn_permlane32_swap(__float_as_uint(l_reg),__float_as_uint(l_reg),false,false);l_reg=__uint_as_float(rr[0])+__uint_as_float(rr[1]);}
  if(hi==0)wsf[32+r32]=l_reg;asm volatile("s_waitcnt lgkmcnt(0)":::"memory");
  float rli[16];
  #pragma unroll
  for(int r=0;r<16;++r)rli[r]=__builtin_amdgcn_rcpf(wsf[32+crow(r,hi)]);
  bf16*Ow=O+(rowbase+q0+wid*QBLK)*DMO+h*D;
  { bf16*stg=(bf16*)(shm+LDS_OST)+wid*2048;
    #pragma unroll
    for(int r=0;r<16;++r){const int orow=crow(r,hi);
      #pragma unroll
      for(int d0=0;d0<2;++d0)stg[orow*64+d0*32+r32]=__float2bfloat16(o[d0][r]*rli[r]);}
    asm volatile("s_waitcnt lgkmcnt(0)":::"memory");
    #pragma unroll
    for(int i=0;i<4;++i){const int row=i*8+(lane>>3),ch=lane&7; const u32x4 v=*(const u32x4*)(stg+row*64+ch*8); ATTN_STORE16(Ow+(long)row*DMO+ch*8,v);} }
  asm volatile("s_waitcnt lgkmcnt(0)\n\ts_barrier":::"memory");
  #undef BFRAG
  #undef BFR
  #undef MFRAG_SET
  #undef QLD
  #undef DMA_K
  #undef DMA_V
  #undef CMASK
  #undef START
  #undef RESC
  #undef ROT
}
constexpr int ATTN_LDS_BYTES=LDS_BYTES;
#undef SBAR
#undef WAIT_BAR
}
#define LAS __attribute__((address_space(3)))
typedef unsigned short bf16;
typedef unsigned v4u __attribute__((ext_vector_type(4)));
typedef unsigned v2u __attribute__((ext_vector_type(2)));
typedef float f32x4 __attribute__((ext_vector_type(4)));
typedef short bf16x8 __attribute__((ext_vector_type(8)));
typedef float f32x16 __attribute__((ext_vector_type(16)));
typedef LAS unsigned char* ldsp;
constexpr int NWAVES = 8;
constexpr int BATCH = 8, SEQ = 8192, D = 1024, M = BATCH * SEQ, NMEM = 256, MM = BATCH * NMEM, FF = 4096;
constexpr int ZW = 3584, NIN = 3840;
constexpr int ZC_MLQ = 0, ZC_MLK = 512, ZC_MLV = 1024, ZC_MLO = 1536, ZC_FXQ = 2048, ZC_FXK = 2560, ZC_FXV = 3072;
constexpr float LOG2E = 1.4426950408889634f;
constexpr float C2_FOX = 0.125f * LOG2E, C2_X = 0.0625f * LOG2E;
constexpr size_t MiB = 1u << 20;
constexpr size_t WS_CTL = 0, CTL_ZERO_BYTES = 131072;
constexpr size_t WS_WIN = 2 * MiB, WS_WOUT = 10 * MiB, WS_WXQ = 12 * MiB, WS_WXKV = 14 * MiB, WS_WXO = 18 * MiB, WS_W1 = 20 * MiB, WS_W2 = 28 * MiB;
constexpr size_t WS_MEMN = 36 * MiB, WS_KX = 40 * MiB, WS_VXT = 44 * MiB, WS_G = 48 * MiB, WS_CNEG = 52 * MiB, WS_SS1 = 54 * MiB, WS_SS2 = 58 * MiB, WS_SS3 = 62 * MiB;
constexpr size_t WS_XN = 72 * MiB, WS_MIX = 200 * MiB, WS_Z = 328 * MiB, WS_U = 328 * MiB, WS_VTG = 776 * MiB, WS_END = 840 * MiB;
constexpr int RING_BYTES = 131072, MISC_OFF = RING_BYTES, LDS_BYTES = 147456;

__device__ __forceinline__ unsigned f2bf(float f) { unsigned u = __builtin_bit_cast(unsigned, f); return (u + 0x7fffu + ((u >> 16) & 1u)) >> 16; }
__device__ __forceinline__ unsigned pk2(float lo, float hi) { return pg8::cvt_pk_bf16(lo, hi); }
__device__ __forceinline__ float bf_lo(unsigned w) { return __uint_as_float(w << 16); }
__device__ __forceinline__ float bf_hi(unsigned w) { return __uint_as_float(w & 0xffff0000u); }
__device__ __forceinline__ float wave_sum(float v) {
#pragma unroll
    for (int o = 1; o < 64; o <<= 1) v += __shfl_xor(v, o);
    return v;
}
__device__ __forceinline__ float logsig(float x) { const float e = __builtin_amdgcn_exp2f(-fabsf(x) * LOG2E); return fminf(x, 0.f) - __builtin_amdgcn_logf(1.0f + e) * 0.6931471805599453f; }
#define LDS_WAIT() asm volatile("s_waitcnt lgkmcnt(0)" ::: "memory")
#define LBAR() asm volatile("s_waitcnt lgkmcnt(0)\n\ts_barrier" ::: "memory")

template <class F> __device__ __forceinline__ void p0_transpose_item(const float* W, int K, int N, int ND, bf16* WT, LAS float* scr, int item, int lane, F srcmap) {
    const int nblk = ND / 32, kb = item / nblk, nb = item % nblk, k0 = 64 * kb, n0 = 32 * nb;
    const int sc = srcmap(n0 + (lane & 31));
#pragma unroll 8
    for (int i = 0; i < 32; ++i) { const int kk = 2 * i + (lane >> 5); scr[kk * 33 + (lane & 31)] = sc >= 0 ? W[(size_t)(k0 + kk) * N + sc] : 0.f; }
    LDS_WAIT(); asm volatile("" ::: "memory");
    const int c = lane & 7;
#pragma unroll
    for (int j = 0; j < 4; ++j) { const int n = (lane >> 3) + 8 * j; const LAS float* s = scr + (8 * c) * 33 + n;
        v4u o; o.x = pk2(s[0 * 33], s[1 * 33]); o.y = pk2(s[2 * 33], s[3 * 33]); o.z = pk2(s[4 * 33], s[5 * 33]); o.w = pk2(s[6 * 33], s[7 * 33]);
        *(v4u*)(WT + (size_t)(n0 + n) * K + k0 + 8 * c) = o; }
    LDS_WAIT(); asm volatile("" ::: "memory");
}
__device__ __forceinline__ void rms_row_to_bf16(const float* xrow, const float* gain, bf16* orow, int lane) {
    const f32x4* xr = (const f32x4*)xrow + lane; const f32x4* gr = (const f32x4*)gain + lane;
    f32x4 v[4]; float s = 0.f;
#pragma unroll
    for (int j = 0; j < 4; ++j) { v[j] = xr[64 * j]; s += (v[j].x * v[j].x + v[j].y * v[j].y) + (v[j].z * v[j].z + v[j].w * v[j].w); }
    const float r = 1.0f / sqrtf(wave_sum(s) * (1.f / 1024.f) + 1e-6f);
    unsigned long long* o8 = (unsigned long long*)orow + lane;
#pragma unroll
    for (int j = 0; j < 4; ++j) { const f32x4 g = gr[64 * j]; o8[64 * j] = (unsigned long long)pk2(v[j].x * r * g.x, v[j].y * r * g.y) | ((unsigned long long)pk2(v[j].z * r * g.z, v[j].w * r * g.w) << 32); }
}
template <int NR> __device__ __forceinline__ void rms_rows_to_bf16(const float* x0, size_t row_stride, const float* gain, bf16* o0, int lane) {
    f32x4 v[NR][4]; float s[NR];
#pragma unroll
    for (int r = 0; r < NR; ++r) { const f32x4* xr = (const f32x4*)(x0 + r * row_stride) + lane;
#pragma unroll
        for (int j = 0; j < 4; ++j) v[r][j] = xr[64 * j]; }
    f32x4 g[4];
#pragma unroll
    for (int j = 0; j < 4; ++j) g[j] = ((const f32x4*)gain)[lane + 64 * j];
#pragma unroll
    for (int r = 0; r < NR; ++r) { s[r] = 0.f;
#pragma unroll
        for (int j = 0; j < 4; ++j) s[r] += (v[r][j].x * v[r][j].x + v[r][j].y * v[r][j].y) + (v[r][j].z * v[r][j].z + v[r][j].w * v[r][j].w); }
#pragma unroll
    for (int o = 1; o < 64; o <<= 1) {
#pragma unroll
        for (int r = 0; r < NR; ++r) s[r] += __shfl_xor(s[r], o); }
#pragma unroll
    for (int r = 0; r < NR; ++r) { const float rs = 1.0f / sqrtf(s[r] * (1.f / 1024.f) + 1e-6f); unsigned long long* o8 = (unsigned long long*)(o0 + r * row_stride) + lane;
#pragma unroll
        for (int j = 0; j < 4; ++j) o8[64 * j] = (unsigned long long)pk2(v[r][j].x * rs * g[j].x, v[r][j].y * rs * g[j].y) | ((unsigned long long)pk2(v[r][j].z * rs * g[j].z, v[r][j].w * rs * g[j].w) << 32); }
}
namespace ml {
constexpr int QS = 0, KS = QS + 64 * 272, KWT = KS + 64 * 272, VT = KWT + 128 * 144, PS = VT + 128 * 144, RSP = PS + 64 * 144, CWL = RSP + 512, PRE_END = CWL + 5120;
constexpr int SB_Q = 0, SB_KW = 64 * 272, SB_VT = SB_KW + 128 * 144, SB_BYTES = SB_VT + 128 * 144, NQ = 2 * SB_BYTES, NV = NQ + 256, SSQ = NV + 512, ST_END = SSQ + 2048;
static_assert(PRE_END <= RING_BYTES && ST_END <= RING_BYTES, "mlstm LDS");
__device__ __forceinline__ float scan_add(float v, int lane) {
#pragma unroll
    for (int o = 1; o < 64; o <<= 1) { const float t = __shfl_up(v, o); if (lane >= o) v += t; }
    return v;
}
__device__ __forceinline__ float scan_max(float v, int lane) {
#pragma unroll
    for (int o = 1; o < 64; o <<= 1) { const float t = __shfl_up(v, o); if (lane >= o) v = fmaxf(v, t); }
    return v;
}
#define MFMA16(a, b, c) __builtin_amdgcn_mfma_f32_16x16x32_bf16(a, b, c, 0, 0, 0)
struct PreOut { bf16* QF; bf16* KWTg; bf16* VTg; float* HI; float* SC; float* SC2; };
struct PreRegs { v4u rq[7]; v4u rv[2]; float g_i, g_f; };
__device__ __forceinline__ void pre_load(int u, const bf16* __restrict__ Z, const float* __restrict__ G, PreRegs& R, const int tid) {
    const int lane = tid & 63, bh = u >> 7, c = u & 127, b = bh >> 2, h = bh & 3;
    const int g8 = tid & 15, isK = tid >> 8, tb = (tid >> 4) & 15, sb = tid >> 4;
    const int ch0 = (isK ? 512 : 0) + h * 128 + 8 * g8;
    const size_t rb = (size_t)b * SEQ + (size_t)c * 64;
    const bf16* zq = Z + rb * ZW + ch0; const bf16* zv = Z + rb * ZW + ZC_MLV + h * 128 + 8 * g8; const float* gp = G + rb * 16 + h;
#pragma unroll
    for (int i = 0; i < 7; ++i) { const int t = 4 * tb - 3 + i; R.rq[i] = (c == 0 && t < 0) ? (v4u){0u, 0u, 0u, 0u} : *(const v4u*)(zq + t * ZW); }
#pragma unroll
    for (int j = 0; j < 2; ++j) R.rv[j] = *(const v4u*)(zv + (2 * sb + j) * ZW);
    R.g_i = gp[lane * 16]; R.g_f = gp[lane * 16 + 4];
}
__device__ __forceinline__ void pre_unit(int u, const bf16* __restrict__ Z, const float* __restrict__ G, const PreOut& O,
        const float* __restrict__ conv_w, const float* __restrict__ conv_b, const float* __restrict__ b_i, const float* __restrict__ b_f, ldsp L, const int tid_in, int& cw_head, PreRegs& R, const int u_next) {
    const int tid = tid_in, lane = tid & 63, w = __builtin_amdgcn_readfirstlane(tid >> 6), fr = lane & 15, fq = lane >> 4;
    const int bh = u >> 7, c = u & 127, b = bh >> 2, h = bh & 3;
    const int g8 = tid & 15, isK = tid >> 8, tb = (tid >> 4) & 15, sb = tid >> 4;
    const int ch0 = (isK ? 512 : 0) + h * 128 + 8 * g8;
    const size_t rb = (size_t)b * SEQ + (size_t)c * 64;
    if (cw_head != h) {
        for (int idx = tid; idx < 1280; idx += 512) { const int which = idx / 640, j = (idx % 640) >> 7, ch = idx & 127;
            *(LAS float*)(L + CWL + idx * 4) = j < 4 ? conv_w[j * 1024 + which * 512 + h * 128 + ch] : conv_b[which * 512 + h * 128 + ch]; }
        cw_head = h;
        __syncthreads();
    }
    const int cwo = CWL + (isK * 640 + 8 * g8) * 4;
    const float lf = logsig(R.g_f + b_f[h]), ig = R.g_i + b_i[h];
    const float bc = scan_add(lf, lane), uu = ig - bc, pm = scan_max(uu, lane);
    const float umax = __shfl(pm, 63), gl = __shfl(bc, 63);
    const float wl = __expf(uu - umax);
    {
        float y[4][8];
        { const f32x4 c0 = *(const LAS f32x4*)(L + cwo + 4 * 512), c1 = *(const LAS f32x4*)(L + cwo + 4 * 512 + 16);
#pragma unroll
          for (int tt = 0; tt < 4; ++tt) { y[tt][0] = c0[0]; y[tt][1] = c0[1]; y[tt][2] = c0[2]; y[tt][3] = c0[3]; y[tt][4] = c1[0]; y[tt][5] = c1[1]; y[tt][6] = c1[2]; y[tt][7] = c1[3]; } }
#pragma unroll
        for (int j = 0; j < 4; ++j) {
            const f32x4 c0 = *(const LAS f32x4*)(L + cwo + j * 512), c1 = *(const LAS f32x4*)(L + cwo + j * 512 + 16);
            const float cwj[8] = {c0[0], c0[1], c0[2], c0[3], c1[0], c1[1], c1[2], c1[3]};
#pragma unroll
            for (int tt = 0; tt < 4; ++tt) { const int r = tt + j;
                const float x[8] = {bf_lo(R.rq[r].x), bf_hi(R.rq[r].x), bf_lo(R.rq[r].y), bf_hi(R.rq[r].y), bf_lo(R.rq[r].z), bf_hi(R.rq[r].z), bf_lo(R.rq[r].w), bf_hi(R.rq[r].w)};
#pragma unroll
                for (int i = 0; i < 8; ++i) y[tt][i] += cwj[i] * x[i]; }
        }
        const float ksc = isK ? 0.08838834764831845f : 1.0f;
#pragma unroll
        for (int tt = 0; tt < 4; ++tt)
#pragma unroll
            for (int i = 0; i < 8; ++i) { const float a = y[tt][i]; y[tt][i] = a * __builtin_amdgcn_rcpf(1.0f + __expf(-a)) * ksc; }
        const int base = isK ? KS : QS;
#pragma unroll
        for (int tt = 0; tt < 4; ++tt) { v4u o; o.x = pk2(y[tt][0], y[tt][1]); o.y = pk2(y[tt][2], y[tt][3]); o.z = pk2(y[tt][4], y[tt][5]); o.w = pk2(y[tt][6], y[tt][7]);
            *(LAS v4u*)(L + base + (4 * tb + tt) * 272 + 16 * g8) = o;
            if (!isK) *(v4u*)(O.QF + ((size_t)u * 64 + 4 * tb + tt) * 128 + 8 * g8) = o; }
        if (isK) {
            float was[4];
#pragma unroll
            for (int tt = 0; tt < 4; ++tt) was[tt] = __shfl(wl, 4 * tb + tt);
#pragma unroll
            for (int i = 0; i < 8; ++i) { v2u o; o.x = pk2(y[0][i] * was[0], y[1][i] * was[1]); o.y = pk2(y[2][i] * was[2], y[3][i] * was[3]);
                *(LAS v2u*)(L + KWT + (8 * g8 + i) * 144 + 8 * tb) = o; }
        }
        {
            const unsigned a0[4] = {R.rv[0].x, R.rv[0].y, R.rv[0].z, R.rv[0].w}, a1[4] = {R.rv[1].x, R.rv[1].y, R.rv[1].z, R.rv[1].w};
#pragma unroll
            for (int i = 0; i < 4; ++i) {
                const unsigned lo = (a0[i] & 0xffffu) | (a1[i] << 16), hi = (a0[i] >> 16) | (a1[i] & 0xffff0000u);
                *(LAS unsigned*)(L + VT + (8 * g8 + 2 * i) * 144 + 4 * sb) = lo;
                *(LAS unsigned*)(L + VT + (8 * g8 + 2 * i + 1) * 144 + 4 * sb) = hi; }
        }
    }
    if (u_next >= 0) pre_load(u_next, Z, G, R, tid);
    LBAR();
    {
        const int tt = w >> 1, half = w & 1, t = 16 * tt + fr; const float Pt = __shfl(pm, t); float rs = 0.f;
#pragma unroll
        for (int j = 0; j < 2; ++j) { const int st = 2 * half + j; f32x4 a = (f32x4){0.f, 0.f, 0.f, 0.f};
            if (st <= tt) {
#pragma unroll
                for (int ks = 0; ks < 4; ++ks) { const bf16x8 kf = *(const LAS bf16x8*)(L + KS + (16 * st + fr) * 272 + (32 * ks + 8 * fq) * 2); const bf16x8 qf = *(const LAS bf16x8*)(L + QS + t * 272 + (32 * ks + 8 * fq) * 2); a = MFMA16(kf, qf, a); }
            }
            float p[4];
#pragma unroll
            for (int i = 0; i < 4; ++i) { const int s = 16 * st + 4 * fq + i; const float us = __shfl(uu, s); p[i] = (s <= t) ? a[i] * __expf(us - Pt) : 0.f; rs += p[i]; }
            v2u o; o.x = pk2(p[0], p[1]); o.y = pk2(p[2], p[3]);
            *(LAS v2u*)(L + PS + t * 144 + (16 * st + 4 * fq) * 2) = o; }
        rs += __shfl_xor(rs, 16); rs += __shfl_xor(rs, 32);
        if (fq == 0) *(LAS float*)(L + RSP + (t * 2 + half) * 4) = rs;
    }
#pragma unroll
    for (int i = 0; i < 2; ++i) { const int it = tid + 512 * i, row = it >> 3, chk = it & 7;
        *(v4u*)(O.KWTg + ((size_t)u * 128 + row) * 64 + 8 * chk) = *(const LAS v4u*)(L + KWT + row * 144 + 16 * chk);
        *(v4u*)(O.VTg + ((size_t)u * 128 + row) * 64 + 8 * chk) = *(const LAS v4u*)(L + VT + row * 144 + 16 * chk); }
    LBAR();
    {
        bf16x8 vf[2];
#pragma unroll
        for (int ks = 0; ks < 2; ++ks) vf[ks] = *(const LAS bf16x8*)(L + VT + (16 * w + fr) * 144 + (32 * ks + 8 * fq) * 2);
#pragma unroll
        for (int t4 = 0; t4 < 4; ++t4) { const int t = 16 * t4 + fr; f32x4 a = (f32x4){0.f, 0.f, 0.f, 0.f};
#pragma unroll
            for (int ks = 0; ks < 2; ++ks) { const bf16x8 pf = *(const LAS bf16x8*)(L + PS + t * 144 + (32 * ks + 8 * fq) * 2); a = MFMA16(vf[ks], pf, a); }
            *(f32x4*)(O.HI + ((size_t)u * 64 + t) * 128 + 16 * w + 4 * fq) = a; }
        if (w == 0) { const float rsum = *(const LAS float*)(L + RSP + lane * 8) + *(const LAS float*)(L + RSP + lane * 8 + 4);
            *(f32x4*)(O.SC + ((size_t)u * 64 + lane) * 4) = (f32x4){bc, pm, rsum, 0.f};
            if (lane == 0) { O.SC2[(size_t)u * 2] = umax; O.SC2[(size_t)u * 2 + 1] = gl; } }
    }
    LBAR();
}
__device__ __forceinline__ void stream(int b, int h, const bf16* __restrict__ Z, const PreOut& O, bf16* __restrict__ MIX, const float* __restrict__ ml_norm, ldsp L, const int tid_in, const int c_begin, const int c_end) {
    const int tid = tid_in, lane = tid & 63, w = __builtin_amdgcn_readfirstlane(tid >> 6), fr = lane & 15, fq = lane >> 4;
    const int bh = b * 4 + h;
    const f32x4 mln = *(const f32x4*)(ml_norm + h * 128 + 16 * w + 4 * fq);
    f32x4 accC[8];
#pragma unroll
    for (int i = 0; i < 8; ++i) accC[i] = (f32x4){0.f, 0.f, 0.f, 0.f};
    if (tid < 128) *(LAS float*)(L + NV + tid * 4) = 0.f;
    float mcar = 0.f;
    const size_t row0 = (size_t)b * SEQ;
    v4u st[6]; f32x4 hi[4]; v2u ro[4]; f32x4 sc4 = (f32x4){0.f, 0.f, 0.f, 0.f}; float umax, gch;
#pragma unroll
    for (int i = 0; i < 6; ++i) st[i] = (v4u){0u, 0u, 0u, 0u};
#pragma unroll
    for (int i = 0; i < 4; ++i) { hi[i] = (f32x4){0.f, 0.f, 0.f, 0.f}; ro[i] = (v2u){0u, 0u}; }
#define ML_LOAD(cc) do { const size_t u_ = (size_t)bh * 128 + (cc); \
        const bf16* pk_ = O.KWTg + u_ * 8192; const bf16* pv_ = O.VTg + u_ * 8192; \
        _Pragma("unroll") for (int i_ = 0; i_ < 2; ++i_) { const int it_ = tid + 512 * i_; st[2 + i_] = *(const v4u*)(pk_ + it_ * 8); st[4 + i_] = *(const v4u*)(pv_ + it_ * 8); } \
        umax = O.SC2[u_ * 2]; gch = O.SC2[u_ * 2 + 1]; \
        if ((cc) >= c_begin) { const bf16* pq_ = O.QF + u_ * 8192; const float* ph_ = O.HI + u_ * 8192; const bf16* po_ = Z + (row0 + (size_t)(cc) * 64) * ZW + ZC_MLO + h * 128; const float* ps_ = O.SC + u_ * 256; \
        _Pragma("unroll") for (int i_ = 0; i_ < 2; ++i_) { const int it_ = tid + 512 * i_; st[i_] = *(const v4u*)(pq_ + it_ * 8); } \
        _Pragma("unroll") for (int t4_ = 0; t4_ < 4; ++t4_) { hi[t4_] = *(const f32x4*)(ph_ + (16 * t4_ + fr) * 128 + 16 * w + 4 * fq); \
            ro[t4_] = *(const v2u*)(po_ + (16 * t4_ + fr) * ZW + 16 * w + 4 * fq); } \
        sc4 = *(const f32x4*)(ps_ + lane * 4); } } while (0)
    ML_LOAD(0);
    for (int c = 0; c < c_end; ++c) {
        const bool full = c >= c_begin;
        const int sbo = (c & 1) * SB_BYTES;
#pragma unroll
        for (int i = 0; i < 2; ++i) { const int it = tid + 512 * i;
            *(LAS v4u*)(L + sbo + SB_Q + (it >> 4) * 272 + (it & 15) * 16) = st[i];
            *(LAS v4u*)(L + sbo + SB_KW + (it >> 3) * 144 + (it & 7) * 16) = st[2 + i];
            *(LAS v4u*)(L + sbo + SB_VT + (it >> 3) * 144 + (it & 7) * 16) = st[4 + i]; }
        const float bc = sc4[0], pm = sc4[1], rsl = sc4[2];
        const float Mv = fmaxf(mcar, pm), Ml = fmaxf(mcar, umax);
        const float r1 = __expf(pm - Mv), inter = __expf(mcar - Mv), flo = __expf(-(bc + Mv));
        const float scl = __expf(umax - Ml), decay = __expf(mcar - Ml);
        mcar = gch + Ml;
        f32x4 acch[4]; v2u og[4];
#pragma unroll
        for (int t4 = 0; t4 < 4; ++t4) { acch[t4] = hi[t4]; og[t4] = ro[t4]; }
        if (c + 1 < c_end) ML_LOAD(c + 1);
        LBAR();
        if (full) {
            bf16x8 cx[4];
#pragma unroll
            for (int ks = 0; ks < 4; ++ks) { v4u o; o.x = pk2(accC[2 * ks][0], accC[2 * ks][1]); o.y = pk2(accC[2 * ks][2], accC[2 * ks][3]); o.z = pk2(accC[2 * ks + 1][0], accC[2 * ks + 1][1]); o.w = pk2(accC[2 * ks + 1][2], accC[2 * ks + 1][3]);
                cx[ks] = __builtin_bit_cast(bf16x8, o); }
#pragma unroll
            for (int t4 = 0; t4 < 4; ++t4) { const int t = 16 * t4 + fr; const float it = __shfl(inter, t), r1t = __shfl(r1, t);
                f32x4 a = (f32x4){0.f, 0.f, 0.f, 0.f};
                __builtin_amdgcn_s_setprio(1);
#pragma unroll
                for (int ks = 0; ks < 4; ++ks) { const v2u qlo = *(const LAS v2u*)(L + sbo + SB_Q + t * 272 + (32 * ks + 4 * fq) * 2), qhi = *(const LAS v2u*)(L + sbo + SB_Q + t * 272 + (32 * ks + 16 + 4 * fq) * 2);
                    const v4u qq = {qlo.x, qlo.y, qhi.x, qhi.y}; a = MFMA16(cx[ks], __builtin_bit_cast(bf16x8, qq), a); }
                __builtin_amdgcn_s_setprio(0);
                acch[t4] = acch[t4] * r1t + a * it;
                float sq = (acch[t4][0] * acch[t4][0] + acch[t4][1] * acch[t4][1]) + (acch[t4][2] * acch[t4][2] + acch[t4][3] * acch[t4][3]);
                sq += __shfl_xor(sq, 16); sq += __shfl_xor(sq, 32);
                if (fq == 0) *(LAS float*)(L + SSQ + (t * 8 + w) * 4) = sq; }
        }
        if (full) {
            const int ft = tid >> 3, part = tid & 7; float s = 0.f;
#pragma unroll
            for (int j = 0; j < 2; ++j) { const v4u qv = *(const LAS v4u*)(L + sbo + SB_Q + ft * 272 + (16 * part + 8 * j) * 2); const f32x4 n0 = *(const LAS f32x4*)(L + NV + (16 * part + 8 * j) * 4), n1 = *(const LAS f32x4*)(L + NV + (16 * part + 8 * j + 4) * 4);
                s += bf_lo(qv.x) * n0[0] + bf_hi(qv.x) * n0[1] + bf_lo(qv.y) * n0[2] + bf_hi(qv.y) * n0[3] + bf_lo(qv.z) * n1[0] + bf_hi(qv.z) * n1[1] + bf_lo(qv.w) * n1[2] + bf_hi(qv.w) * n1[3]; }
            s += __shfl_xor(s, 1); s += __shfl_xor(s, 2); s += __shfl_xor(s, 4);
            if (part == 0) *(LAS float*)(L + NQ + ft * 4) = s;
        }
        float nsum;
        {
            bf16x8 vf[2];
#pragma unroll
            for (int ks = 0; ks < 2; ++ks) vf[ks] = *(const LAS bf16x8*)(L + sbo + SB_VT + (16 * w + fr) * 144 + (32 * ks + 8 * fq) * 2);
            __builtin_amdgcn_s_setprio(1);
#pragma unroll
            for (int dt = 0; dt < 8; ++dt) { f32x4 a = (f32x4){0.f, 0.f, 0.f, 0.f};
#pragma unroll
                for (int ks = 0; ks < 2; ++ks) { const bf16x8 kwf = *(const LAS bf16x8*)(L + sbo + SB_KW + (16 * dt + fr) * 144 + (32 * ks + 8 * fq) * 2); a = MFMA16(kwf, vf[ks], a); }
                accC[dt] = accC[dt] * decay + a * scl; }
            __builtin_amdgcn_s_setprio(0);
            const int d = tid >> 2, part = tid & 3; float s = 0.f;
#pragma unroll
            for (int j = 0; j < 2; ++j) { const v4u kv = *(const LAS v4u*)(L + sbo + SB_KW + d * 144 + (16 * part + 8 * j) * 2);
                s += (bf_lo(kv.x) + bf_hi(kv.x)) + (bf_lo(kv.y) + bf_hi(kv.y)) + (bf_lo(kv.z) + bf_hi(kv.z)) + (bf_lo(kv.w) + bf_hi(kv.w)); }
            s += __shfl_xor(s, 1); s += __shfl_xor(s, 2);
            nsum = s;
        }
        LBAR();
        { const int d = tid >> 2, part = tid & 3; if (part == 0) { LAS float* np = (LAS float*)(L + NV + d * 4); *np = decay * *np + scl * nsum; } }
        if (full) {
#pragma unroll
        for (int t4 = 0; t4 < 4; ++t4) { const int t = 16 * t4 + fr;
            const float it = __shfl(inter, t), r1t = __shfl(r1, t), fl = __shfl(flo, t), rst = __shfl(rsl, t);
            const float den = r1t * rst + it * *(const LAS float*)(L + NQ + t * 4);
            const float dn = __builtin_amdgcn_rcpf(fmaxf(fabsf(den), fl));
            const f32x4 s0 = *(const LAS f32x4*)(L + SSQ + t * 32), s1 = *(const LAS f32x4*)(L + SSQ + t * 32 + 16);
            const float ss = (((s0[0] + s0[1]) + (s0[2] + s0[3])) + ((s1[0] + s1[1]) + (s1[2] + s1[3]))) * dn * dn;
            const float r = dn * __builtin_amdgcn_rsqf(ss * (1.0f / 128.0f) + 1e-6f);
            const float o0 = bf_lo(og[t4].x), o1 = bf_hi(og[t4].x), o2 = bf_lo(og[t4].y), o3 = bf_hi(og[t4].y);
            const float e0 = acch[t4][0] * r * mln[0] * __builtin_amdgcn_rcpf(1.0f + __expf(-o0)), e1 = acch[t4][1] * r * mln[1] * __builtin_amdgcn_rcpf(1.0f + __expf(-o1));
            const float e2 = acch[t4][2] * r * mln[2] * __builtin_amdgcn_rcpf(1.0f + __expf(-o2)), e3 = acch[t4][3] * r * mln[3] * __builtin_amdgcn_rcpf(1.0f + __expf(-o3));
            v2u o; o.x = pk2(e0, e1); o.y = pk2(e2, e3);
            *(v2u*)(MIX + (row0 + (size_t)c * 64 + t) * 1024 + h * 128 + 16 * w + 4 * fq) = o; }
        }
    }
#undef ML_LOAD
    __syncthreads();
}
}
namespace xa {
constexpr int BUFB = 36864;
#define MFMA32(a, b, c) __builtin_amdgcn_mfma_f32_32x32x16_bf16(a, b, c, 0, 0, 0)
__device__ __forceinline__ void xattn_unit(int pt, int hx, bf16* __restrict__ QO, const bf16* __restrict__ KX, const bf16* __restrict__ VXT, ldsp L, const int tid_in) {
    const int tid = tid_in, lane = tid & 63, w = __builtin_amdgcn_readfirstlane(tid >> 6), r32 = lane & 31, hi = lane >> 5;
    const int b = pt >> 5;
    bf16* qrow = QO + ((size_t)pt * 256 + w * 32 + r32) * 1024 + hx * 256;
    bf16x8 qf[16];
#pragma unroll
    for (int d0 = 0; d0 < 16; ++d0) qf[d0] = *(const bf16x8*)(qrow + 16 * d0 + 8 * hi);
    const bf16* kbase = KX + (size_t)b * 256 * 1024 + hx * 256;
    const bf16* vbase = VXT + (size_t)hx * 256 * 2048 + b * 256;
    v4u st[4];
#define XA_LOAD(j) do { if ((j) < 4) { _Pragma("unroll") for (int i_ = 0; i_ < 4; ++i_) { const int it_ = tid + 512 * i_, row_ = it_ >> 5, ch_ = it_ & 31; st[i_] = *(const v4u*)(kbase + (size_t)(64 * (j) + row_) * 1024 + 8 * ch_); } } \
        else { _Pragma("unroll") for (int i_ = 0; i_ < 2; ++i_) { const int it_ = tid + 512 * i_, row_ = it_ >> 3, ch_ = it_ & 7; st[i_] = *(const v4u*)(vbase + (size_t)(128 * (((j) - 4) >> 2) + row_) * 2048 + 64 * (((j) - 4) & 3) + 8 * ch_); } } } while (0)
#define XA_STORE(j) do { const int bo_ = ((j) & 1) * BUFB; if ((j) < 4) { _Pragma("unroll") for (int i_ = 0; i_ < 4; ++i_) { const int it_ = tid + 512 * i_, row_ = it_ >> 5, ch_ = it_ & 31; *(LAS v4u*)(L + bo_ + row_ * 528 + 16 * ch_) = st[i_]; } } \
        else { _Pragma("unroll") for (int i_ = 0; i_ < 2; ++i_) { const int it_ = tid + 512 * i_, row_ = it_ >> 3, ch_ = it_ & 7; *(LAS v4u*)(L + bo_ + row_ * 144 + 16 * ch_) = st[i_]; } } } while (0)
#define XA_QK(a0, a1, bo) do { a0 = (f32x16){}; a1 = (f32x16){}; __builtin_amdgcn_s_setprio(1); _Pragma("unroll") for (int d0 = 0; d0 < 16; ++d0) { \
        const bf16x8 k0_ = *(const LAS bf16x8*)(L + (bo) + r32 * 528 + (16 * d0 + 8 * hi) * 2), k1_ = *(const LAS bf16x8*)(L + (bo) + (32 + r32) * 528 + (16 * d0 + 8 * hi) * 2); \
        a0 = MFMA32(k0_, qf[d0], a0); a1 = MFMA32(k1_, qf[d0], a1); } __builtin_amdgcn_s_setprio(0); } while (0)
    XA_LOAD(0); XA_STORE(0);
    LBAR();
    float mt[4], lt[4];
    v4u pw[4][4];
#pragma unroll
    for (int j = 0; j < 4; ++j) {
        XA_LOAD(j + 1);
        f32x16 a0, a1; XA_QK(a0, a1, (j & 1) * BUFB);
        float mx = fmaxf(a0[0], a1[0]);
#pragma unroll
        for (int r = 1; r < 16; ++r) mx = fmaxf(mx, fmaxf(a0[r], a1[r]));
        mx = fmaxf(mx, __shfl_xor(mx, 32));
        float p[16], q[16], l = 0.f;
#pragma unroll
        for (int r = 0; r < 16; ++r) { p[r] = __builtin_amdgcn_exp2f(a0[r] - mx); q[r] = __builtin_amdgcn_exp2f(a1[r] - mx); l += p[r] + q[r]; }
        mt[j] = mx; lt[j] = l;
        pw[j][0] = (v4u){pk2(p[0], p[1]), pk2(p[2], p[3]), pk2(p[4], p[5]), pk2(p[6], p[7])};
        pw[j][1] = (v4u){pk2(p[8], p[9]), pk2(p[10], p[11]), pk2(p[12], p[13]), pk2(p[14], p[15])};
        pw[j][2] = (v4u){pk2(q[0], q[1]), pk2(q[2], q[3]), pk2(q[4], q[5]), pk2(q[6], q[7])};
        pw[j][3] = (v4u){pk2(q[8], q[9]), pk2(q[10], q[11]), pk2(q[12], q[13]), pk2(q[14], q[15])};
        XA_STORE(j + 1);
        LBAR();
    }
    const float mg = fmaxf(fmaxf(mt[0], mt[1]), fmaxf(mt[2], mt[3]));
    float l = 0.f;
#pragma unroll
    for (int j = 0; j < 4; ++j) { const float f = __builtin_amdgcn_exp2f(mt[j] - mg); l += f * lt[j];
#pragma unroll
        for (int k = 0; k < 4; ++k) { unsigned w4[4] = {pw[j][k].x, pw[j][k].y, pw[j][k].z, pw[j][k].w};
#pragma unroll
            for (int e = 0; e < 4; ++e) w4[e] = pk2(bf_lo(w4[e]) * f, bf_hi(w4[e]) * f);
            pw[j][k] = (v4u){w4[0], w4[1], w4[2], w4[3]}; } }
    l += __shfl_xor(l, 32);
    const float rl = 1.0f / l;
    bf16* obase = QO + ((size_t)pt * 256 + w * 32) * 1024 + hx * 256;
#pragma unroll
    for (int hd = 0; hd < 2; ++hd) {
        f32x16 o[4];
#pragma unroll
        for (int i = 0; i < 4; ++i) o[i] = (f32x16){};
#pragma unroll
        for (int vt = 0; vt < 4; ++vt) {
            const int j = 4 + 4 * hd + vt;
            if (j < 11) XA_LOAD(j + 1);
            const int bo = (j & 1) * BUFB;
            __builtin_amdgcn_s_setprio(1);
#pragma unroll
            for (int db = 0; db < 4; ++db)
#pragma unroll
                for (int j4 = 0; j4 < 4; ++j4) { const v2u lo = *(const LAS v2u*)(L + bo + (32 * db + r32) * 144 + (16 * j4 + 4 * hi) * 2), hh = *(const LAS v2u*)(L + bo + (32 * db + r32) * 144 + (16 * j4 + 8 + 4 * hi) * 2);
                    const v4u vv = {lo.x, lo.y, hh.x, hh.y}; o[db] = MFMA32(__builtin_bit_cast(bf16x8, pw[vt][j4]), __builtin_bit_cast(bf16x8, vv), o[db]); }
            __builtin_amdgcn_s_setprio(0);
            if (j < 11) { XA_STORE(j + 1); }
            LBAR();
        }
#pragma unroll
        for (int r = 0; r < 16; ++r) { const int q = (r & 3) + 8 * (r >> 2) + 4 * hi; const float rq = __shfl(rl, q);
#pragma unroll
            for (int db = 0; db < 4; ++db) obase[(size_t)q * 1024 + 128 * hd + 32 * db + r32] = (bf16)f2bf(o[db][r] * rq); }
    }
#undef XA_QK
#undef XA_LOAD
#undef XA_STORE
}
}
#define XB_TMO      128
#define XB_XCNT(j)  (256  + 64 * (j))
#define XB_XSUB(j)  (1280 + 64 * (j))
#define XB_XGEN(j)  (2304 + 64 * (j))
#define XB_TOP      3328
#define XB_TOPGEN   3392
#define XCD_BAR_WORDS 3456
#define XB_SPIN_CAP (1u << 18)

__device__ __forceinline__ unsigned xb_ld(unsigned* p)              { return __hip_atomic_load(p, __ATOMIC_RELAXED, __HIP_MEMORY_SCOPE_AGENT); }
__device__ __forceinline__ unsigned xb_add(unsigned* p, unsigned v) { return __hip_atomic_fetch_add(p, v, __ATOMIC_RELAXED, __HIP_MEMORY_SCOPE_AGENT); }
__device__ __forceinline__ unsigned xb_xcc_id() { return (unsigned)__builtin_amdgcn_s_getreg((3 << 11) | 20) & 0xFu; }
#define XB_SPIN(cond, bar) do { unsigned _sp = 0; while (cond) { __builtin_amdgcn_s_sleep(1); \
    if ((++_sp & 255u) == 0u) { if (xb_ld(&(bar)[XB_TMO])) break; if (_sp > XB_SPIN_CAP) { atomicAdd(&(bar)[XB_TMO], 1u); break; } } } } while (0)

struct XcdBarrier {
    unsigned* bar; unsigned x;
    volatile LAS unsigned* st;
};

__device__ __forceinline__ XcdBarrier xcd_barrier_post(unsigned* bar, volatile LAS unsigned* st) {
    XcdBarrier b; b.bar = bar; b.x = xb_xcc_id(); b.st = st;
    if (threadIdx.x == 0) (void)xb_add(&bar[XB_XCNT(b.x)], 1u);
    return b;
}
__device__ __forceinline__ void xcd_barrier_complete(unsigned* bar, unsigned x, unsigned& nloc, unsigned& nx) {
    const unsigned G = gridDim.x * gridDim.y * gridDim.z;
    unsigned sum, cnt, mine, sp = 0u;
    for (;;) {
        sum = 0u; cnt = 0u; mine = 0u;
#pragma unroll
        for (unsigned j = 0; j < 16; ++j) { const unsigned c = xb_ld(&bar[XB_XCNT(j)]); sum += c; cnt += (c > 0u) ? 1u : 0u; mine = (j == x) ? c : mine; }
        if (sum == G) break;
        __builtin_amdgcn_s_sleep(1);
        if ((++sp & 255u) == 0u) { if (xb_ld(&bar[XB_TMO])) break; if (sp > XB_SPIN_CAP) { atomicAdd(&bar[XB_TMO], 1u); break; } }
    }
    nloc = mine > 0u ? mine : 1u; nx = cnt > 0u ? cnt : 1u;
}

__device__ __forceinline__ void xcd_barrier(const XcdBarrier& b) {
    asm volatile("s_waitcnt vmcnt(0)" ::: "memory");
    __syncthreads();
    if (threadIdx.x == 0) {
        unsigned* bar = b.bar;
        __builtin_amdgcn_s_waitcnt(0);
        unsigned nloc = b.st[0], nx = b.st[1];
        if (nloc == 0u) { xcd_barrier_complete(bar, b.x, nloc, nx); b.st[0] = nloc; b.st[1] = nx; }
        const unsigned old = xb_add(&bar[XB_XSUB(b.x)], 1u);
        const unsigned gen = old / nloc;
        if (old + 1u == (gen + 1u) * nloc) {
            __builtin_amdgcn_fence(__ATOMIC_RELEASE, "agent");
            asm volatile("s_waitcnt vmcnt(0)" ::: "memory");
            const unsigned og = xb_add(&bar[XB_TOP], 1u);
            const unsigned tg = og / nx;
            if (og + 1u == (tg + 1u) * nx) xb_add(&bar[XB_TOPGEN], 1u);
            else XB_SPIN(xb_ld(&bar[XB_TOPGEN]) == tg, bar);
            __builtin_amdgcn_fence(__ATOMIC_ACQUIRE, "agent");
            xb_add(&bar[XB_XGEN(b.x)], 1u);
            asm volatile("s_waitcnt vmcnt(0)" ::: "memory");
        } else {
            XB_SPIN(xb_ld(&bar[XB_XGEN(b.x)]) == gen, bar);
            __builtin_amdgcn_fence(__ATOMIC_ACQUIRE, "agent");
            asm volatile("s_waitcnt vmcnt(0)" ::: "memory");
        }
    }
    __syncthreads();
}

struct Args { const float* in[20]; float* out; unsigned char* ws; int ph_lo, ph_hi, coop, pad; };
constexpr int N_PHASES = 10;
__global__ void __launch_bounds__(NWAVES * 64, 2) mk_fwd(Args args) {
    __builtin_assume(__builtin_amdgcn_workitem_id_y() == 0); __builtin_assume(__builtin_amdgcn_workitem_id_z() == 0);
    extern __shared__ __attribute__((aligned(16))) unsigned char lds[];
    const ldsp L = (ldsp)lds;
    volatile LAS unsigned* MISC = (volatile LAS unsigned*)(L + MISC_OFF);
    const int tid = threadIdx.x, lane = tid & 63, wave = __builtin_amdgcn_readfirstlane(tid >> 6);
    const int G = gridDim.x, bid = blockIdx.x;
#define x (args.in[0])
#define mem (args.in[1])
#define ln1 (args.in[2])
#define w_in (args.in[3])
#define conv_w (args.in[4])
#define conv_b (args.in[5])
#define ml_b_i (args.in[6])
#define ml_b_f (args.in[7])
#define ml_norm (args.in[8])
#define fx_b_f (args.in[9])
#define w_out (args.in[10])
#define ln_x (args.in[11])
#define ln_mem (args.in[12])
#define w_xq (args.in[13])
#define w_xkv (args.in[14])
#define w_xo (args.in[15])
#define ln2 (args.in[16])
#define w_ff1 (args.in[17])
#define w_ff2 (args.in[18])
#define ln_f (args.in[19])
    float* const out = args.out;
#define ctl ((unsigned*)(args.ws + WS_CTL))
#define Win_t ((bf16*)(args.ws + WS_WIN))
#define Wout_t ((bf16*)(args.ws + WS_WOUT))
#define Wxq_t ((bf16*)(args.ws + WS_WXQ))
#define Wxkv_t ((bf16*)(args.ws + WS_WXKV))
#define Wxo_t ((bf16*)(args.ws + WS_WXO))
#define W1_t ((bf16*)(args.ws + WS_W1))
#define W2_t ((bf16*)(args.ws + WS_W2))
#define MEMN ((bf16*)(args.ws + WS_MEMN))
#define KX ((bf16*)(args.ws + WS_KX))
#define VXT ((bf16*)(args.ws + WS_VXT))
#define GT ((float*)(args.ws + WS_G))
#define CNEG ((float*)(args.ws + WS_CNEG))
#define SS1 ((float*)(args.ws + WS_SS1))
#define SS2 ((float*)(args.ws + WS_SS2))
#define SS3 ((float*)(args.ws + WS_SS3))
#define XN ((bf16*)(args.ws + WS_XN))
#define MIX ((bf16*)(args.ws + WS_MIX))
#define Zb ((bf16*)(args.ws + WS_Z))
#define Ub ((bf16*)(args.ws + WS_U))
    const int lo = args.ph_lo, hi = args.ph_hi;
    if (tid < 16) MISC[tid] = 0u;
    __syncthreads();
    const XcdBarrier xbar = xcd_barrier_post((unsigned*)(ctl + 24576), MISC + 8);
#ifndef PH_MASK
#define PH_MASK 0x7ff
#endif
#define IN(k) ((((PH_MASK) >> (k)) & 1) && lo <= (k) && (k) < hi)
#ifndef DIL_MASK
#define DIL_MASK 0
#endif
#ifndef DIL_MUL
#define DIL_MUL 3
#endif
    unsigned long long tprev = (DIL_MASK) ? __builtin_amdgcn_s_memrealtime() : 0ull;
#define SEAM(k) do { if (IN(k) && IN((k) + 1)) { if (args.coop == 0x7fff0001) cg::this_grid().sync(); xcd_barrier(xbar); } \
    if (DIL_MASK) { unsigned long long t1_ = __builtin_amdgcn_s_memrealtime(); if (((DIL_MASK) >> (k)) & 1) { const unsigned long long w_ = (t1_ - tprev) * (DIL_MUL); while (__builtin_amdgcn_s_memrealtime() - t1_ < w_) __builtin_amdgcn_s_sleep(8); t1_ = __builtin_amdgcn_s_memrealtime(); } tprev = t1_; } } while (0)

    if (IN(0)) {
        LAS float* scr = (LAS float*)(L + wave * 16384);
        const int gw = bid * NWAVES + wave, NGW = G * NWAVES;
        constexpr int I_IN = 16 * (NIN / 32), I_SQ = 16 * 32, I_KV = 16 * 64, I_1 = 16 * 128, I_2 = 64 * 32;
        constexpr int NITEMS = I_IN + 3 * I_SQ + I_KV + I_1 + I_2;
        auto ident = [](int n) { return n; };
        auto inmap = [](int n) { return n < 2048 ? n : (n < 3584 ? n + 8 : (n < 3592 ? n - 1536 : (n < 3600 ? n : -1))); };
        for (int it = gw; it < NITEMS; it += NGW) {
            int r = it;
            if (r < I_IN) { p0_transpose_item(w_in, 1024, 3600, NIN, Win_t, scr, r, lane, inmap); continue; } r -= I_IN;
            if (r < I_SQ) { p0_transpose_item(w_out, 1024, 1024, 1024, Wout_t, scr, r, lane, ident); continue; } r -= I_SQ;
            if (r < I_SQ) { p0_transpose_item(w_xq, 1024, 1024, 1024, Wxq_t, scr, r, lane, ident); continue; } r -= I_SQ;
            if (r < I_KV) { p0_transpose_item(w_xkv, 1024, 2048, 2048, Wxkv_t, scr, r, lane, ident); continue; } r -= I_KV;
            if (r < I_SQ) { p0_transpose_item(w_xo, 1024, 1024, 1024, Wxo_t, scr, r, lane, ident); continue; } r -= I_SQ;
            if (r < I_1) { p0_transpose_item(w_ff1, 1024, 4096, 4096, W1_t, scr, r, lane, ident); continue; } r -= I_1;
            p0_transpose_item(w_ff2, 4096, 1024, 1024, W2_t, scr, r, lane, ident);
        }
        { int m = gw; for (; m + 3 * NGW < M; m += 4 * NGW) rms_rows_to_bf16<4>(x + (size_t)m * D, (size_t)NGW * D, ln1, XN + (size_t)m * D, lane);
          for (; m < M; m += NGW) rms_row_to_bf16(x + (size_t)m * D, ln1, XN + (size_t)m * D, lane); }
        for (int m = gw; m < MM; m += NGW) rms_row_to_bf16(mem + (size_t)m * D, ln_mem, MEMN + (size_t)m * D, lane);
        __syncthreads();
    }
    SEAM(0);
    if (IN(1)) {
        pg8::Gemm g{XN, Win_t, M, NIN, D}; pg8::StaticOrder S; S.init(M, NIN, G, bid);
        pg8::EpiZ E{Zb, GT, C2_FOX};
        pg8::gemm_phase<pg8::EpiZ, pg8::StaticOrder, true, true>(L, g, S, E, tid);
    }
    SEAM(1);
    if (IN(2)) {
        if (bid < 64) {
            const int b = bid >> 3, h = bid & 7; const float bfv = fx_b_f[h];
            float v[16]; float run = 0.f;
#pragma unroll
            for (int j = 0; j < 16; ++j) { const int s = 16 * tid + j; run += logsig(GT[((size_t)b * SEQ + s) * 16 + 8 + h] + bfv); v[j] = run; }
            const float inc = ml::scan_add(run, lane);
            LAS float* wt = (LAS float*)(L);
            if (lane == 63) wt[wave] = inc;
            __syncthreads();
            float off = inc - run;
            for (int ww = 0; ww < wave; ++ww) off += wt[ww];
#pragma unroll
            for (int j4 = 0; j4 < 4; ++j4) { f32x4 o;
#pragma unroll
                for (int i = 0; i < 4; ++i) o[i] = -(off + v[4 * j4 + i]) * LOG2E;
                *(f32x4*)(CNEG + (size_t)bid * SEQ + 16 * tid + 4 * j4) = o; }
            __syncthreads();
        } else if (bid < 96) {
            pg8::Gemm g{MEMN, Wxkv_t, MM, 1024, D}; pg8::StaticOrder S; S.init(MM, 1024, 32, bid - 64);
            pg8::EpiPlain E{KX, 1024};
            pg8::gemm_phase<pg8::EpiPlain, pg8::StaticOrder, true, true>(L, g, S, E, tid);
        } else if (bid < 128) {
            pg8::Gemm g{Wxkv_t + (size_t)1024 * 1024, MEMN, 1024, MM, D}; pg8::StaticOrder S; S.init(1024, MM, 32, bid - 96);
            pg8::EpiPlain E{VXT, 2048};
            pg8::gemm_phase<pg8::EpiPlain, pg8::StaticOrder, true, true>(L, g, S, E, tid);
        }
        {
            const ml::PreOut PO{XN, XN + (size_t)32 * 1024 * 1024, (bf16*)(args.ws + WS_VTG), out, SS2, SS3};
            int cw_head = -1;
            const int u0 = bid < 128 ? 14 * bid : 1792 + 18 * (bid - 128), nu = (G == 256) ? (bid < 128 ? 14 : 18) : 0;
            ml::PreRegs PR;
            if (nu > 0) ml::pre_load(u0, Zb, GT, PR, tid);
            for (int i = 0; i < nu; ++i) ml::pre_unit(u0 + i, Zb, GT, PO, conv_w, conv_b, ml_b_i, ml_b_f, L, tid, cw_head, PR, i + 1 < nu ? u0 + i + 1 : -1);
            if (G != 256) { for (int u = bid; u < 4096; u += G) { ml::pre_load(u, Zb, GT, PR, tid); ml::pre_unit(u, Zb, GT, PO, conv_w, conv_b, ml_b_i, ml_b_f, L, tid, cw_head, PR, -1); } }
        }
    }
    SEAM(2);
    if (IN(3)) {
#ifndef NO_ML
        if (bid < 64) { const ml::PreOut PO{XN, XN + (size_t)32 * 1024 * 1024, (bf16*)(args.ws + WS_VTG), out, SS2, SS3}; const int sg = 1 - (bid >> 5), sbh = bid & 31; ml::stream(sbh >> 2, sbh & 3, Zb, PO, MIX, ml_norm, L, tid, 64 * sg, 64 * sg + 64); }
#endif
#if defined(ML_SEP)
        cg::this_grid().sync();
        if (DIL_MASK) { unsigned long long t1_ = __builtin_amdgcn_s_memrealtime(); if (((DIL_MASK) >> 11) & 1) { const unsigned long long w_ = (t1_ - tprev) * (DIL_MUL); while (__builtin_amdgcn_s_memrealtime() - t1_ < w_) __builtin_amdgcn_s_sleep(8); t1_ = __builtin_amdgcn_s_memrealtime(); } tprev = t1_; }
#endif
        {
            if (tid == 0) { MISC[2] = (unsigned)__builtin_amdgcn_s_getreg((3 << 11) | 20) & 7u; MISC[3] = 0u; }
            for (;;) {
                if (tid == 0) { unsigned qi = MISC[3], u = 0xffffffffu;
                    while (qi < 8u) { const unsigned qx = (MISC[2] + qi) & 7u; const unsigned v = atomicAdd(ctl + 64 + 16 * qx, 1u); if (v < 256u) { u = qx * 256u + v; break; } ++qi; }
                    MISC[3] = qi; MISC[0] = u; }
                LBAR();
                const unsigned u = MISC[0];
                LBAR();
                if (u == 0xffffffffu) break;
                const int bh = (int)(u >> 5), qb = 31 - (int)(u & 31); int tq = tid; asm volatile("" : "+v"(tq));
#ifndef NO_FOX
                attn_body::attn_unit<100>(bh >> 3, bh & 7, qb, (const attn_body::bf16*)(Zb + ZC_FXQ), (const attn_body::bf16*)(Zb + ZC_FXK), (const attn_body::bf16*)(Zb + ZC_FXV),
                                        (attn_body::bf16*)(MIX + 512), CNEG + (size_t)bh * SEQ, (char*)lds, tq);
#endif
            }
        }
    }
    SEAM(3);
    if (IN(4)) {
        pg8::Gemm g{MIX, Wout_t, M, D, D}; pg8::StaticOrder S; S.init(M, D, G, bid);
        pg8::EpiRes E{x, out, XN, ln_x, SS1};
        pg8::gemm_phase<pg8::EpiRes, pg8::StaticOrder, true, true>(L, g, S, E, tid);
    }
    SEAM(4);
    if (IN(5)) {
        pg8::Gemm g{XN, Wxq_t, M, D, D}; pg8::StaticOrder S; S.init(M, D, G, bid);
        pg8::EpiRowScale<0> E{MIX, 1024, SS1, C2_X};
        pg8::gemm_phase<pg8::EpiRowScale<0>, pg8::StaticOrder, true, true>(L, g, S, E, tid);
    }
    if (IN(6)) {
#ifndef NO_XA
        { pg8::StaticOrder S; S.init(M, D, G, bid); pg8::Unit uu; for (int i = 0; S.next(i, uu); ++i) xa::xattn_unit(uu.pm, uu.pn, MIX, KX, VXT, L, tid); }
#endif
    }
    SEAM(6);
    if (IN(7)) {
        pg8::Gemm g{MIX, Wxo_t, M, D, D}; pg8::StaticOrder S; S.init(M, D, G, bid);
        pg8::EpiRes E{out, out, XN, ln2, SS2};
        pg8::gemm_phase<pg8::EpiRes, pg8::StaticOrder, true, true>(L, g, S, E, tid);
    }
    SEAM(7);
    if (IN(8)) {
        pg8::Gemm g{XN, W1_t, M, FF, D}; pg8::StaticOrder S; S.init(M, FF, G, bid);
        pg8::EpiRowScale<1> E{Ub, FF, SS2, 1.0f};
        pg8::gemm_phase<pg8::EpiRowScale<1>, pg8::StaticOrder, true, true>(L, g, S, E, tid);
    }
    SEAM(8);
    if (IN(9)) {
        pg8::Gemm g{Ub, W2_t, M, D, FF}; pg8::StaticOrder S; S.init(M, D, G, bid);
        if (G == 256) {
            pg8::EpiResNorm E{out, out, ln_f, SS3, ctl + 4096};
            pg8::gemm_phase<pg8::EpiResNorm, pg8::StaticOrder, true, true>(L, g, S, E, tid);
        } else {
            pg8::EpiRes E{out, out, nullptr, nullptr, SS3};
            pg8::gemm_phase<pg8::EpiRes, pg8::StaticOrder, true, true>(L, g, S, E, tid);
            xcd_barrier(xbar);
            const int gw = bid * NWAVES + wave, NGW = G * NWAVES;
            for (int m = gw; m < M; m += NGW) { const float r = pg8::row_rs(SS3, m); f32x4* p = (f32x4*)(out + (size_t)m * D) + lane;
#pragma unroll
                for (int j = 0; j < 4; ++j) p[64 * j] = p[64 * j] * ((const f32x4*)ln_f)[lane + 64 * j] * r; }
        }
    }
    SEAM(9);
#undef IN
#undef SEAM
}
#undef x
#undef mem
#undef ln1
#undef w_in
#undef conv_w
#undef conv_b
#undef ml_b_i
#undef ml_b_f
#undef ml_norm
#undef fx_b_f
#undef w_out
#undef ln_x
#undef ln_mem
#undef w_xq
#undef w_xkv
#undef w_xo
#undef ln2
#undef w_ff1
#undef w_ff2
#undef ln_f
#undef ctl
#undef Win_t
#undef Wout_t
#undef Wxq_t
#undef Wxkv_t
#undef Wxo_t
#undef W1_t
#undef W2_t
#undef MEMN
#undef KX
#undef VXT
#undef GT
#undef CNEG
#undef SS1
#undef SS2
#undef SS3
#undef XN
#undef MIX
#undef Zb
#undef Ub

#ifndef MK_SPLIT
#define MK_SPLIT 0
#endif
extern "C" void kernel_launch(void* const* d_in, const int* in_sizes, int n_in, void* d_out, int out_size, void* d_ws, size_t ws_size, hipStream_t stream) {
    static int grid = 0;
    if (grid == 0) {
        if (n_in != 20 || out_size != M * D || ws_size < WS_END) { fprintf(stderr, "kernel_launch: unexpected problem (n_in %d out %d ws %zu)\n", n_in, out_size, ws_size); grid = -1; return; }
        int dev = 0, cus = 0, per_cu = 0;
        hipGetDevice(&dev); hipDeviceGetAttribute(&cus, hipDeviceAttributeMultiprocessorCount, dev);
        if (hipFuncSetAttribute((const void*)mk_fwd, hipFuncAttributeMaxDynamicSharedMemorySize, LDS_BYTES) != hipSuccess) { fprintf(stderr, "kernel_launch: hipFuncSetAttribute failed\n"); grid = -1; return; }
        if (hipOccupancyMaxActiveBlocksPerMultiprocessor(&per_cu, (const void*)mk_fwd, NWAVES * 64, LDS_BYTES) != hipSuccess || per_cu < 1) { fprintf(stderr, "kernel_launch: occupancy query says %d\n", per_cu); per_cu = 1; }
        (void)hipGetLastError();
        grid = cus;
        if (grid > 256) grid = 256;
    }
    if (grid < 0) return;
    hipMemsetAsync((char*)d_ws + WS_CTL, 0, CTL_ZERO_BYTES, stream);
    Args a{};
    for (int i = 0; i < 20; ++i) a.in[i] = (const float*)d_in[i];
    a.out = (float*)d_out; a.ws = (unsigned char*)d_ws;
#if MK_SPLIT
    for (int p = 0; p < N_PHASES; ++p) { a.ph_lo = p; a.ph_hi = p + 1; a.coop = 0; hipLaunchKernelGGL(mk_fwd, dim3(grid), dim3(NWAVES * 64), LDS_BYTES, stream, a); }
#else
    a.ph_lo = 0; a.ph_hi = N_PHASES; a.coop = 1;
    void* kargs[] = {&a};
    hipError_t e = hipLaunchCooperativeKernel((const void*)mk_fwd, dim3(grid), dim3(NWAVES * 64), kargs, LDS_BYTES, stream);
    if (e != hipSuccess) fprintf(stderr, "cooperative launch failed: %s (grid %d)\n", hipGetErrorString(e), grid);
#endif
}
```
